# Optimizing an MI355X kernel written in HIP

```python
import math
import jax
import jax.numpy as jnp
from jax import lax
import numpy as np

D_MODEL = 1024
BATCH = 2
SEQ = 16384
DEPTH = 4

CHUNK = 64
N_A_LAYERS = max(1, DEPTH // 2)
N_B_LAYERS = DEPTH - N_A_LAYERS

GLA_HEADS = 4
GLA_DK = D_MODEL // 2 // GLA_HEADS
GLA_DV = D_MODEL // GLA_HEADS
GLA_GATE_RANK = 16
GLA_GATE_TAU = 16.0
GLA_HK = GLA_HEADS * GLA_DK
GLA_HV = GLA_HEADS * GLA_DV
GLA_IN = 2 * GLA_HK + 2 * GLA_HV + GLA_GATE_RANK

DIFF_HEADS = 8
DIFF_DH = D_MODEL // (2 * DIFF_HEADS)
DIFF_DV = 2 * DIFF_DH
DIFF_QK = DIFF_HEADS * DIFF_DH
Q_BLOCK = 128

REL_BUCKETS = 32
REL_MAX_DIST = 128

MOE_GROUPS = 4
MOE_EXPERTS_PER_GROUP = 4
MOE_EXPERTS = MOE_GROUPS * MOE_EXPERTS_PER_GROUP
MOE_TOPK = 2
MOE_FF = D_MODEL // 2

DEEPNORM_ALPHA = (2.0 * DEPTH) ** 0.25
DEEPNORM_BETA = (8.0 * DEPTH) ** -0.25
LN_EPS = 1e-5
NEG_INF = -1e30

kernel_name = 'hybrid_gla_diffattn_hmoe_yoco'


def layer_norm(x, g, b):
    xf = x.astype(jnp.float32)
    mu = jnp.mean(xf, -1, keepdims=True)
    var = jnp.mean(jnp.square(xf - mu), -1, keepdims=True)
    return ((xf - mu) * lax.rsqrt(var + LN_EPS)).astype(x.dtype) * g + b


def rms_norm(x, g):
    xf = x.astype(jnp.float32)
    return (xf * lax.rsqrt(jnp.mean(xf * xf, -1, keepdims=True) + LN_EPS)).astype(x.dtype) * g


def gla_mixer(x, w_in, w_gate2, b_gate, g_norm, w_out):
    B, S, _ = x.shape
    nc = S // CHUNK
    h = x @ w_in
    q, k, v, r, lr = jnp.split(h, [GLA_HK, 2 * GLA_HK, 2 * GLA_HK + GLA_HV, 2 * GLA_HK + 2 * GLA_HV], axis=-1)
    log_a = jax.nn.log_sigmoid((lr @ w_gate2 + b_gate).astype(jnp.float32)) / GLA_GATE_TAU

    def to_chunks(t, d):
        return t.reshape(B, nc, CHUNK, GLA_HEADS, d).transpose(1, 0, 3, 2, 4)

    qc = to_chunks(q * (GLA_DK ** -0.5), GLA_DK)
    kc = to_chunks(k, GLA_DK)
    vc = to_chunks(v, GLA_DV)
    cum = jnp.cumsum(to_chunks(log_a, GLA_DK), axis=3)
    last = cum[:, :, :, -1:, :]
    k_dec = kc * jnp.exp(last - cum).astype(kc.dtype)
    chunk_decay = jnp.exp(last[:, :, :, 0, :])

    def step(state, inp):
        q_c, k_c, v_c, dec = inp
        state = dec[..., None] * state + jnp.einsum('bhck,bhcv->bhkv', k_c.astype(jnp.float32), v_c.astype(jnp.float32))
        o = jnp.einsum('bhck,bhkv->bhcv', q_c.astype(jnp.float32), state)
        return state, o

    s0 = jnp.zeros((B, GLA_HEADS, GLA_DK, GLA_DV), jnp.float32)
    _, o = lax.scan(step, s0, (qc, k_dec, vc, chunk_decay))
    o = o.astype(x.dtype).transpose(1, 0, 3, 2, 4).reshape(B, S, GLA_HEADS, GLA_DV)
    o = rms_norm(o, g_norm.reshape(GLA_HEADS, GLA_DV)).reshape(B, S, GLA_HV)
    return (o * jax.nn.silu(r)) @ w_out


def shared_kv(x, w_kv):
    B, S, _ = x.shape
    kv = x @ w_kv
    k1, k2, v = jnp.split(kv, [DIFF_QK, 2 * DIFF_QK], axis=-1)
    k1 = k1.reshape(B, S, DIFF_HEADS, DIFF_DH).transpose(0, 2, 1, 3)
    k2 = k2.reshape(B, S, DIFF_HEADS, DIFF_DH).transpose(0, 2, 1, 3)
    v = v.reshape(B, S, DIFF_HEADS, DIFF_DV).transpose(0, 2, 1, 3)
    return k1, k2, v


def rel_bucket(rel):
    nb = REL_BUCKETS // 2
    max_exact = nb // 2
    base = jnp.where(rel > 0, nb, 0)
    n = jnp.abs(rel)
    large = max_exact + (jnp.log(jnp.maximum(n, 1).astype(jnp.float32) / max_exact)
                         / math.log(REL_MAX_DIST / max_exact) * (nb - max_exact)).astype(jnp.int32)
    large = jnp.minimum(large, nb - 1)
    return base + jnp.where(n < max_exact, n, large)


def diff_attention(x, w_q, lam_q1, lam_k1, lam_q2, lam_k2, g_sub, w_out, k1, k2, v, rel_table, lambda_init):
    B, S, _ = x.shape
    nb = S // Q_BLOCK
    q1, q2 = jnp.split(x @ w_q, 2, axis=-1)

    def blocks(t):
        return t.reshape(B, nb, Q_BLOCK, DIFF_HEADS, DIFF_DH).transpose(1, 0, 3, 2, 4)

    lam = (jnp.exp(jnp.sum(lam_q1 * lam_k1)) - jnp.exp(jnp.sum(lam_q2 * lam_k2)) + lambda_init).astype(jnp.float32)
    kpos = jnp.arange(S)
    scale = DIFF_DH ** -0.5

    def attend(args):
        i, q1b, q2b = args
        qpos = i * Q_BLOCK + jnp.arange(Q_BLOCK)
        bias = rel_table[rel_bucket(kpos[None, :] - qpos[:, None])].transpose(2, 0, 1).astype(jnp.float32)
        visible = (kpos[None, :] // CHUNK) <= (qpos[:, None] // CHUNK)

        def probs(qb, kk):
            s = jnp.einsum('bhqd,bhkd->bhqk', qb, kk).astype(jnp.float32) * scale + bias
            return jax.nn.softmax(jnp.where(visible, s, NEG_INF), axis=-1)

        w = probs(q1b, k1) - lam * probs(q2b, k2)
        return jnp.einsum('bhqk,bhkv->bhqv', w.astype(v.dtype), v)

    o = lax.map(attend, (jnp.arange(nb), blocks(q1), blocks(q2)))
    o = rms_norm(o, g_sub) * (1.0 - lambda_init)
    o = o.transpose(1, 0, 3, 2, 4).reshape(B, S, DIFF_HEADS * DIFF_DV)
    return o @ w_out


def hier_moe(x, w_group, b_group, w_router, b_router, w_gate, w_up, w_down):
    B, S, D = x.shape
    t = x.reshape(-1, D)
    g_logits = (t @ w_group).astype(jnp.float32) + b_group
    g_prob = jax.nn.softmax(g_logits, axis=-1)
    g_idx = jnp.argmax(g_logits, axis=-1)
    g_w = jnp.take_along_axis(g_prob, g_idx[:, None], axis=-1)
    e_logits = (t @ w_router).astype(jnp.float32).reshape(-1, MOE_GROUPS, MOE_EXPERTS_PER_GROUP) + b_router
    e_logits = jnp.take_along_axis(e_logits, g_idx[:, None, None], axis=1)[:, 0]
    top_w, top_i = lax.top_k(jax.nn.softmax(e_logits, axis=-1), MOE_TOPK)
    top_w = top_w / jnp.sum(top_w, -1, keepdims=True)
    within = jnp.sum(jax.nn.one_hot(top_i, MOE_EXPERTS_PER_GROUP, dtype=jnp.float32) * top_w[..., None], axis=1)
    combine = (jax.nn.one_hot(g_idx, MOE_GROUPS, dtype=jnp.float32)[:, :, None]
               * within[:, None, :] * g_w[:, :, None]).reshape(-1, MOE_EXPERTS).astype(t.dtype)
    y = jnp.zeros_like(t)
    for e in range(MOE_EXPERTS):
        hdn = jax.nn.silu(t @ w_gate[e]) * (t @ w_up[e])
        y = y + combine[:, e:e + 1] * (hdn @ w_down[e])
    return y.reshape(B, S, D)


def setup_inputs(seed: int = 0) -> dict:
    key = jax.random.key(seed)
    ks = jax.random.split(key, 24)

    def nrm(k, shape, scale):
        return jax.random.normal(k, shape, jnp.float32) * scale

    D = D_MODEL
    return {
        'x': nrm(ks[0], (BATCH, SEQ, D), 1.0),
        'a_w_in': nrm(ks[1], (N_A_LAYERS, D, GLA_IN), D ** -0.5),
        'a_w_gate2': nrm(ks[2], (N_A_LAYERS, GLA_GATE_RANK, GLA_HK), GLA_GATE_RANK ** -0.5),
        'a_b_gate': nrm(ks[3], (N_A_LAYERS, GLA_HK), 0.1),
        'a_g_norm': 1.0 + nrm(ks[4], (N_A_LAYERS, GLA_HV), 0.02),
        'a_w_out': nrm(ks[5], (N_A_LAYERS, GLA_HV, D), GLA_HV ** -0.5 * DEEPNORM_BETA),
        'kv_w': nrm(ks[6], (D, 2 * DIFF_QK + DIFF_HEADS * DIFF_DV), D ** -0.5),
        'b_w_q': nrm(ks[7], (N_B_LAYERS, D, 2 * DIFF_QK), D ** -0.5),
        'b_lam_q1': nrm(ks[8], (N_B_LAYERS, DIFF_DH), 0.1),
        'b_lam_k1': nrm(ks[9], (N_B_LAYERS, DIFF_DH), 0.1),
        'b_lam_q2': nrm(ks[10], (N_B_LAYERS, DIFF_DH), 0.1),
        'b_lam_k2': nrm(ks[11], (N_B_LAYERS, DIFF_DH), 0.1),
        'b_g_sub': 1.0 + nrm(ks[12], (N_B_LAYERS, DIFF_DV), 0.02),
        'b_w_out': nrm(ks[13], (N_B_LAYERS, DIFF_HEADS * DIFF_DV, D), (DIFF_HEADS * DIFF_DV) ** -0.5 * DEEPNORM_BETA),
        'rel_table': nrm(ks[14], (REL_BUCKETS, DIFF_HEADS), 0.2),
        'moe_w_group': nrm(ks[15], (DEPTH, D, MOE_GROUPS), D ** -0.5),
        'moe_b_group': nrm(ks[16], (DEPTH, MOE_GROUPS), 0.01),
        'moe_w_router': nrm(ks[17], (DEPTH, D, MOE_EXPERTS), D ** -0.5),
        'moe_b_router': nrm(ks[18], (DEPTH, MOE_GROUPS, MOE_EXPERTS_PER_GROUP), 0.01),
        'moe_w_gate': nrm(ks[19], (DEPTH, MOE_EXPERTS, D, MOE_FF), D ** -0.5),
        'moe_w_up': nrm(ks[20], (DEPTH, MOE_EXPERTS, D, MOE_FF), D ** -0.5),
        'moe_w_down': nrm(ks[21], (DEPTH, MOE_EXPERTS, MOE_FF, D), MOE_FF ** -0.5 * DEEPNORM_BETA),
        'ln_g': 1.0 + nrm(ks[22], (DEPTH, 2, D), 0.02),
        'ln_b': nrm(ks[23], (DEPTH, 2, D), 0.02),
    }


def reference(x, a_w_in, a_w_gate2, a_b_gate, a_g_norm, a_w_out, kv_w, b_w_q, b_lam_q1, b_lam_k1,
              b_lam_q2, b_lam_k2, b_g_sub, b_w_out, rel_table, moe_w_group, moe_b_group, moe_w_router,
              moe_b_router, moe_w_gate, moe_w_up, moe_w_down, ln_g, ln_b):
    h = x
    k1 = k2 = v = None
    for layer in range(DEPTH):
        if layer < N_A_LAYERS:
            mix = gla_mixer(h, a_w_in[layer], a_w_gate2[layer], a_b_gate[layer], a_g_norm[layer], a_w_out[layer])
        else:
            j = layer - N_A_LAYERS
            lambda_init = 0.8 - 0.6 * math.exp(-0.3 * layer)
            mix = diff_attention(h, b_w_q[j], b_lam_q1[j], b_lam_k1[j], b_lam_q2[j], b_lam_k2[j], b_g_sub[j],
                                 b_w_out[j], k1, k2, v, rel_table, lambda_init)
        h = layer_norm(DEEPNORM_ALPHA * h + mix, ln_g[layer, 0], ln_b[layer, 0])
        ffn = hier_moe(h, moe_w_group[layer], moe_b_group[layer], moe_w_router[layer], moe_b_router[layer],
                       moe_w_gate[layer], moe_w_up[layer], moe_w_down[layer])
        h = layer_norm(DEEPNORM_ALPHA * h + ffn, ln_g[layer, 1], ln_b[layer, 1])
        if layer == N_A_LAYERS - 1:
            k1, k2, v = shared_kv(h, kv_w)
    return h
```

```cpp
#include <hip/hip_runtime.h>
#include <cstdio>
#include <cstdint>
#include <cmath>

typedef unsigned short bf16_t;
typedef short bf16x8 __attribute__((ext_vector_type(8)));
typedef float f32x4 __attribute__((ext_vector_type(4)));
typedef float f32x2 __attribute__((ext_vector_type(2)));

constexpr int NB = 2, SEQ = 16384, T = NB * SEQ, D = 1024;
constexpr int CHUNK = 64, NCH = SEQ / CHUNK;
constexpr int GH = 4, GDK = 128, GDV = 256, GHK = 512, GHV = 1024, GIN = 3088, GQKVR = 3072;
constexpr int AH = 8, ADH = 64, ADV = 128;
constexpr int NE = 16, FF = 512;
constexpr int NSLOT = 2 * T + NE * 256;
constexpr float ALPHA = 1.6817928305074290f;
constexpr float LN_EPS = 1e-5f;

constexpr size_t al256(size_t x) { return (x + 255) & ~(size_t)255; }
constexpr size_t WS_CTL = 0;
constexpr size_t CTL_BYTES = 1u << 20;
constexpr size_t WS_WIN = WS_CTL + CTL_BYTES;
constexpr size_t WS_WOA = WS_WIN + (size_t)2 * GQKVR * D * 2;
constexpr size_t WS_WKV = WS_WOA + (size_t)2 * D * D * 2;
constexpr size_t WS_WQ = WS_WKV + (size_t)2048 * D * 2;
constexpr size_t WS_WOB = WS_WQ + (size_t)2 * D * D * 2;
constexpr size_t WS_WGU = WS_WOB + (size_t)2 * D * D * 2;
constexpr size_t WS_WD = WS_WGU + (size_t)4 * NE * 1024 * D * 2;
constexpr size_t WS_HB = WS_WD + (size_t)4 * NE * D * FF * 2;
constexpr size_t WS_R1 = WS_HB + (size_t)T * D * 2;
constexpr size_t WS_MIX = WS_R1 + (size_t)T * GQKVR * 2;
constexpr size_t WS_LR = WS_MIX + (size_t)T * D * 2;
constexpr size_t WS_DEC = WS_LR + (size_t)T * 16 * 4;
constexpr size_t WS_LIST = WS_DEC + (size_t)NB * NCH * GHK * 4;
constexpr size_t WS_TOKE = WS_LIST + (size_t)NE * T * 4;
constexpr size_t WS_TOKP = WS_TOKE + (size_t)T * 2 * 4;
constexpr size_t WS_TOKW = WS_TOKP + (size_t)T * 2 * 4;
constexpr size_t WS_END = WS_TOKW + (size_t)T * 2 * 4;
static_assert(WS_TOKP == WS_TOKE + (size_t)T * 2 * 4 && WS_TOKW == WS_TOKP + (size_t)T * 2 * 4, "the row phase reads tok_e | tok_pos | tok_w as one array");
constexpr size_t WS_HBUF = WS_R1;
constexpr size_t WS_YSLOT = WS_R1 + al256((size_t)NSLOT * FF * 2);
static_assert(WS_YSLOT + (size_t)NSLOT * D * 2 <= WS_LR, "MoE overlay fits R1|MIX");
constexpr size_t WS_QB = WS_R1;
constexpr size_t WS_OB = WS_R1 + (size_t)T * D * 2;
constexpr int CW_CNT = 64;

__device__ __forceinline__ float bf2f(bf16_t v) { return __uint_as_float(((unsigned)v) << 16); }
__device__ __forceinline__ bf16_t f2bf(float f) { return __builtin_bit_cast(bf16_t, (__bf16)f); }
__device__ __forceinline__ float wave_sum(float v) {
#pragma unroll
    for (int o = 1; o < 64; o <<= 1) v += __shfl_xor(v, o);
    return v;
}
__device__ __forceinline__ float silu_f(float x) { return x * __builtin_amdgcn_rcpf(1.f + __expf(-x)); }

struct RowArgs {
    int mode;
    int pad0;
    const float* x; bf16_t* hb; bf16_t* hb_out; const bf16_t* mix; const bf16_t* Y;
    const float* ln_g; const float* ln_b;
    const float* w_group; const float* b_group; const float* w_router; const float* b_router;
    int* cnt; int* list; int* tok_e; int* tok_pos; float* tok_w;
    const float* lr_w; float* lr_out;
    float* out;
};

constexpr int ROW_LDS_W = 36 * 1024 * 4;
constexpr int ROW_LDS_BYTES = ROW_LDS_W + 4096;

template <int O> __device__ __forceinline__ float xor_get(float v, int lane) {
    if constexpr (O == 32) { const auto rr = __builtin_amdgcn_permlane32_swap(__float_as_uint(v), __float_as_uint(v), false, false); return __uint_as_float(lane < 32 ? rr[1] : rr[0]); }
    else return __int_as_float(__builtin_amdgcn_ds_swizzle(__float_as_int(v), (O << 10) | 0x1f));
}
template <int O> __device__ __forceinline__ float xor_add(float v) {
    if constexpr (O == 32) { const auto rr = __builtin_amdgcn_permlane32_swap(__float_as_uint(v), __float_as_uint(v), false, false); return __uint_as_float(rr[0]) + __uint_as_float(rr[1]); }
    else return v + __int_as_float(__builtin_amdgcn_ds_swizzle(__float_as_int(v), (O << 10) | 0x1f));
}
template <int N, int MASK> __device__ __forceinline__ void halve_step(float* a, int lane) {
    const bool up = (lane & MASK) != 0;
#pragma unroll
    for (int i = 0; i < N / 2; ++i) { const float send = up ? a[i] : a[N / 2 + i], keep = up ? a[N / 2 + i] : a[i]; a[i] = keep + xor_get<MASK>(send, lane); }
}
#define ROW_SUM4(x) do { _Pragma("unroll") for (int rr = 0; rr < 4; ++rr) x[rr] = xor_add<1>(x[rr]); _Pragma("unroll") for (int rr = 0; rr < 4; ++rr) x[rr] = xor_add<2>(x[rr]); \
    _Pragma("unroll") for (int rr = 0; rr < 4; ++rr) x[rr] = xor_add<4>(x[rr]); _Pragma("unroll") for (int rr = 0; rr < 4; ++rr) x[rr] = xor_add<8>(x[rr]); \
    _Pragma("unroll") for (int rr = 0; rr < 4; ++rr) x[rr] = xor_add<16>(x[rr]); _Pragma("unroll") for (int rr = 0; rr < 4; ++rr) x[rr] = xor_add<32>(x[rr]); } while (0)
typedef unsigned u32x2_nt __attribute__((ext_vector_type(2)));
__device__ __forceinline__ ushort4 ld_nt8(const bf16_t* p) { const u32x2_nt v = __builtin_nontemporal_load((const u32x2_nt*)p); ushort4 r; r.x = (unsigned short)v[0]; r.y = (unsigned short)(v[0] >> 16); r.z = (unsigned short)v[1]; r.w = (unsigned short)(v[1] >> 16); return r; }
__device__ __forceinline__ int wt_idx(int jj, int c) { return ((((jj >> 1) * 4 + (c >> 8)) * 2 + ((c >> 1) & 1)) * 256) + 4 * ((c >> 2) & 63) + (c & 1) * 2 + (jj & 1); }
template <int NTHR, int NDOT> __device__ __forceinline__ void row_phase(const RowArgs& a, unsigned char* lds_raw, int nblocks, int bid, int tid) {
    float* Wt = (float*)lds_raw;
    float* GB = Wt + 24 * 1024;
    int* lcnt = (int*)(lds_raw + ROW_LDS_W);
    int* lbase = lcnt + 16;
    int* offs = lbase + 16;
    int* ent = offs + 16;
    constexpr int nthr = NTHR, nw = NTHR / 64; const int lane = tid & 63, wave = tid >> 6;
    bf16_t* const hbo = a.hb_out ? a.hb_out : a.hb;
    const int rows_per_block = T / nblocks;
    if (a.mode == 1) {
        for (int i = tid; i < 1024 * 4; i += nthr) { const int c = i >> 2, j = i & 3; Wt[wt_idx(j, c)] = a.w_group[i]; }
        for (int i = tid; i < 1024 * 16; i += nthr) { const int c = i >> 4, j = i & 15; Wt[wt_idx(4 + j, c)] = a.w_router[i]; }
        if (tid < 16) lcnt[tid] = 0;
    } else if (a.lr_w) {
        for (int i = tid; i < 1024 * 16; i += nthr) { const int c = i >> 4, j = i & 15; Wt[wt_idx(j, c)] = a.lr_w[(size_t)c * GIN + j]; }
    }
    if (a.mode != 0) for (int i = tid; i < 2048; i += nthr) GB[i] = i < 1024 ? a.ln_g[i] : a.ln_b[i - 1024];
    int offv = 0;
    if (a.mode == 2) { const int myc = a.cnt[lane & (NE - 1)]; int o = 0;
#pragma unroll
        for (int e = 0; e < NE; ++e) { if (lane == e) offv = o; o += (__builtin_amdgcn_readlane(myc, e) + 255) & ~255; } }
    __syncthreads();
    const int iters = rows_per_block / (nw * 4);
    for (int it = 0; it < iters; ++it) {
        const int lr0 = (it * nw + wave) * 4;
        const size_t rowb = ((size_t)it * nblocks + bid) * (nw * 4) + wave * 4;
        float v[4][16];
        if (a.mode == 0) {
            f32x4 xr[4][4];
#pragma unroll
            for (int rr = 0; rr < 4; ++rr)
#pragma unroll
                for (int i = 0; i < 4; ++i) xr[rr][i] = __builtin_nontemporal_load((const f32x4*)(a.x + (rowb + rr) * D + 256 * i + 4 * lane));
#pragma unroll
            for (int rr = 0; rr < 4; ++rr)
#pragma unroll
                for (int i = 0; i < 4; ++i) { v[rr][4 * i] = xr[rr][i][0]; v[rr][4 * i + 1] = xr[rr][i][1]; v[rr][4 * i + 2] = xr[rr][i][2]; v[rr][4 * i + 3] = xr[rr][i][3]; }
        } else {
            ushort4 hr[4][4], ar[4][4], br[4][4]; float w0[4], w1[4];
            const bf16_t* pa[4]; const bf16_t* pb[4];
            if (a.mode == 1) {
#pragma unroll
                for (int rr = 0; rr < 4; ++rr) { pa[rr] = a.mix + (rowb + rr) * D; pb[rr] = pa[rr]; w0[rr] = 1.f; w1[rr] = 0.f; }
            } else {
                const int k_ = (lane >> 3) > 2 ? 2 : (lane >> 3); const int m = a.tok_e[(size_t)k_ * (2 * T) + rowb * 2 + (lane & 7)];
#pragma unroll
                for (int rr = 0; rr < 4; ++rr) { const int e0 = __builtin_amdgcn_readlane(m, 2 * rr), e1 = __builtin_amdgcn_readlane(m, 2 * rr + 1), p0 = __builtin_amdgcn_readlane(m, 8 + 2 * rr), p1 = __builtin_amdgcn_readlane(m, 9 + 2 * rr);
                    w0[rr] = __int_as_float(__builtin_amdgcn_readlane(m, 16 + 2 * rr)); w1[rr] = __int_as_float(__builtin_amdgcn_readlane(m, 17 + 2 * rr));
                    pa[rr] = a.Y + (size_t)(__builtin_amdgcn_readlane(offv, e0) + p0) * D; pb[rr] = a.Y + (size_t)(__builtin_amdgcn_readlane(offv, e1) + p1) * D; }
            }
#pragma unroll
            for (int rr = 0; rr < 4; ++rr)
#pragma unroll
                for (int i = 0; i < 4; ++i) { hr[rr][i] = *(const ushort4*)(a.hb + (rowb + rr) * D + 256 * i + 4 * lane); ar[rr][i] = ld_nt8(pa[rr] + 256 * i + 4 * lane);
                    if (a.mode == 2) br[rr][i] = ld_nt8(pb[rr] + 256 * i + 4 * lane); }
#pragma unroll
            for (int rr = 0; rr < 4; ++rr) { __builtin_amdgcn_sched_barrier(0);
#pragma unroll
                for (int i = 0; i < 4; ++i) {
                    v[rr][4 * i] = ALPHA * bf2f(hr[rr][i].x) + w0[rr] * bf2f(ar[rr][i].x); v[rr][4 * i + 1] = ALPHA * bf2f(hr[rr][i].y) + w0[rr] * bf2f(ar[rr][i].y);
                    v[rr][4 * i + 2] = ALPHA * bf2f(hr[rr][i].z) + w0[rr] * bf2f(ar[rr][i].z); v[rr][4 * i + 3] = ALPHA * bf2f(hr[rr][i].w) + w0[rr] * bf2f(ar[rr][i].w);
                    if (a.mode == 2) { v[rr][4 * i] += w1[rr] * bf2f(br[rr][i].x); v[rr][4 * i + 1] += w1[rr] * bf2f(br[rr][i].y); v[rr][4 * i + 2] += w1[rr] * bf2f(br[rr][i].z); v[rr][4 * i + 3] += w1[rr] * bf2f(br[rr][i].w); } } }
            __builtin_amdgcn_sched_barrier(0);
            float mu[4], rstd[4];
#pragma unroll
            for (int rr = 0; rr < 4; ++rr) { float s = 0.f;
#pragma unroll
                for (int i = 0; i < 16; ++i) s += v[rr][i];
                mu[rr] = s; }
            ROW_SUM4(mu);
#pragma unroll
            for (int rr = 0; rr < 4; ++rr) { mu[rr] *= (1.f / D); float q = 0.f;
#pragma unroll
                for (int i = 0; i < 16; ++i) { v[rr][i] -= mu[rr]; q += v[rr][i] * v[rr][i]; }
                rstd[rr] = q; }
            ROW_SUM4(rstd);
#pragma unroll
            for (int rr = 0; rr < 4; ++rr) rstd[rr] = rsqrtf(rstd[rr] * (1.f / D) + LN_EPS);
#pragma unroll
            for (int i = 0; i < 4; ++i) { int gl = 4 * lane; asm volatile("" : "+v"(gl));
                const f32x4 gg = *(const f32x4*)(GB + 256 * i + gl), bb = *(const f32x4*)(GB + 1024 + 256 * i + gl);
#pragma unroll
                for (int rr = 0; rr < 4; ++rr)
#pragma unroll
                    for (int qd = 0; qd < 4; ++qd) v[rr][4 * i + qd] = v[rr][4 * i + qd] * rstd[rr] * gg[qd] + bb[qd]; }
        }
#pragma unroll
        for (int rr = 0; rr < 4; ++rr)
#pragma unroll
            for (int i = 0; i < 4; ++i) { ushort4 t; t.x = f2bf(v[rr][4 * i]); t.y = f2bf(v[rr][4 * i + 1]); t.z = f2bf(v[rr][4 * i + 2]); t.w = f2bf(v[rr][4 * i + 3]);
                if (!a.out) *(ushort4*)(hbo + (rowb + rr) * D + 256 * i + 4 * lane) = t;
                if (a.out) { f32x4 o; o[0] = v[rr][4 * i]; o[1] = v[rr][4 * i + 1]; o[2] = v[rr][4 * i + 2]; o[3] = v[rr][4 * i + 3]; __builtin_nontemporal_store(o, (f32x4*)(a.out + (rowb + rr) * D + 256 * i + 4 * lane)); } }
        if constexpr (NDOT == 20) {
            float* res = Wt + 32 * 1024 + wave * 80;
            const int nb = ((lane >> 5) & 1) * 8 + ((lane >> 4) & 1) * 4 + ((lane >> 3) & 1) * 2 + ((lane >> 2) & 1);
#define ROW_FMA4(T_, RR, I, WA, WB) do { T_ = __builtin_elementwise_fma((f32x2){v[RR][4 * (I)], v[RR][4 * (I)]}, (f32x2){WA[0], WA[1]}, T_); T_ = __builtin_elementwise_fma((f32x2){v[RR][4 * (I) + 1], v[RR][4 * (I) + 1]}, (f32x2){WA[2], WA[3]}, T_); \
                T_ = __builtin_elementwise_fma((f32x2){v[RR][4 * (I) + 2], v[RR][4 * (I) + 2]}, (f32x2){WB[0], WB[1]}, T_); T_ = __builtin_elementwise_fma((f32x2){v[RR][4 * (I) + 3], v[RR][4 * (I) + 3]}, (f32x2){WB[2], WB[3]}, T_); } while (0)
#define ROW_RED16(X, SLOT) do { halve_step<16, 32>(X, lane); halve_step<8, 16>(X, lane); halve_step<4, 8>(X, lane); halve_step<2, 4>(X, lane); X[0] = xor_add<2>(X[0]); X[0] = xor_add<1>(X[0]); \
                if ((lane & 3) == 0) res[(SLOT) + nb] = X[0]; asm volatile("s_waitcnt lgkmcnt(0)" ::: "memory"); } while (0)
            f32x2 g2[8];
#pragma unroll
            for (int n = 0; n < 8; ++n) g2[n] = (f32x2){0.f, 0.f};
#pragma unroll
            for (int i = 0; i < 4; ++i)
#pragma unroll
                for (int jp = 0; jp < 2; ++jp) { const f32x4 wa = *(const f32x4*)(Wt + ((jp * 4 + i) * 2) * 256 + 4 * lane), wb = *(const f32x4*)(Wt + ((jp * 4 + i) * 2 + 1) * 256 + 4 * lane);
#pragma unroll
                    for (int rr = 0; rr < 4; ++rr) ROW_FMA4(g2[rr * 2 + jp], rr, i, wa, wb); }
            float ga[16];
#pragma unroll
            for (int n = 0; n < 8; ++n) { ga[2 * n] = g2[n][0]; ga[2 * n + 1] = g2[n][1]; }
            ROW_RED16(ga, 0);
            int gi[4];
            const float bg0 = a.b_group[0], bg1 = a.b_group[1], bg2 = a.b_group[2], bg3 = a.b_group[3];
#pragma unroll
            for (int rr = 0; rr < 4; ++rr) { const f32x4 t = *(const f32x4*)(res + 4 * rr); const float gl[4] = {t[0] + bg0, t[1] + bg1, t[2] + bg2, t[3] + bg3};
                int g_ = 0; float gm = gl[0];
#pragma unroll
                for (int j = 1; j < 4; ++j) if (gl[j] > gm) { gm = gl[j]; g_ = j; }
                gi[rr] = g_; }
            f32x2 e2[8];
#pragma unroll
            for (int n = 0; n < 8; ++n) e2[n] = (f32x2){0.f, 0.f};
#pragma unroll
            for (int rr = 0; rr < 4; ++rr) { const float* wr_ = Wt + (2 + 2 * gi[rr]) * 2048 + 4 * lane;
#pragma unroll
                for (int i = 0; i < 4; ++i)
#pragma unroll
                    for (int q = 0; q < 2; ++q) { const f32x4 wa = *(const f32x4*)(wr_ + q * 2048 + (i * 2) * 256), wb = *(const f32x4*)(wr_ + q * 2048 + (i * 2 + 1) * 256);
                        ROW_FMA4(e2[rr * 2 + q], rr, i, wa, wb); } }
            float ea[16];
#pragma unroll
            for (int n = 0; n < 8; ++n) { ea[2 * n] = e2[n][0]; ea[2 * n + 1] = e2[n][1]; }
            ROW_RED16(ea, 16);
#undef ROW_FMA4
#undef ROW_RED16
            if (lane < 4) {
                const f32x4 tg = *(const f32x4*)(res + 4 * lane), te = *(const f32x4*)(res + 16 + 4 * lane);
                const float gl[4] = {tg[0] + bg0, tg[1] + bg1, tg[2] + bg2, tg[3] + bg3};
                int gq = 0; float gm = gl[0];
#pragma unroll
                for (int j = 1; j < 4; ++j) if (gl[j] > gm) { gm = gl[j]; gq = j; }
                float gs = 0.f;
#pragma unroll
                for (int j = 0; j < 4; ++j) gs += __expf(gl[j] - gm);
                const float gw = 1.f / gs;
                float l4[4];
#pragma unroll
                for (int j = 0; j < 4; ++j) l4[j] = te[j] + a.b_router[gq * 4 + j];
                int ia = 0; float la = l4[0];
#pragma unroll
                for (int j = 1; j < 4; ++j) if (l4[j] > la) { la = l4[j]; ia = j; }
                int ib = -1; float lb = -3.0e38f;
#pragma unroll
                for (int j = 0; j < 4; ++j) if (j != ia && l4[j] > lb) { lb = l4[j]; ib = j; }
                const float eb = __expf(lb - la), wa = 1.f / (1.f + eb), wb = eb / (1.f + eb);
                const int e1 = gq * 4 + ia, e2_ = gq * 4 + ib;
                const int p1 = atomicAdd(&lcnt[e1], 1), p2 = atomicAdd(&lcnt[e2_], 1);
                const int lrow = lr0 + lane; const size_t row = rowb + lane;
                ent[lrow * 4 + 0] = e1; ent[lrow * 4 + 1] = p1; ent[lrow * 4 + 2] = e2_; ent[lrow * 4 + 3] = p2;
                a.tok_e[row * 2] = e1; a.tok_e[row * 2 + 1] = e2_; a.tok_w[row * 2] = gw * wa; a.tok_w[row * 2 + 1] = gw * wb;
            }
        } else if constexpr (NDOT > 0) {
            constexpr int NV = 4 * NDOT, NP = NDOT / 2;
            f32x2 acc2[4 * NP];
#pragma unroll
            for (int n = 0; n < 4 * NP; ++n) acc2[n] = (f32x2){0.f, 0.f};
#pragma unroll
            for (int i = 0; i < 4; ++i) {
#pragma unroll
                for (int jp = 0; jp < NP; ++jp) { const f32x4 wa = *(const f32x4*)(Wt + ((jp * 4 + i) * 2) * 256 + 4 * lane), wb = *(const f32x4*)(Wt + ((jp * 4 + i) * 2 + 1) * 256 + 4 * lane);
#pragma unroll
                    for (int rr = 0; rr < 4; ++rr) { f32x2 t = acc2[rr * NP + jp];
                        t = __builtin_elementwise_fma((f32x2){v[rr][4 * i], v[rr][4 * i]}, (f32x2){wa[0], wa[1]}, t); t = __builtin_elementwise_fma((f32x2){v[rr][4 * i + 1], v[rr][4 * i + 1]}, (f32x2){wa[2], wa[3]}, t);
                        t = __builtin_elementwise_fma((f32x2){v[rr][4 * i + 2], v[rr][4 * i + 2]}, (f32x2){wb[0], wb[1]}, t); t = __builtin_elementwise_fma((f32x2){v[rr][4 * i + 3], v[rr][4 * i + 3]}, (f32x2){wb[2], wb[3]}, t);
                        acc2[rr * NP + jp] = t; }
                    asm volatile("" : "+v"(acc2[jp]), "+v"(acc2[NP + jp]), "+v"(acc2[2 * NP + jp]), "+v"(acc2[3 * NP + jp]) :: "memory"); }
            }
            float acc[NV];
#pragma unroll
            for (int n = 0; n < 4 * NP; ++n) { acc[2 * n] = acc2[n][0]; acc[2 * n + 1] = acc2[n][1]; }
            halve_step<NV, 32>(acc, lane); halve_step<NV / 2, 16>(acc, lane); halve_step<NV / 4, 8>(acc, lane); halve_step<NV / 8, 4>(acc, lane);
            constexpr int NR = NV / 16;
#pragma unroll
            for (int i = 0; i < NR; ++i) { acc[i] = xor_add<2>(acc[i]); acc[i] = xor_add<1>(acc[i]); }
            float* res = Wt + 32 * 1024 + wave * 80;
            if ((lane & 3) == 0) { const int nb = ((lane >> 5) & 1) * (NV / 2) + ((lane >> 4) & 1) * (NV / 4) + ((lane >> 3) & 1) * (NV / 8) + ((lane >> 2) & 1) * (NV / 16);
#pragma unroll
                for (int i = 0; i < NR; ++i) res[nb + i] = acc[i]; }
            asm volatile("s_waitcnt lgkmcnt(0)" ::: "memory");
            if (a.mode != 1) {
                if (lane < NV) a.lr_out[rowb * 16 + lane] = res[lane];
            } else if (lane < 4) {
                const float* rp = res + lane * NDOT;
                float gl[4], el[16];
#pragma unroll
                for (int j = 0; j < 4; ++j) gl[j] = rp[j] + a.b_group[j];
#pragma unroll
                for (int j = 0; j < 16; ++j) el[j] = rp[4 + j] + a.b_router[j];
                int gi = 0; float gm = gl[0];
#pragma unroll
                for (int j = 1; j < 4; ++j) if (gl[j] > gm) { gm = gl[j]; gi = j; }
                float gs = 0.f;
#pragma unroll
                for (int j = 0; j < 4; ++j) gs += __expf(gl[j] - gm);
                const float gw = 1.f / gs;
                float l4[4];
#pragma unroll
                for (int j = 0; j < 4; ++j) l4[j] = gi == 0 ? el[j] : gi == 1 ? el[4 + j] : gi == 2 ? el[8 + j] : el[12 + j];
                int ia = 0; float la = l4[0];
#pragma unroll
                for (int j = 1; j < 4; ++j) if (l4[j] > la) { la = l4[j]; ia = j; }
                int ib = -1; float lb = -3.0e38f;
#pragma unroll
                for (int j = 0; j < 4; ++j) if (j != ia && l4[j] > lb) { lb = l4[j]; ib = j; }
                const float eb = __expf(lb - la), wa = 1.f / (1.f + eb), wb = eb / (1.f + eb);
                const int e1 = gi * 4 + ia, e2 = gi * 4 + ib;
                const int p1 = atomicAdd(&lcnt[e1], 1), p2 = atomicAdd(&lcnt[e2], 1);
                const int lrow = lr0 + lane; const size_t row = rowb + lane;
                ent[lrow * 4 + 0] = e1; ent[lrow * 4 + 1] = p1; ent[lrow * 4 + 2] = e2; ent[lrow * 4 + 3] = p2;
                a.tok_e[row * 2] = e1; a.tok_e[row * 2 + 1] = e2; a.tok_w[row * 2] = gw * wa; a.tok_w[row * 2 + 1] = gw * wb;
            }
        }
    }
    if (a.mode == 1) {
        __syncthreads();
        if (tid < 16) lbase[tid] = atomicAdd(&a.cnt[tid], lcnt[tid]);
        __syncthreads();
        for (int r = tid; r < rows_per_block; r += nthr) {
            const int e1 = ent[r * 4], p1 = lbase[e1] + ent[r * 4 + 1], e2 = ent[r * 4 + 2], p2 = lbase[e2] + ent[r * 4 + 3];
            const int tok = ((r / (nw * 4)) * nblocks + bid) * (nw * 4) + (r % (nw * 4));
            a.list[(size_t)e1 * T + p1] = tok; a.list[(size_t)e2 * T + p2] = tok;
            a.tok_pos[tok * 2] = p1; a.tok_pos[tok * 2 + 1] = p2;
        }
    }
    __syncthreads();
}

__device__ __forceinline__ int rel_bucket_dev(int rel) {
    const int n = rel < 0 ? -rel : rel; int bk;
    if (n < 8) bk = n; else if (n >= 128) bk = 15; else { const int x = (n * n) >> 6; bk = 8 + (31 - __clz(x)); if (bk > 15) bk = 15; }
    return (rel > 0 ? 16 : 0) + bk;
}
namespace pg8 {
#define PG8_LAS __attribute__((address_space(3)))
typedef unsigned u32x4 __attribute__((ext_vector_type(4)));
typedef unsigned u32x2 __attribute__((ext_vector_type(2)));
constexpr int BM = 256, BK = 64, HALF = 128, HTB = HALF * BK * 2, STAGE_BYTES = 8 * HTB, NXCD = 8, WGM = 8;
__host__ __device__ __forceinline__ int lds_byte(int r, int c) { const int st = (r >> 4) * 2 + (c >> 5), rr = r & 15, cc = c & 31, ob = rr * 64 + cc * 2; return st * 1024 + (ob ^ (((ob >> 9) & 1) << 5)); }
__host__ __device__ __forceinline__ void stage_rc(int b, int& R, int& C) { const int st = b / 1024, sb = b % 1024, swz = sb ^ (((sb >> 9) & 1) << 5); R = (st >> 1) * 16 + swz / 64; C = (st & 1) * 32 + (swz % 64) / 2; }
__host__ __device__ __forceinline__ int perm32(int rho) { const int n = rho >> 4, i = rho & 15; return 8 * (i >> 2) + 4 * n + (i & 3); }

struct Unit { int pn, e, arow, orow, cnt; };
struct Gemm { const bf16_t* A; const bf16_t* Bt; int lda, ldb, K; size_t bt_estride; };

struct DenseOrder {
    int nM, nN, nwg, G, c;
    __device__ __forceinline__ void init(int M, int N, int G_, int c_) { nM = M / BM; nN = N / BM; nwg = nM * nN; G = G_; c = c_; }
    __device__ __forceinline__ bool next(int i, Unit& u) const {
        const long L = (long)i * G + c; if (L >= nwg) return false;
        int wgid = (int)L; { const int q = nwg / NXCD, r = nwg % NXCD, xcd = wgid % NXCD, off = wgid / NXCD; wgid = (xcd < r ? xcd * (q + 1) : r * (q + 1) + (xcd - r) * q) + off; }
        const int nig = WGM * nN, gid = wgid / nig, fm = gid * WGM, gsz = (nM - fm) < WGM ? (nM - fm) : WGM;
        const int pm = fm + ((wgid % nig) % gsz); u.pn = (wgid % nig) / gsz; u.e = 0; u.arow = pm * BM; u.orow = pm * BM; u.cnt = 0; return true;
    }
    __device__ __forceinline__ unsigned rowbyte(const Unit& u, int r, int lda) const { return (unsigned)(u.arow + r) * (unsigned)lda * 2u; }
};
template <bool GATHER> struct MoeOrder {
    const int* cnt; const int* list; int nN, G, c;
    __device__ __forceinline__ bool next(int i, Unit& u) const {
        const int lane = (int)__builtin_amdgcn_mbcnt_hi(~0u, __builtin_amdgcn_mbcnt_lo(~0u, 0u));
        const int myc = cnt[lane & (NE - 1)];
        const int x = c & 7, nwx = G >> 3; int L = __builtin_amdgcn_readfirstlane(i * nwx + (c >> 3)); bool found = false;
        u.pn = 0; u.e = 0; u.arow = 0; u.orow = 0; u.cnt = 0;
        int esel = -1, ce_sel = 0;
        { const int ce0 = __builtin_amdgcn_readlane(myc, x), nu0 = ((ce0 + 255) >> 8) * nN;
          if (L < nu0) { esel = x; ce_sel = ce0; }
          else { L -= nu0; const int ce1 = __builtin_amdgcn_readlane(myc, x + 8), nu1 = ((ce1 + 255) >> 8) * nN; if (L < nu1) { esel = x + 8; ce_sel = ce1; } } }
        if (esel >= 0) { int off = 0;
#pragma unroll
            for (int e = 0; e < NE; ++e) { const int nt = (__builtin_amdgcn_readlane(myc, e) + 255) >> 8; if (e < esel) off += nt * BM; }
            const int pm = L / nN; u.pn = L - pm * nN; u.e = esel; u.arow = pm * BM; u.orow = off + pm * BM; u.cnt = ce_sel; found = true; }
        return found;
    }
    __device__ __forceinline__ unsigned rowbyte(const Unit& u, int r, int lda) const {
        if (GATHER) { const int li = u.arow + r; const int tok = li < u.cnt ? list[(size_t)u.e * T + li] : 0; return (unsigned)tok * (unsigned)lda * 2u; }
        return (unsigned)(u.orow + r) * (unsigned)lda * 2u;
    }
};

__device__ __forceinline__ unsigned cvt_pk_bf16(float lo, float hi) { unsigned r; asm volatile("v_cvt_pk_bf16_f32 %0, %1, %2" : "=v"(r) : "v"(lo), "v"(hi)); return r; }
struct EpiBf16 {
    static constexpr bool PERM = true;
    bf16_t* O; int ldc;
    __device__ __forceinline__ void operator()(const f32x4 (&acc)[2][2][4][2], const Unit& u, int wr, int wc, int fr, int fq) const {
        const int row0 = u.orow + wr * 64 + fr, col0 = u.pn * BM + wc * 32 + 8 * fq;
#pragma unroll
        for (int ai = 0; ai < 2; ++ai)
#pragma unroll
            for (int m = 0; m < 4; ++m) { bf16_t* rowp = O + (size_t)(row0 + ai * HALF + m * 16) * ldc + col0;
#pragma unroll
                for (int bj = 0; bj < 2; ++bj) { const f32x4 v0 = acc[ai][bj][m][0], v1 = acc[ai][bj][m][1];
                    u32x4 w; w.x = cvt_pk_bf16(v0[0], v0[1]); w.y = cvt_pk_bf16(v0[2], v0[3]); w.z = cvt_pk_bf16(v1[0], v1[1]); w.w = cvt_pk_bf16(v1[2], v1[3]);
                    *(u32x4*)(rowp + bj * HALF) = w; } }
    }
};
struct EpiSwiglu {
    static constexpr bool PERM = false;
    bf16_t* O; int ldc;
    __device__ __forceinline__ void operator()(const f32x4 (&acc)[2][2][4][2], const Unit& u, int wr, int wc, int fr, int fq) const {
        const int row0 = u.orow + wr * 64 + fr, col0 = u.pn * (BM / 2) + wc * 16 + 4 * fq;
#pragma unroll
        for (int ai = 0; ai < 2; ++ai)
#pragma unroll
            for (int m = 0; m < 4; ++m) { bf16_t* rowp = O + (size_t)(row0 + ai * HALF + m * 16) * ldc + col0;
#pragma unroll
                for (int bj = 0; bj < 2; ++bj) { const f32x4 g = acc[ai][bj][m][0], v = acc[ai][bj][m][1];
                    u32x2 w; w.x = cvt_pk_bf16(silu_f(g[0]) * v[0], silu_f(g[1]) * v[1]); w.y = cvt_pk_bf16(silu_f(g[2]) * v[2], silu_f(g[3]) * v[3]);
                    *(u32x2*)(rowp + bj * (HALF / 2)) = w; } }
    }
};

template <class Epi, class Sched>
__device__ __forceinline__ void gemm_phase(PG8_LAS unsigned char* lds, const Gemm g, const Sched& S, const Epi& E, int tid) {
    const int wid = __builtin_amdgcn_readfirstlane(tid >> 6), lane = tid & 63, wr = wid >> 2, wc = wid & 3, fr = lane & 15, fq = lane >> 4;
    const int K = g.K, nt = K / BK;
    unsigned voffB[2];
#pragma unroll
    for (int i = 0; i < 2; ++i) { int R, C; stage_rc(tid * 16 + i * 8192, R, C); const int Rb = Epi::PERM ? ((R & ~31) + perm32(R & 31)) : R;
        voffB[i] = (unsigned)(Rb * g.ldb + C) * 2u; }
    const size_t kstep = (size_t)(BK * 2);
    const size_t hstepB = (size_t)HALF * g.ldb * 2, tstepB = 2 * hstepB;
    const unsigned ldsw = (unsigned)wid * 1024u;
    const int aoff = lds_byte(wr * 64 + fr, fq * 8), boff = lds_byte(wc * 32 + fr, fq * 8);
#define PG8_SA(b, h) (((b) * 2 + (h)) * HTB)
#define PG8_SB(b, h) ((4 + (b) * 2 + (h)) * HTB)
#define PG8_STAGE(bufoff, gbase, voff) do { _Pragma("unroll") for (int _i = 0; _i < 2; ++_i) \
        __builtin_amdgcn_global_load_lds((const unsigned*)((const char*)(gbase) + (voff)[_i]), (PG8_LAS unsigned*)(lds + (bufoff) + ldsw + _i * 8192), 16, 0, 0); } while (0)
#define PG8_LDA(dst, b, h) do { _Pragma("unroll") for (int m = 0; m < 4; ++m) _Pragma("unroll") for (int k = 0; k < 2; ++k) dst[m][k] = *(const PG8_LAS bf16x8*)(lds + PG8_SA(b, h) + aoff + m * 2048 + k * 1024); } while (0)
#define PG8_LDB(dst, b, h) do { _Pragma("unroll") for (int n = 0; n < 2; ++n) _Pragma("unroll") for (int k = 0; k < 2; ++k) dst[n][k] = *(const PG8_LAS bf16x8*)(lds + PG8_SB(b, h) + boff + n * 2048 + k * 1024); } while (0)
#define PG8_MMA(ai, bj, At, Bt) do { __builtin_amdgcn_s_setprio(1); _Pragma("unroll") for (int m = 0; m < 4; ++m) _Pragma("unroll") for (int n = 0; n < 2; ++n) _Pragma("unroll") for (int k = 0; k < 2; ++k) \
        acc[ai][bj][m][n] = __builtin_amdgcn_mfma_f32_16x16x32_bf16(Bt[n][k], At[m][k], acc[ai][bj][m][n], 0, 0, 0); __builtin_amdgcn_s_setprio(0); } while (0)
#define PG8_WAIT_V(n) asm volatile("s_waitcnt vmcnt(" #n ")" ::: "memory")
#define PG8_WAIT_L(n) asm volatile("s_waitcnt lgkmcnt(" #n ")" ::: "memory")
#define PG8_BAR __builtin_amdgcn_s_barrier()
#define PG8_SCHED __builtin_amdgcn_sched_barrier(0)
#define PG8_ROWS(dst, u) do { int _t = tid; asm volatile("" : "+v"(_t)); _Pragma("unroll") for (int _i = 0; _i < 2; ++_i) { int _R, _C; stage_rc(_t * 16 + _i * 8192, _R, _C); \
        _Pragma("unroll") for (int _h = 0; _h < 2; ++_h) dst[_h][_i] = S.rowbyte(u, _h * HALF + _R, g.lda) + (unsigned)(_C * 2); } } while (0)
    Unit cur, nxt; int ui = 0;
    if (!S.next(0, cur)) return;
    f32x4 acc[2][2][4][2];
#pragma unroll
    for (int a = 0; a < 2; ++a)
#pragma unroll
        for (int b = 0; b < 2; ++b)
#pragma unroll
            for (int m = 0; m < 4; ++m)
#pragma unroll
                for (int n = 0; n < 2; ++n) acc[a][b][m][n] = (f32x4){0.f, 0.f, 0.f, 0.f};
    bf16x8 At[4][2], B0[2][2], B1[2][2];
    unsigned cvA[2][2], nvA[2][2];
    PG8_ROWS(cvA, cur);
    const char* const gA = (const char*)g.A;
    const char* cB = (const char*)g.Bt + (size_t)cur.e * g.bt_estride * 2 + (size_t)cur.pn * tstepB;
    PG8_STAGE(PG8_SB(0, 0), cB, voffB); PG8_STAGE(PG8_SB(0, 1), cB + hstepB, voffB); PG8_STAGE(PG8_SA(0, 0), gA, cvA[0]); PG8_STAGE(PG8_SA(0, 1), gA, cvA[1]);
    if (wr == 1) PG8_BAR;
    PG8_WAIT_V(2); PG8_BAR;
    PG8_STAGE(PG8_SB(1, 0), cB + kstep, voffB); PG8_STAGE(PG8_SA(1, 0), gA + kstep, cvA[0]); PG8_STAGE(PG8_SB(1, 1), cB + hstepB + kstep, voffB);
    PG8_WAIT_V(6); PG8_BAR;
    for (;;) {
        const bool has_next = S.next(ui + 1, nxt);
        const char* nB = has_next ? (const char*)g.Bt + (size_t)nxt.e * g.bt_estride * 2 + (size_t)nxt.pn * tstepB : cB;
        if (has_next) { PG8_ROWS(nvA, nxt); }
        else {
#pragma unroll
            for (int _h = 0; _h < 2; ++_h)
#pragma unroll
                for (int _i = 0; _i < 2; ++_i) nvA[_h][_i] = cvA[_h][_i];
        }
        for (int t = 0; t < nt; t += 2) {
            const bool last = (t == nt - 2);
            const char* a1 = gA + (size_t)(t + 1) * kstep;
            const char* a2 = last ? gA : gA + (size_t)(t + 2) * kstep; const char* b2 = last ? nB : cB + (size_t)(t + 2) * kstep;
            const char* a3 = a2 + kstep; const char* b3 = b2 + kstep;
            PG8_LDB(B0, 0, 0); PG8_LDB(B1, 0, 1); PG8_SCHED; PG8_LDA(At, 0, 0); PG8_STAGE(PG8_SA(1, 1), a1, cvA[1]);
            PG8_WAIT_V(8); PG8_WAIT_L(0); PG8_BAR; PG8_MMA(0, 0, At, B0); PG8_MMA(0, 1, At, B1); PG8_BAR; PG8_SCHED;
            PG8_LDA(At, 0, 1); PG8_STAGE(PG8_SB(0, 0), b2, voffB); PG8_STAGE(PG8_SB(0, 1), b2 + hstepB, voffB); if (last) PG8_STAGE(PG8_SA(0, 0), a2, nvA[0]); else PG8_STAGE(PG8_SA(0, 0), a2, cvA[0]);
            PG8_WAIT_V(8); PG8_WAIT_L(0); PG8_BAR; PG8_MMA(1, 0, At, B0); PG8_MMA(1, 1, At, B1); PG8_BAR; PG8_SCHED;
            PG8_LDB(B0, 1, 0); PG8_LDB(B1, 1, 1); PG8_SCHED; PG8_LDA(At, 1, 0); if (last) PG8_STAGE(PG8_SA(0, 1), a2, nvA[1]); else PG8_STAGE(PG8_SA(0, 1), a2, cvA[1]);
            PG8_WAIT_V(8); PG8_WAIT_L(0); PG8_BAR; PG8_MMA(0, 0, At, B0); PG8_MMA(0, 1, At, B1); PG8_BAR; PG8_SCHED;
            PG8_LDA(At, 1, 1); PG8_STAGE(PG8_SB(1, 0), b3, voffB); PG8_STAGE(PG8_SB(1, 1), b3 + hstepB, voffB); if (last) PG8_STAGE(PG8_SA(1, 0), a3, nvA[0]); else PG8_STAGE(PG8_SA(1, 0), a3, cvA[0]);
            PG8_WAIT_V(8); PG8_WAIT_L(0); PG8_BAR; PG8_MMA(1, 0, At, B0); PG8_MMA(1, 1, At, B1); PG8_BAR; PG8_SCHED;
        }
        if (wr == 0) PG8_BAR;
        E(acc, cur, wr, wc, fr, fq);
        if (!has_next) break;
#pragma unroll
        for (int a = 0; a < 2; ++a)
#pragma unroll
            for (int b = 0; b < 2; ++b)
#pragma unroll
                for (int m = 0; m < 4; ++m)
#pragma unroll
                    for (int n = 0; n < 2; ++n) acc[a][b][m][n] = (f32x4){0.f, 0.f, 0.f, 0.f};
        cur = nxt; cB = nB; ++ui;
#pragma unroll
        for (int _h = 0; _h < 2; ++_h)
#pragma unroll
            for (int _i = 0; _i < 2; ++_i) cvA[_h][_i] = nvA[_h][_i];
        if (wr == 1) PG8_BAR;
    }
    PG8_WAIT_V(0);
    PG8_BAR;
#undef PG8_SA
#undef PG8_SB
#undef PG8_STAGE
#undef PG8_LDA
#undef PG8_LDB
#undef PG8_MMA
#undef PG8_WAIT_V
#undef PG8_WAIT_L
#undef PG8_BAR
#undef PG8_SCHED
#undef PG8_ROWS
}
}

namespace att {
using s16x4  = __attribute__((ext_vector_type(4))) short;
using f32x16 = __attribute__((ext_vector_type(16))) float;
using f32x2  = __attribute__((ext_vector_type(2))) float;
using u32x4  = __attribute__((ext_vector_type(4))) unsigned;
constexpr int NW = 8, QBLK = 32, KVBLK = 64, LDKV = 2048, LDQ = 1024;
constexpr int SHM_V = KVBLK * ADV * 2, SHM_K = KVBLK * ADH * 2;
constexpr int OFF_V = 0, OFF_K = 4 * SHM_V, OFF_WS = OFF_K + 4 * SHM_K, OFF_LUT = OFF_WS + NW * 64 * 4, LDS_ATT = OFF_LUT + 1024;
constexpr float LOG2E = 1.4426950408889634f, THR2 = 8.f * LOG2E;
#define KSWZ64(row, colB) ((row) * 128 + ((colB) ^ ((((row) >> 1) & 7) << 4)))
#define SBAR() __builtin_amdgcn_sched_barrier(0)
__device__ __forceinline__ int crow(int r, int hi) { return (r & 3) + 8 * (r >> 2) + 4 * hi; }
typedef __bf16 bf2_t __attribute__((ext_vector_type(2)));
__device__ __forceinline__ unsigned cvtpk(float lo, float hi) { const f32x2 v = {lo, hi}; return __builtin_bit_cast(unsigned, __builtin_convertvector(v, bf2_t)); }

__device__ __forceinline__ void sm_max0(const f32x16& p0, float& pmax) {
  pmax = p0[0];
#pragma unroll
  for (int r = 1; r < 16; ++r) pmax = fmaxf(pmax, p0[r]);
}
__device__ __forceinline__ void sm_decide(f32x16& p0, f32x16& p1, float& pmax, float& m_reg, float& alpha, f32x16& ct) {
#pragma unroll
  for (int r = 0; r < 16; ++r) pmax = fmaxf(pmax, p1[r]);
  { auto rr = __builtin_amdgcn_permlane32_swap(__float_as_uint(pmax), __float_as_uint(pmax), false, false);
    pmax = fmaxf(__uint_as_float(rr[0]), __uint_as_float(rr[1])); }
  if (__builtin_expect(__all(pmax <= THR2), 1)) { alpha = 1.f; }
  else { const float d = fmaxf(pmax, 0.f); alpha = __builtin_amdgcn_exp2f(-d); m_reg += d;
#pragma unroll
    for (int r = 0; r < 16; ++r) { p0[r] -= d; p1[r] -= d; ct[r] -= d; } }
}
__device__ __forceinline__ void sm_exp(f32x16& p) {
#pragma unroll
  for (int r = 0; r < 16; ++r) p[r] = __builtin_amdgcn_exp2f(p[r]);
}
__device__ __forceinline__ void sm_first(f32x16& p0, f32x16& p1, float& m_reg) {
  float pmax; sm_max0(p0, pmax);
#pragma unroll
  for (int r = 0; r < 16; ++r) pmax = fmaxf(pmax, p1[r]);
  { auto rr = __builtin_amdgcn_permlane32_swap(__float_as_uint(pmax), __float_as_uint(pmax), false, false);
    pmax = fmaxf(__uint_as_float(rr[0]), __uint_as_float(rr[1])); }
  m_reg = pmax;
#pragma unroll
  for (int r = 0; r < 16; ++r) { p0[r] = __builtin_amdgcn_exp2f(p0[r] - pmax); p1[r] = __builtin_amdgcn_exp2f(p1[r] - pmax); }
}
__device__ __forceinline__ void finishSM(const f32x16& p0, const f32x16& p1, float alpha, float& l_reg, bf16x8& pa0, bf16x8& pa1, bf16x8& pa2, bf16x8& pa3) {
  f32x2 a = {p0[0], p0[1]}, b = {p0[2], p0[3]};
#pragma unroll
  for (int r = 4; r < 16; r += 4) { a += (f32x2){p0[r], p0[r + 1]}; b += (f32x2){p0[r + 2], p0[r + 3]}; }
#pragma unroll
  for (int r = 0; r < 16; r += 4) { a += (f32x2){p1[r], p1[r + 1]}; b += (f32x2){p1[r + 2], p1[r + 3]}; }
  float ps = (a[0] + a[1]) + (b[0] + b[1]);
  { auto rr = __builtin_amdgcn_permlane32_swap(__float_as_uint(ps), __float_as_uint(ps), false, false);
    ps = __uint_as_float(rr[0]) + __uint_as_float(rr[1]); }
  l_reg = l_reg * alpha + ps;
#define PK4(P, BASE, OUT) do { u32x4 w = {cvtpk(P[BASE + 0], P[BASE + 1]), cvtpk(P[BASE + 2], P[BASE + 3]), cvtpk(P[BASE + 4], P[BASE + 5]), cvtpk(P[BASE + 6], P[BASE + 7])}; OUT = *reinterpret_cast<bf16x8*>(&w); } while (0)
  PK4(p0, 0, pa0); PK4(p0, 8, pa1); PK4(p1, 0, pa2); PK4(p1, 8, pa3);
#undef PK4
}
#ifndef ATT_BIGSUM_LOG2
#define ATT_BIGSUM_LOG2 17.5f
#endif
template <int H> __device__ __forceinline__ void sm_exp8(f32x16& p) {
#pragma unroll
  for (int r = 8 * H; r < 8 * H + 8; ++r) p[r] = __builtin_amdgcn_exp2f(p[r]);
}
__device__ __forceinline__ float sm_rowsum(const f32x16& p0, const f32x16& p1) {
  f32x2 a = {p0[0], p0[1]}, b = {p0[2], p0[3]};
#pragma unroll
  for (int r = 4; r < 16; r += 4) { a += (f32x2){p0[r], p0[r + 1]}; b += (f32x2){p0[r + 2], p0[r + 3]}; }
#pragma unroll
  for (int r = 0; r < 16; r += 4) { a += (f32x2){p1[r], p1[r + 1]}; b += (f32x2){p1[r + 2], p1[r + 3]}; }
  float ps = (a[0] + a[1]) + (b[0] + b[1]);
  { auto rr = __builtin_amdgcn_permlane32_swap(__float_as_uint(ps), __float_as_uint(ps), false, false);
    ps = __uint_as_float(rr[0]) + __uint_as_float(rr[1]); }
  return ps;
}
__device__ __forceinline__ void sm_pack(const f32x16& p0, const f32x16& p1, bf16x8& pa0, bf16x8& pa1, bf16x8& pa2, bf16x8& pa3) {
#define PK4(P, BASE, OUT) do { u32x4 w = {cvtpk(P[BASE + 0], P[BASE + 1]), cvtpk(P[BASE + 2], P[BASE + 3]), cvtpk(P[BASE + 4], P[BASE + 5]), cvtpk(P[BASE + 6], P[BASE + 7])}; OUT = *reinterpret_cast<bf16x8*>(&w); } while (0)
  PK4(p0, 0, pa0); PK4(p0, 8, pa1); PK4(p1, 0, pa2); PK4(p1, 8, pa3);
#undef PK4
}
template <int MODE> __device__ __forceinline__ void qk_mma(f32x16& p0, f32x16& p1, const f32x16& ct, const bf16x8* b0, const bf16x8* b1, const bf16x8* qr) {
#pragma unroll
  for (int d0 = 0; d0 < 4; ++d0) {
    if (MODE == 0 && d0 == 0) { p0 = __builtin_amdgcn_mfma_f32_32x32x16_bf16(b0[0], qr[0], ct, 0, 0, 0); p1 = __builtin_amdgcn_mfma_f32_32x32x16_bf16(b1[0], qr[0], ct, 0, 0, 0); }
    else { p0 = __builtin_amdgcn_mfma_f32_32x32x16_bf16(b0[d0], qr[d0], p0, 0, 0, 0); p1 = __builtin_amdgcn_mfma_f32_32x32x16_bf16(b1[d0], qr[d0], p1, 0, 0, 0); } }
}
template <int KOFF> __device__ __forceinline__ void qkt_far(f32x16& p0, f32x16& p1, const f32x16& ct, const int* kb, const bf16x8* qr) {
  bf16x8 b0[4], b1[4];
#pragma unroll
  for (int d0 = 0; d0 < 4; ++d0) { b0[d0] = *(const PG8_LAS bf16x8*)(unsigned)(kb[d0] + KOFF); b1[d0] = *(const PG8_LAS bf16x8*)(unsigned)(kb[d0] + KOFF + 4096); }
  SBAR();
#pragma unroll
  for (int d0 = 0; d0 < 4; ++d0) {
    if (d0 == 0) { p0 = __builtin_amdgcn_mfma_f32_32x32x16_bf16(b0[0], qr[0], ct, 0, 0, 0); p1 = __builtin_amdgcn_mfma_f32_32x32x16_bf16(b1[0], qr[0], ct, 0, 0, 0); }
    else { p0 = __builtin_amdgcn_mfma_f32_32x32x16_bf16(b0[d0], qr[d0], p0, 0, 0, 0); p1 = __builtin_amdgcn_mfma_f32_32x32x16_bf16(b1[d0], qr[d0], p1, 0, 0, 0); } }
}
template <int MODE> __device__ __forceinline__ void qkt(f32x16& p0, f32x16& p1, const f32x16& ct, const char* Ks, const bf16x8* qr, int r32, int hi) {
  bf16x8 b0[4], b1[4];
#pragma unroll
  for (int d0 = 0; d0 < 4; ++d0) { const int cb = (d0 * 16 + hi * 8) * 2;
    b0[d0] = *reinterpret_cast<const bf16x8*>(Ks + KSWZ64(r32, cb)); b1[d0] = *reinterpret_cast<const bf16x8*>(Ks + KSWZ64(32 + r32, cb)); }
  SBAR();
#pragma unroll
  for (int d0 = 0; d0 < 4; ++d0) {
    if (MODE == 0 && d0 == 0) { p0 = __builtin_amdgcn_mfma_f32_32x32x16_bf16(b0[0], qr[0], ct, 0, 0, 0); p1 = __builtin_amdgcn_mfma_f32_32x32x16_bf16(b1[0], qr[0], ct, 0, 0, 0); }
    else { p0 = __builtin_amdgcn_mfma_f32_32x32x16_bf16(b0[d0], qr[d0], p0, 0, 0, 0); p1 = __builtin_amdgcn_mfma_f32_32x32x16_bf16(b1[d0], qr[d0], p1, 0, 0, 0); } }
}
__device__ __forceinline__ void p_init(f32x16& p0, f32x16& p1, int j, int cq, int qoff, int hi, const float* lut, float m_reg) {
  if (j > cq) {
#pragma unroll
    for (int r = 0; r < 16; ++r) { p0[r] = -1e30f; p1[r] = -1e30f; }
  } else {
    const float* lp = lut + (64 * (j - cq) - qoff + 192 + 4 * hi);
#pragma unroll
    for (int r = 0; r < 16; ++r) { p0[r] = lp[(r & 3) + 8 * (r >> 2)] - m_reg; p1[r] = lp[32 + (r & 3) + 8 * (r >> 2)] - m_reg; }
  }
}
#define QK_TILE(p0, p1, j, Ks) do { if ((j) < cq - 2) qkt<0>(p0, p1, ct, Ks, qr, r32, hi); else { p_init(p0, p1, j, cq, qoff, hi, lut, m_reg); qkt<1>(p0, p1, ct, Ks, qr, r32, hi); } } while (0)
__device__ __forceinline__ int v_st(int k, int c) { const int kk = (k & ~0xC) | ((k & 4) << 1) | ((k & 8) >> 1); return ((kk >> 3) * 4 + (c >> 5)) * 512 + ((kk & 7) * 32 + (c & 31)) * 2; }
__device__ __forceinline__ int v_rd_base(int lane) { return ((lane & 3) << 3) | (((lane >> 2) & 3) << 6) | (((lane >> 4) & 1) << 5) | (((lane >> 5) & 1) << 11); }
constexpr int v_rd_off(int d0, int ks, int half) { return d0 * 512 + ks * 4096 + half * 256; }
template <int OFF> __device__ __forceinline__ s16x4 tr_read(int vb) {
  s16x4 r; asm volatile("ds_read_b64_tr_b16 %0, %1 offset:%2" : "=&v"(r) : "v"(vb), "i"(OFF) : "memory"); return r;
}
struct VFrag { s16x4 l0, h0, l1, h1, l2, h2, l3, h3; };
template <int D0, int SOFF = 0> __device__ __forceinline__ void pv_load(VFrag& f, int vb) {
  f.l0 = tr_read<SOFF + v_rd_off(D0, 0, 0)>(vb); f.h0 = tr_read<SOFF + v_rd_off(D0, 0, 1)>(vb); f.l1 = tr_read<SOFF + v_rd_off(D0, 1, 0)>(vb); f.h1 = tr_read<SOFF + v_rd_off(D0, 1, 1)>(vb);
  f.l2 = tr_read<SOFF + v_rd_off(D0, 2, 0)>(vb); f.h2 = tr_read<SOFF + v_rd_off(D0, 2, 1)>(vb); f.l3 = tr_read<SOFF + v_rd_off(D0, 3, 0)>(vb); f.h3 = tr_read<SOFF + v_rd_off(D0, 3, 1)>(vb);
}
__device__ __forceinline__ void pv_mma(f32x16& od, const VFrag& f, bf16x8 pa0, bf16x8 pa1, bf16x8 pa2, bf16x8 pa3) {
#define PK(L, H) (bf16x8){L[0], L[1], L[2], L[3], H[0], H[1], H[2], H[3]}
  od = __builtin_amdgcn_mfma_f32_32x32x16_bf16(pa0, PK(f.l0, f.h0), od, 0, 0, 0);
  od = __builtin_amdgcn_mfma_f32_32x32x16_bf16(pa1, PK(f.l1, f.h1), od, 0, 0, 0);
  od = __builtin_amdgcn_mfma_f32_32x32x16_bf16(pa2, PK(f.l2, f.h2), od, 0, 0, 0);
  od = __builtin_amdgcn_mfma_f32_32x32x16_bf16(pa3, PK(f.l3, f.h3), od, 0, 0, 0);
#undef PK
}
#define PV_LGK(n) do { asm volatile("s_waitcnt lgkmcnt(" #n ")" ::: "memory"); SBAR(); } while (0)
#define PV_PRE(vb) VFrag fA_, fB_; pv_load<0>(fA_, vb); pv_load<1>(fB_, vb)
#define PV_PRE_S(SO) VFrag fA_, fB_; pv_load<0, SO>(fA_, vb0); pv_load<1, SO>(fB_, vb0)
#define PV_WITH_SM_S(o, SO, pa0, pa1, pa2, pa3, q0, q1) do { \
    PV_LGK(8); pv_mma(o[0], fA_, pa0, pa1, pa2, pa3); sm_exp8<0>(q0); asm volatile("" : "+v"(q0)); \
    pv_load<2, SO>(fA_, vb0); PV_LGK(8); pv_mma(o[1], fB_, pa0, pa1, pa2, pa3); sm_exp8<1>(q0); asm volatile("" : "+v"(q0)); \
    pv_load<3, SO>(fB_, vb0); PV_LGK(8); pv_mma(o[2], fA_, pa0, pa1, pa2, pa3); sm_exp8<0>(q1); asm volatile("" : "+v"(q1)); \
    PV_LGK(0); pv_mma(o[3], fB_, pa0, pa1, pa2, pa3); sm_exp8<1>(q1); asm volatile("" : "+v"(q1)); } while (0)
#define PV_WITH_SM(o, vb, pa0, pa1, pa2, pa3, q0, q1) do { \
    PV_LGK(8); pv_mma(o[0], fA_, pa0, pa1, pa2, pa3); sm_exp8<0>(q0); asm volatile("" : "+v"(q0)); \
    pv_load<2>(fA_, vb); PV_LGK(8); pv_mma(o[1], fB_, pa0, pa1, pa2, pa3); sm_exp8<1>(q0); asm volatile("" : "+v"(q0)); \
    pv_load<3>(fB_, vb); PV_LGK(8); pv_mma(o[2], fA_, pa0, pa1, pa2, pa3); sm_exp8<0>(q1); asm volatile("" : "+v"(q1)); \
    PV_LGK(0); pv_mma(o[3], fB_, pa0, pa1, pa2, pa3); sm_exp8<1>(q1); asm volatile("" : "+v"(q1)); } while (0)
#define PV_A(o, vb, pa0, pa1, pa2, pa3, q0, q1) do { \
    PV_LGK(8); pv_mma(o[0], fA_, pa0, pa1, pa2, pa3); sm_exp8<0>(q0); asm volatile("" : "+v"(q0)); \
    pv_load<2>(fA_, vb); PV_LGK(8); pv_mma(o[1], fB_, pa0, pa1, pa2, pa3); sm_exp8<1>(q0); asm volatile("" : "+v"(q0)); \
    pv_load<3>(fB_, vb); PV_LGK(8); pv_mma(o[2], fA_, pa0, pa1, pa2, pa3); sm_exp8<0>(q1); asm volatile("" : "+v"(q1)); } while (0)
#define PV_A_S(o, SO, pa0, pa1, pa2, pa3, q0, q1) do { \
    PV_LGK(8); pv_mma(o[0], fA_, pa0, pa1, pa2, pa3); sm_exp8<0>(q0); asm volatile("" : "+v"(q0)); \
    pv_load<2, SO>(fA_, vb0); PV_LGK(8); pv_mma(o[1], fB_, pa0, pa1, pa2, pa3); sm_exp8<1>(q0); asm volatile("" : "+v"(q0)); \
    pv_load<3, SO>(fB_, vb0); PV_LGK(8); pv_mma(o[2], fA_, pa0, pa1, pa2, pa3); sm_exp8<0>(q1); asm volatile("" : "+v"(q1)); } while (0)
#define PV_B(o, pa0, pa1, pa2, pa3, q1) do { PV_LGK(8); pv_mma(o[3], fB_, pa0, pa1, pa2, pa3); sm_exp8<1>(q1); asm volatile("" : "+v"(q1)); } while (0)
#define PV_ONLY(o, vb, pa0, pa1, pa2, pa3) do { \
    PV_LGK(8); pv_mma(o[0], fA_, pa0, pa1, pa2, pa3); pv_load<2>(fA_, vb); PV_LGK(8); pv_mma(o[1], fB_, pa0, pa1, pa2, pa3); \
    pv_load<3>(fB_, vb); PV_LGK(8); pv_mma(o[2], fA_, pa0, pa1, pa2, pa3); PV_LGK(0); pv_mma(o[3], fB_, pa0, pa1, pa2, pa3); } while (0)

__device__ __forceinline__ void attn_unit(const int FIN, const bf16_t* __restrict__ Qb, const bf16_t* __restrict__ Kh, const bf16_t* __restrict__ Vh, bf16_t* __restrict__ Ob, float* __restrict__ park,
                                                             float lam, const float* __restrict__ g_sub, float gscale, int qb, char* lds, int tid) {
  const int wid = __builtin_amdgcn_readfirstlane(tid >> 6), lane = tid & 63, r32 = lane & 31, hi = lane >> 5;
  char* V_lds = lds + OFF_V; char* K_lds = lds + OFF_K;
  float* ws = (float*)(lds + OFF_WS) + wid * 64; float* li_l = ws; float* al_l = ws + 32;
  const float* lut = (const float*)(lds + OFF_LUT);
  const float cfar = lut[0];
  const int cq = 4 * qb + (wid >> 1), qoff = 32 * (wid & 1) + r32;
  float m_reg = 0.f, l_reg = 0; f32x16 o[4] = {}; bf16x8 qr[4]; f32x16 ct;
  const bf16_t* Qw = Qb + (size_t)(wid * QBLK + r32) * LDQ + hi * 8;
#pragma unroll
  for (int d0 = 0; d0 < 4; ++d0) qr[d0] = *reinterpret_cast<const bf16x8*>(Qw + d0 * 16);
  const int kq = wid * 64 + lane, krow = kq >> 3, kcs = (kq & 7) ^ ((krow >> 1) & 7);
  const unsigned kgb = (unsigned)(krow * LDKV + kcs * 8) * 2u;
  unsigned vgb[2];
#pragma unroll
  for (int i = 0; i < 2; ++i) { const int P = ((i * 8 + wid) * 64 + lane) * 16, sub = P >> 9, rem = P & 511, kk = (sub >> 2) * 8 + (rem >> 6), c = (sub & 3) * 32 + ((rem & 63) >> 1);
    const int k = (kk & ~0xC) | ((kk & 4) << 1) | ((kk & 8) >> 1); vgb[i] = (unsigned)(k * LDKV + c) * 2u; }
  const __amdgpu_buffer_rsrc_t krs = __builtin_amdgcn_make_buffer_rsrc((void*)Kh, 0, 0x08000000, 0x00020000), vrs = __builtin_amdgcn_make_buffer_rsrc((void*)Vh, 0, 0x08000000, 0x00020000);
  const int vb0 = (int)(uintptr_t)V_lds + v_rd_base(lane);
  PG8_LAS unsigned char* const ldsl = (PG8_LAS unsigned char*)lds;
#define GLDK(t) do { const unsigned so_ = (unsigned)(t) * (unsigned)(KVBLK * LDKV * 2); \
    __builtin_amdgcn_raw_ptr_buffer_load_lds(krs, (PG8_LAS void*)(ldsl + OFF_K + ((t) & 3) * SHM_K + wid * 1024), 16, kgb, so_, 0, 0); } while (0)
#define GLDV(t) do { const unsigned so_ = (unsigned)(t) * (unsigned)(KVBLK * LDKV * 2); const int sl_ = (t) & 3; \
    __builtin_amdgcn_raw_ptr_buffer_load_lds(vrs, (PG8_LAS void*)(ldsl + OFF_V + sl_ * SHM_V + wid * 1024), 16, vgb[0], so_, 0, 0); \
    __builtin_amdgcn_raw_ptr_buffer_load_lds(vrs, (PG8_LAS void*)(ldsl + OFF_V + sl_ * SHM_V + (8 + wid) * 1024), 16, vgb[1], so_, 0, 0); } while (0)
#define GLDK_S(t, SL) do { const unsigned so_ = (unsigned)(t) * (unsigned)(KVBLK * LDKV * 2); \
    __builtin_amdgcn_raw_ptr_buffer_load_lds(krs, (PG8_LAS void*)(ldsl + OFF_K + (SL) * SHM_K + wid * 1024), 16, kgb, so_, 0, 0); } while (0)
#define GLDV_S(t, SL) do { const unsigned so_ = (unsigned)(t) * (unsigned)(KVBLK * LDKV * 2); \
    __builtin_amdgcn_raw_ptr_buffer_load_lds(vrs, (PG8_LAS void*)(ldsl + OFF_V + (SL) * SHM_V + wid * 1024), 16, vgb[0], so_, 0, 0); \
    __builtin_amdgcn_raw_ptr_buffer_load_lds(vrs, (PG8_LAS void*)(ldsl + OFF_V + (SL) * SHM_V + (8 + wid) * 1024), 16, vgb[1], so_, 0, 0); } while (0)
#define TILE_BAR(n) do { asm volatile("s_waitcnt vmcnt(" #n ")" ::: "memory"); __builtin_amdgcn_s_barrier(); asm volatile("" ::: "memory"); } while (0)
#define RESC(a) do { if (__any((a) < 1.f)) { if (hi == 0) al_l[r32] = (a); asm volatile("s_waitcnt lgkmcnt(0)" ::: "memory"); \
    _Pragma("unroll") for (int d = 0; d < 4; ++d) _Pragma("unroll") for (int r = 0; r < 16; ++r) o[d][r] *= al_l[crow(r, hi)]; } } while (0)
  f32x16 pA0, pA1, pB0, pB1; bf16x8 pa0, pa1, pa2, pa3; const int NT = 4 * qb + 4;
  int kbl[4];
#pragma unroll
  for (int d0 = 0; d0 < 4; ++d0) { kbl[d0] = (int)(uintptr_t)K_lds + KSWZ64(r32, (d0 * 16 + hi * 8) * 2); asm volatile("" : "+v"(kbl[d0])); }
  bf16x8 kf0[4], kf1[4];
#define K_LOADR(t) do { const int ko_ = ((t) & 3) * SHM_K; _Pragma("unroll") for (int d0 = 0; d0 < 4; ++d0) { kf0[d0] = *(const PG8_LAS bf16x8*)(unsigned)(kbl[d0] + ko_); kf1[d0] = *(const PG8_LAS bf16x8*)(unsigned)(kbl[d0] + ko_ + 4096); } } while (0)
#define K_LOADS(KOFF) do { _Pragma("unroll") for (int d0 = 0; d0 < 4; ++d0) { kf0[d0] = *(const PG8_LAS bf16x8*)(unsigned)(kbl[d0] + (KOFF)); kf1[d0] = *(const PG8_LAS bf16x8*)(unsigned)(kbl[d0] + (KOFF) + 4096); } } while (0)
  GLDK(0); GLDV(0); GLDK(1); GLDV(1); TILE_BAR(3);
  K_LOADR(0);
  if (0 < cq - 2) {
#pragma unroll
    for (int r = 0; r < 16; ++r) { pA0[r] = cfar; pA1[r] = cfar; }
  } else p_init(pA0, pA1, 0, cq, qoff, hi, lut, 0.f);
  asm volatile("s_waitcnt lgkmcnt(0)" ::: "memory"); SBAR();
  qk_mma<1>(pA0, pA1, ct, kf0, kf1, qr); sm_first(pA0, pA1, m_reg);
#pragma unroll
  for (int r = 0; r < 16; ++r) ct[r] = cfar - m_reg;
  GLDK(2); GLDV(2); GLDK(3); TILE_BAR(3);
  K_LOADR(1);
#define FIN_SM(pC0, pC1, pN0, pN1, HASN) do { float ps_ = sm_rowsum(pC0, pC1); \
    if (__builtin_expect(__any(ps_ > BIGSUM), 0)) { const float d_ = ps_ > BIGSUM ? __builtin_amdgcn_logf(ps_) : 0.f, a_ = __builtin_amdgcn_exp2f(-d_); \
      m_reg += d_; ps_ *= a_; l_reg *= a_; \
      _Pragma("unroll") for (int r = 0; r < 16; ++r) { pC0[r] *= a_; pC1[r] *= a_; ct[r] -= d_; if (HASN) { pN0[r] -= d_; pN1[r] -= d_; } } \
      RESC(a_); } \
    l_reg += ps_; sm_pack(pC0, pC1, pa0, pa1, pa2, pa3); } while (0)
  const float BIGSUM = __builtin_amdgcn_exp2f(ATT_BIGSUM_LOG2);
#define FAR_STEP(pN0, pN1, pC0, pC1, T_, SK, SV) do { { SBAR(); asm volatile("s_waitcnt lgkmcnt(0)" ::: "memory"); SBAR(); qk_mma<0>(pN0, pN1, ct, kf0, kf1, qr); SBAR(); \
    PV_PRE_S((SV) * SHM_V); SBAR(); \
    FIN_SM(pC0, pC1, pN0, pN1, true); SBAR(); \
    GLDK_S((T_) + 3, ((SK) + 3) & 3); GLDV_S((T_) + 2, ((SK) + 2) & 3); SBAR(); \
    PV_A_S(o, (SV) * SHM_V, pa0, pa1, pa2, pa3, pN0, pN1); SBAR(); \
    K_LOADS((((SK) + 1) & 3) * SHM_K); SBAR(); \
    PV_B(o, pa0, pa1, pa2, pa3, pN1); } \
    TILE_BAR(3); } while (0)
  const int nfar4 = qb > 0 ? qb - 1 : 0;
#pragma unroll 1
  for (int g4 = 0; g4 < nfar4; ++g4) { const int t0_ = 4 * g4 + 1;
    FAR_STEP(pB0, pB1, pA0, pA1, t0_, 1, 0); FAR_STEP(pA0, pA1, pB0, pB1, t0_ + 1, 2, 1); FAR_STEP(pB0, pB1, pA0, pA1, t0_ + 2, 3, 2); FAR_STEP(pA0, pA1, pB0, pB1, t0_ + 3, 0, 3); }
#undef FAR_STEP
#define GEN_STEP(pN0, pN1, pC0, pC1, T_) do { const bool hk_ = (T_) + 3 < NT, hv_ = (T_) + 2 < NT; \
    { SBAR(); if ((T_) < cq - 2) { asm volatile("s_waitcnt lgkmcnt(0)" ::: "memory"); SBAR(); qk_mma<0>(pN0, pN1, ct, kf0, kf1, qr); } \
      else { p_init(pN0, pN1, T_, cq, qoff, hi, lut, m_reg); asm volatile("s_waitcnt lgkmcnt(0)" ::: "memory"); SBAR(); qk_mma<1>(pN0, pN1, ct, kf0, kf1, qr); } SBAR(); \
    PV_PRE(vb0 + (((T_) - 1) & 3) * SHM_V); SBAR(); \
    FIN_SM(pC0, pC1, pN0, pN1, true); SBAR(); \
    if (hk_) { GLDK((T_) + 3); } if (hv_) { GLDV((T_) + 2); } SBAR(); \
    PV_A(o, vb0 + (((T_) - 1) & 3) * SHM_V, pa0, pa1, pa2, pa3, pN0, pN1); SBAR(); \
    K_LOADR((T_) + 1); SBAR(); \
    PV_B(o, pa0, pa1, pa2, pa3, pN1); } \
    if (hk_ && hv_) TILE_BAR(3); else TILE_BAR(0); } while (0)
  for (int j = 4 * nfar4 + 1; j + 1 < NT; j += 2) { GEN_STEP(pB0, pB1, pA0, pA1, j); GEN_STEP(pA0, pA1, pB0, pB1, j + 1); }
#undef GEN_STEP
  { SBAR(); if ((NT - 1) < cq - 2) { asm volatile("s_waitcnt lgkmcnt(0)" ::: "memory"); SBAR(); qk_mma<0>(pB0, pB1, ct, kf0, kf1, qr); }
    else { p_init(pB0, pB1, NT - 1, cq, qoff, hi, lut, m_reg); asm volatile("s_waitcnt lgkmcnt(0)" ::: "memory"); SBAR(); qk_mma<1>(pB0, pB1, ct, kf0, kf1, qr); } SBAR();
  { PV_PRE(vb0 + ((NT - 2) & 3) * SHM_V); SBAR();
  FIN_SM(pA0, pA1, pB0, pB1, true); SBAR();
  PV_WITH_SM(o, vb0 + ((NT - 2) & 3) * SHM_V, pa0, pa1, pa2, pa3, pB0, pB1); }
  { asm volatile("s_waitcnt lgkmcnt(0)" ::: "memory"); SBAR(); PV_PRE(vb0 + ((NT - 1) & 3) * SHM_V); SBAR();
  FIN_SM(pB0, pB1, pB0, pB1, false); SBAR();
  PV_ONLY(o, vb0 + ((NT - 1) & 3) * SHM_V, pa0, pa1, pa2, pa3); } }
#undef FIN_SM
#undef K_LOADR
#undef K_LOADS
  if (hi == 0) li_l[r32] = l_reg; asm volatile("s_waitcnt lgkmcnt(0)" ::: "memory");
  float rli[16];
#pragma unroll
  for (int r = 0; r < 16; ++r) rli[r] = __builtin_amdgcn_rcpf(li_l[crow(r, hi)]);
  float* pk = park + (size_t)wid * 4096 + lane;
  if (FIN == 0) {
#pragma unroll
    for (int r = 0; r < 16; ++r)
#pragma unroll
      for (int d0 = 0; d0 < 4; ++d0) pk[(r * 4 + d0) * 64] = o[d0][r] * rli[r];
  } else {
    float ss[16];
#pragma unroll
    for (int r = 0; r < 16; ++r) { float q = 0.f;
#pragma unroll
      for (int d0 = 0; d0 < 4; ++d0) { const float x = pk[(r * 4 + d0) * 64] - lam * (o[d0][r] * rli[r]); o[d0][r] = x; q += x * x; }
      ss[r] = q; }
    halve_step<16, 16>(ss, lane); halve_step<8, 8>(ss, lane); halve_step<4, 4>(ss, lane); halve_step<2, 2>(ss, lane); ss[0] += __shfl_xor(ss[0], 1);
    if ((lane & 1) == 0) al_l[hi * 16 + ((lane >> 4) & 1) * 8 + ((lane >> 3) & 1) * 4 + ((lane >> 2) & 1) * 2 + ((lane >> 1) & 1)] = rsqrtf(ss[0] * (1.f / ADV) + LN_EPS) * gscale;
    asm volatile("s_waitcnt lgkmcnt(0)" ::: "memory");
    float gs[4];
#pragma unroll
    for (int d0 = 0; d0 < 4; ++d0) gs[d0] = g_sub[d0 * 32 + r32];
    bf16_t* Ow = Ob + (size_t)(wid * QBLK) * LDQ;
#pragma unroll
    for (int r = 0; r < 16; ++r) { const int orow = crow(r, hi); const float rs = al_l[hi * 16 + r];
#pragma unroll
      for (int d0 = 0; d0 < 4; ++d0) Ow[(size_t)orow * LDQ + d0 * 32 + r32] = f2bf(o[d0][r] * rs * gs[d0]); }
  }
  __syncthreads();
#undef GLDK
#undef GLDV
#undef GLDK_S
#undef GLDV_S
#undef TILE_BAR
#undef RESC
}
__device__ __forceinline__ void attn_phase(const bf16_t* Q, const bf16_t* KV, float* park, bf16_t* OB, const float* rel_table, const float* lq1, const float* lk1, const float* lq2, const float* lk2, const float* g_sub,
                                           float lambda_init, char* lds, int tid) {
  const int bx = blockIdx.x, xcd = bx & 7, slot = bx >> 3, combo = xcd * 2 + (slot >> 4), wi = slot & 15;
  const int h = combo & 7, b = combo >> 3, lane = tid & 63;
  float* lut = (float*)(lds + OFF_LUT);
  if (tid < 256) lut[tid] = rel_table[rel_bucket_dev(tid - 192) * AH + h] * LOG2E;
  __syncthreads();
  const float lam = __uint_as_float(__builtin_amdgcn_readfirstlane(__float_as_uint(__expf(wave_sum(lq1[lane] * lk1[lane])) - __expf(wave_sum(lq2[lane] * lk2[lane])) + lambda_init)));
  const bf16_t* K1 = KV + (size_t)b * SEQ * LDKV + h * ADH;
  const bf16_t* Vh = KV + (size_t)b * SEQ * LDKV + 1024 + h * ADV;
  float* pk = park + (size_t)bx * (NW * 4096);
#pragma unroll 1
  for (int u = 0; u < 8; ++u) {
    const int i = u >> 1, m = u & 1, g = i >> 1, qb = (i & 1) ? (32 * g + 31 - wi) : (32 * g + wi);
    const size_t row0 = (size_t)b * SEQ + (size_t)qb * 256;
    int t2 = tid; asm volatile("" : "+v"(t2));
    attn_unit(m, Q + row0 * LDQ + m * 512 + h * ADH, K1 + m * 512, Vh, OB + row0 * LDQ + h * ADV, pk, lam, g_sub, 1.f - lambda_init, qb, lds, t2);
  }
}
#undef KSWZ64
#undef SBAR
#undef QK_TILE
#undef PV_LGK
#undef PV_PRE
#undef PV_WITH_SM
#undef PV_ONLY
}

namespace gla {
using s16x4  = __attribute__((ext_vector_type(4))) short;
using f32x16 = __attribute__((ext_vector_type(16))) float;
using u32x4  = __attribute__((ext_vector_type(4))) unsigned;
typedef __bf16 bf2_t __attribute__((ext_vector_type(2)));
typedef float f2_t __attribute__((ext_vector_type(2)));
constexpr int GRP = 8, NGRP = NCH / GRP, NUNIT = NB * GH * NGRP;
constexpr int KP = 320, VP = 576, QP = 272;
constexpr int OFF_KD = 0, OFF_V = OFF_KD + 64 * KP, OFF_Q = OFF_V + 64 * VP, OFF_DEC = OFF_Q + 64 * QP, OFF_SS = OFF_DEC + 512, OFF_RS = OFF_SS + 8 * 64 * 4, LDS_GLA = OFF_RS + 256;
constexpr size_t LS_UNIT = (size_t)GDK * GDV;
__device__ __forceinline__ int crow(int r, int hi) { return (r & 3) + 8 * (r >> 2) + 4 * hi; }
__device__ __forceinline__ unsigned cvtpk2(float lo, float hi) { const f2_t v = {lo, hi}; return __builtin_bit_cast(unsigned, __builtin_convertvector(v, bf2_t)); }
template <int OFF> __device__ __forceinline__ s16x4 tr_read(int a) { s16x4 r; asm volatile("ds_read_b64_tr_b16 %0, %1 offset:%2" : "=&v"(r) : "v"(a), "i"(OFF) : "memory"); return r; }
#define GLA_PK(L, H) (bf16x8){L[0], L[1], L[2], L[3], H[0], H[1], H[2], H[3]}

template <bool WITH_O>
__device__ __forceinline__ void scan_unit(bf16_t* __restrict__ qkvr, const float* __restrict__ dec, float* __restrict__ LS, float* __restrict__ GD, const float* __restrict__ g_norm, bf16_t* __restrict__ yout, int ystride, int u, char* lds, int tid) {
  const int wid = __builtin_amdgcn_readfirstlane(tid >> 6), lane = tid & 63, r32 = lane & 31, hi = lane >> 5;
  const int g = u & (NGRP - 1), h = (u >> 5) & 3, b = u >> 7;
  const size_t tokg = (size_t)b * SEQ + (size_t)g * GRP * CHUNK;
  const int ldsb = (int)(uintptr_t)lds;
  const int i16 = lane & 15, tq = i16 >> 2, tp = i16 & 3, blk = (lane >> 4) & 1;
  const int kbase = ldsb + OFF_KD + (8 * hi + tq) * KP + (16 * blk + 4 * tp) * 2;
  const int vbase = ldsb + OFF_V + (8 * hi + tq) * VP + (32 * wid + 16 * blk + 4 * tp) * 2;
  f32x16 st[4];
  float* Lu = LS + (size_t)u * LS_UNIT;
  if (WITH_O) {
#pragma unroll
    for (int kt = 0; kt < 4; ++kt)
#pragma unroll
      for (int r = 0; r < 16; ++r) st[kt][r] = Lu[(size_t)(32 * kt + crow(r, hi)) * GDV + 32 * wid + r32];
  } else {
#pragma unroll
    for (int kt = 0; kt < 4; ++kt)
#pragma unroll
      for (int r = 0; r < 16; ++r) st[kt][r] = 0.f;
  }
  float gdec = 1.f;
  uint4 kd0, kd1, v0, v1, v2, v3, q0, q1; f32x4 dc_r;
  const int pr = tid >> 4, pc = (tid & 15) * 8;
  const int vr = tid >> 5, vc = (tid & 31) * 8;
#define GLA_LOAD(c) do { const bf16_t* gp = qkvr + (tokg + (size_t)(c) * CHUNK) * GQKVR; \
    kd0 = *(const uint4*)(gp + (size_t)pr * GQKVR + GHK + h * GDK + pc); kd1 = *(const uint4*)(gp + (size_t)(pr + 32) * GQKVR + GHK + h * GDK + pc); \
    if (WITH_O) { q0 = *(const uint4*)(gp + (size_t)pr * GQKVR + h * GDK + pc); q1 = *(const uint4*)(gp + (size_t)(pr + 32) * GQKVR + h * GDK + pc); } \
    v0 = *(const uint4*)(gp + (size_t)vr * GQKVR + 1024 + h * GDV + vc); v1 = *(const uint4*)(gp + (size_t)(vr + 16) * GQKVR + 1024 + h * GDV + vc); \
    v2 = *(const uint4*)(gp + (size_t)(vr + 32) * GQKVR + 1024 + h * GDV + vc); v3 = *(const uint4*)(gp + (size_t)(vr + 48) * GQKVR + 1024 + h * GDV + vc); \
    if (tid < 32) dc_r = *(const f32x4*)(dec + ((size_t)b * NCH + (size_t)g * GRP + (c)) * GHK + h * GDK + tid * 4); } while (0)
#define GLA_STORE() do { \
    *(uint4*)(lds + OFF_KD + pr * KP + pc * 2) = kd0; *(uint4*)(lds + OFF_KD + (pr + 32) * KP + pc * 2) = kd1; \
    if (WITH_O) { *(uint4*)(lds + OFF_Q + pr * QP + pc * 2) = q0; *(uint4*)(lds + OFF_Q + (pr + 32) * QP + pc * 2) = q1; } \
    *(uint4*)(lds + OFF_V + vr * VP + vc * 2) = v0; *(uint4*)(lds + OFF_V + (vr + 16) * VP + vc * 2) = v1; \
    *(uint4*)(lds + OFF_V + (vr + 32) * VP + vc * 2) = v2; *(uint4*)(lds + OFF_V + (vr + 48) * VP + vc * 2) = v3; \
    if (tid < 32) *(f32x4*)(lds + OFF_DEC + tid * 16) = dc_r; } while (0)
  GLA_LOAD(0);
#pragma unroll 1
  for (int c = 0; c < GRP; ++c) {
    const size_t t0 = tokg + (size_t)c * CHUNK;
    GLA_STORE();
    __syncthreads();
    if (!WITH_O && tid < 128) gdec *= ((const float*)(lds + OFF_DEC))[tid];
    if (c + 1 < GRP) GLA_LOAD(c + 1);
#pragma unroll
    for (int kt = 0; kt < 4; ++kt)
#pragma unroll
      for (int g4 = 0; g4 < 4; ++g4) { const f32x4 d = *(const f32x4*)(lds + OFF_DEC + (32 * kt + 8 * g4 + 4 * hi) * 4);
#pragma unroll
        for (int i = 0; i < 4; ++i) st[kt][4 * g4 + i] *= d[i]; }
#define GLA_STEP(S) do { const s16x4 bl = tr_read<(16 * (S)) * VP>(vbase), bh_ = tr_read<(16 * (S) + 4) * VP>(vbase); \
      const s16x4 a0l = tr_read<(16 * (S)) * KP + 0>(kbase), a0h = tr_read<(16 * (S) + 4) * KP + 0>(kbase), a1l = tr_read<(16 * (S)) * KP + 64>(kbase), a1h = tr_read<(16 * (S) + 4) * KP + 64>(kbase); \
      const s16x4 a2l = tr_read<(16 * (S)) * KP + 128>(kbase), a2h = tr_read<(16 * (S) + 4) * KP + 128>(kbase), a3l = tr_read<(16 * (S)) * KP + 192>(kbase), a3h = tr_read<(16 * (S) + 4) * KP + 192>(kbase); \
      asm volatile("s_waitcnt lgkmcnt(0)" ::: "memory"); __builtin_amdgcn_sched_barrier(0); \
      const bf16x8 bv = GLA_PK(bl, bh_); \
      st[0] = __builtin_amdgcn_mfma_f32_32x32x16_bf16(GLA_PK(a0l, a0h), bv, st[0], 0, 0, 0); st[1] = __builtin_amdgcn_mfma_f32_32x32x16_bf16(GLA_PK(a1l, a1h), bv, st[1], 0, 0, 0); \
      st[2] = __builtin_amdgcn_mfma_f32_32x32x16_bf16(GLA_PK(a2l, a2h), bv, st[2], 0, 0, 0); st[3] = __builtin_amdgcn_mfma_f32_32x32x16_bf16(GLA_PK(a3l, a3h), bv, st[3], 0, 0, 0); } while (0)
    GLA_STEP(0); GLA_STEP(1); GLA_STEP(2); GLA_STEP(3);
#undef GLA_STEP
    if (WITH_O) {
      f32x16 oa[2];
#pragma unroll
      for (int rt = 0; rt < 2; ++rt)
#pragma unroll
        for (int r = 0; r < 16; ++r) oa[rt][r] = 0.f;
#pragma unroll
      for (int kt = 0; kt < 4; ++kt)
#pragma unroll
        for (int s = 0; s < 2; ++s) {
          u32x4 pw; pw.x = cvtpk2(st[kt][8 * s + 0], st[kt][8 * s + 1]); pw.y = cvtpk2(st[kt][8 * s + 2], st[kt][8 * s + 3]); pw.z = cvtpk2(st[kt][8 * s + 4], st[kt][8 * s + 5]); pw.w = cvtpk2(st[kt][8 * s + 6], st[kt][8 * s + 7]);
          const bf16x8 bs = __builtin_bit_cast(bf16x8, pw);
#pragma unroll
          for (int rt = 0; rt < 2; ++rt) {
            const char* qp = lds + OFF_Q + (32 * rt + r32) * QP + (32 * kt + 16 * s + 4 * hi) * 2;
            const s16x4 ql = *(const s16x4*)qp, qh = *(const s16x4*)(qp + 16);
            oa[rt] = __builtin_amdgcn_mfma_f32_32x32x16_bf16(GLA_PK(ql, qh), bs, oa[rt], 0, 0, 0);
          }
        }
      float* SS = (float*)(lds + OFF_SS); float* RS = (float*)(lds + OFF_RS);
      { float x[32];
#pragma unroll
        for (int rt = 0; rt < 2; ++rt)
#pragma unroll
          for (int r = 0; r < 16; ++r) x[rt * 16 + r] = oa[rt][r] * oa[rt][r];
        halve_step<32, 16>(x, lane); halve_step<16, 8>(x, lane); halve_step<8, 4>(x, lane); halve_step<4, 2>(x, lane); halve_step<2, 1>(x, lane);
        SS[wid * 64 + 32 * (r32 >> 4) + crow(r32 & 15, hi)] = x[0]; }
      __syncthreads();
      if (tid < 64) { float s = 0.f;
#pragma unroll
        for (int w = 0; w < 8; ++w) s += SS[w * 64 + tid];
        RS[tid] = rsqrtf(s * (1.f / GDV) + LN_EPS); }
      __syncthreads();
      constexpr int YP = 528;
#pragma unroll
      for (int rt = 0; rt < 2; ++rt)
#pragma unroll
        for (int g4 = 0; g4 < 4; ++g4) { const f32x4 rs = *(const f32x4*)(RS + 32 * rt + 8 * g4 + 4 * hi);
#pragma unroll
          for (int i = 0; i < 4; ++i) *(bf16_t*)(lds + OFF_V + (32 * rt + 8 * g4 + 4 * hi + i) * YP + (32 * wid + r32) * 2) = f2bf(oa[rt][4 * g4 + i] * rs[i]); }
      __syncthreads();
#pragma unroll
      for (int i = 0; i < 4; ++i) { const int p = tid + 512 * i, tt = p >> 5, c8 = (p & 31) * 8;
        const uint4 yv = *(const uint4*)(lds + OFF_V + tt * YP + c8 * 2);
        const size_t tok = t0 + tt;
        const uint4 rv = *(const uint4*)(qkvr + tok * GQKVR + 2048 + h * GDV + c8);
        const f32x4 ga = *(const f32x4*)(g_norm + h * GDV + c8), gb = *(const f32x4*)(g_norm + h * GDV + c8 + 4);
        const unsigned yw[4] = {yv.x, yv.y, yv.z, yv.w}, rw[4] = {rv.x, rv.y, rv.z, rv.w}; unsigned ow[4];
#pragma unroll
        for (int k = 0; k < 4; ++k) { const float y0 = __uint_as_float(yw[k] << 16), y1 = __uint_as_float(yw[k] & 0xffff0000u), r0 = __uint_as_float(rw[k] << 16), r1 = __uint_as_float(rw[k] & 0xffff0000u);
          const float g0 = k < 2 ? ga[2 * k] : gb[2 * k - 4], g1 = k < 2 ? ga[2 * k + 1] : gb[2 * k - 3];
          ow[k] = cvtpk2(y0 * g0 * silu_f(r0), y1 * g1 * silu_f(r1)); }
        uint4 o4; o4.x = ow[0]; o4.y = ow[1]; o4.z = ow[2]; o4.w = ow[3];
        *(uint4*)(yout + tok * (size_t)ystride + h * GDV + c8) = o4; }
    }
    __syncthreads();
  }
  if (!WITH_O) {
#pragma unroll
    for (int kt = 0; kt < 4; ++kt)
#pragma unroll
      for (int r = 0; r < 16; ++r) Lu[(size_t)(32 * kt + crow(r, hi)) * GDV + 32 * wid + r32] = st[kt][r];
    if (tid < 128) GD[(size_t)u * GDK + tid] = gdec;
  }
#undef GLA_LOAD
#undef GLA_STORE
}
__device__ __forceinline__ void scan_groups(float* __restrict__ LS, const float* __restrict__ GD, int gtid, int nthreads) {
  for (int i = gtid; i < NB * GH * (GDK * GDV / 2); i += nthreads) {
    const int bh = i >> 14, e2 = i & 16383, k = e2 >> 7, v2 = e2 & 127;
    float* p = LS + (size_t)bh * NGRP * LS_UNIT + (size_t)k * GDV + 2 * v2;
    const float* gd = GD + (size_t)bh * NGRP * GDK + k;
    f2_t s = {0.f, 0.f};
#pragma unroll 8
    for (int g = 0; g < NGRP; ++g) { const f2_t l = *(const f2_t*)(p + (size_t)g * LS_UNIT); const float d = gd[(size_t)g * GDK];
      *(f2_t*)(p + (size_t)g * LS_UNIT) = s; s = s * d + l; }
  }
}
#undef GLA_PK
}

#define LAS __attribute__((address_space(3)))
constexpr int NWAVES = 8, NTHREADS = NWAVES * 64;
constexpr int LDS_XB = 151552;
constexpr int LDS_BYTES = LDS_XB + 256;
constexpr int CW_BAR = 4096;
constexpr int N_PHASES = 48;

#define XB_TMO      128
#define XB_XCNT(j)  (256  + 64 * (j))
#define XB_XSUB(j)  (1280 + 64 * (j))
#define XB_XGEN(j)  (2304 + 64 * (j))
#define XB_TOP      3328
#define XB_TOPGEN   3392
#define XCD_BAR_WORDS 3456
#define XB_SPIN_CAP (1u << 18)
__device__ __forceinline__ unsigned xb_ld(unsigned* p)              { return __hip_atomic_load(p, __ATOMIC_RELAXED, __HIP_MEMORY_SCOPE_AGENT); }
__device__ __forceinline__ unsigned xb_add(unsigned* p, unsigned v) { return __hip_atomic_fetch_add(p, v, __ATOMIC_RELAXED, __HIP_MEMORY_SCOPE_AGENT); }
__device__ __forceinline__ unsigned xb_xcc_id() { return (unsigned)__builtin_amdgcn_s_getreg((3 << 11) | 20) & 0xFu; }
#define XB_SPIN(cond, bar) do { unsigned _sp = 0; while (cond) { __builtin_amdgcn_s_sleep(1); \
    if ((++_sp & 255u) == 0u) { if (xb_ld(&(bar)[XB_TMO])) break; if (_sp > XB_SPIN_CAP) { atomicAdd(&(bar)[XB_TMO], 1u); break; } } } } while (0)
struct XcdBarrier { unsigned* bar; unsigned x; volatile LAS unsigned* st; };
__device__ __forceinline__ XcdBarrier xcd_barrier_post(unsigned* bar, volatile LAS unsigned* st) {
    XcdBarrier b; b.bar = bar; b.x = xb_xcc_id(); b.st = st;
    if (threadIdx.x == 0) (void)xb_add(&bar[XB_XCNT(b.x)], 1u);
    return b;
}
__device__ __forceinline__ void xcd_barrier_complete(unsigned* bar, unsigned x, unsigned& nloc, unsigned& nx) {
    const unsigned G = gridDim.x * gridDim.y * gridDim.z;
    unsigned sum, cnt, mine, sp = 0u;
    for (;;) {
        sum = 0u; cnt = 0u; mine = 0u;
#pragma unroll
        for (unsigned j = 0; j < 16; ++j) { const unsigned c = xb_ld(&bar[XB_XCNT(j)]); sum += c; cnt += (c > 0u) ? 1u : 0u; mine = (j == x) ? c : mine; }
        if (sum == G) break;
        __builtin_amdgcn_s_sleep(1);
        if ((++sp & 255u) == 0u) { if (xb_ld(&bar[XB_TMO])) break; if (sp > XB_SPIN_CAP) { atomicAdd(&bar[XB_TMO], 1u); break; } }
    }
    nloc = mine > 0u ? mine : 1u; nx = cnt > 0u ? cnt : 1u;
}
__device__ __forceinline__ void xcd_barrier(const XcdBarrier& b, int tid) {
    asm volatile("s_waitcnt vmcnt(0)" ::: "memory");
    __syncthreads();
    if (tid == 0) {
        unsigned* bar = b.bar;
        __builtin_amdgcn_s_waitcnt(0);
        unsigned nloc = b.st[0], nx = b.st[1];
        if (nloc == 0u) { xcd_barrier_complete(bar, b.x, nloc, nx); b.st[0] = nloc; b.st[1] = nx; }
        const unsigned old = xb_add(&bar[XB_XSUB(b.x)], 1u);
        const unsigned gen = old / nloc;
        if (old + 1u == (gen + 1u) * nloc) {
            __builtin_amdgcn_fence(__ATOMIC_RELEASE, "agent");
            asm volatile("s_waitcnt vmcnt(0)" ::: "memory");
            const unsigned og = xb_add(&bar[XB_TOP], 1u);
            const unsigned tg = og / nx;
            if (og + 1u == (tg + 1u) * nx) xb_add(&bar[XB_TOPGEN], 1u);
            else XB_SPIN(xb_ld(&bar[XB_TOPGEN]) == tg, bar);
            __builtin_amdgcn_fence(__ATOMIC_ACQUIRE, "agent");
            xb_add(&bar[XB_XGEN(b.x)], 1u);
            asm volatile("s_waitcnt vmcnt(0)" ::: "memory");
        } else {
            XB_SPIN(xb_ld(&bar[XB_XGEN(b.x)]) == gen, bar);
            __builtin_amdgcn_fence(__ATOMIC_ACQUIRE, "agent");
            asm volatile("s_waitcnt vmcnt(0)" ::: "memory");
        }
    }
    __syncthreads();
}

struct MArgs { const float* in[24]; float* out; unsigned char* ws; int ph_lo, ph_hi, li, pad; };

__device__ __forceinline__ unsigned pk2(float lo, float hi) { return (unsigned)f2bf(lo) | ((unsigned)f2bf(hi) << 16); }
__device__ __forceinline__ void tr_item(const float* W, int ld, int K, int N, bf16_t* WT, int rs, int roff, float scale, int nscale, float* scr, int item, int lane) {
    const int nblk = N / 32, kb = item / nblk, nb = item % nblk, k0 = 64 * kb, n0 = 32 * nb;
    const float sc = (n0 + (lane & 31)) < nscale ? scale : 1.f;
#pragma unroll 8
    for (int i = 0; i < 32; ++i) { const int kk = 2 * i + (lane >> 5); scr[kk * 33 + (lane & 31)] = __builtin_nontemporal_load(W + (size_t)(k0 + kk) * ld + n0 + (lane & 31)) * sc; }
    asm volatile("s_waitcnt lgkmcnt(0)" ::: "memory");
    const int c = lane & 7;
#pragma unroll
    for (int j = 0; j < 4; ++j) { const int n = (lane >> 3) + 8 * j; const float* s = scr + (8 * c) * 33 + n;
        uint4 o; o.x = pk2(s[0 * 33], s[1 * 33]); o.y = pk2(s[2 * 33], s[3 * 33]); o.z = pk2(s[4 * 33], s[5 * 33]); o.w = pk2(s[6 * 33], s[7 * 33]);
        const int ng = n0 + n, drow = (ng >> 4) * rs + (ng & 15) + roff;
        *(uint4*)(WT + (size_t)drow * K + k0 + 8 * c) = o; }
    asm volatile("s_waitcnt lgkmcnt(0)" ::: "memory");
}
__device__ __forceinline__ const void* ldptr(volatile LAS unsigned long long* tab, int i) { const unsigned long long v = tab[i];
    const unsigned lo = __builtin_amdgcn_readfirstlane((unsigned)v), hi = __builtin_amdgcn_readfirstlane((unsigned)(v >> 32)); return (const void*)(const __attribute__((address_space(1))) char*)(((unsigned long long)hi << 32) | lo); }
#define INP(i) ((const float*)ldptr(ptab, (i)))
__device__ __forceinline__ void ph_convert(volatile LAS unsigned long long* ptab, unsigned char* ws, unsigned char* lds, int gw, int NGW, int wave, int lane) {
    float* scr = (float*)(lds + wave * 16384);
    constexpr int I0 = 2 * 16 * 96, I1 = 2 * 16 * 32, I2 = 16 * 64, I3 = 2 * 16 * 32, I4 = 2 * 16 * 32, I5 = 64 * 16 * 16, I6 = I5, I7 = 64 * 8 * 32;
    constexpr int NIT = I0 + I1 + I2 + I3 + I4 + I5 + I6 + I7;
    for (int it = gw; it < NIT; it += NGW) {
        int r = it; const float* src; bf16_t* dst; int ld, K = D, N, rs = 16, roff = 0, nscale = 0, item; float scale = 1.f;
        if (r < I0) { const int z = r / (16 * 96); item = r % (16 * 96); src = INP(1) + (size_t)z * D * GIN; ld = GIN; N = GQKVR; dst = (bf16_t*)(ws + WS_WIN) + (size_t)z * GQKVR * D; scale = 0.08838834764831845f; nscale = 512; }
        else if ((r -= I0) < I1) { const int z = r / 512; item = r % 512; src = INP(5) + (size_t)z * D * D; ld = D; N = D; dst = (bf16_t*)(ws + WS_WOA) + (size_t)z * D * D; }
        else if ((r -= I1) < I2) { item = r; src = INP(6); ld = 2048; N = 2048; dst = (bf16_t*)(ws + WS_WKV); }
        else if ((r -= I2) < I3) { const int z = r / 512; item = r % 512; src = INP(7) + (size_t)z * D * D; ld = D; N = D; dst = (bf16_t*)(ws + WS_WQ) + (size_t)z * D * D; scale = 0.125f * 1.4426950408889634f; nscale = 1024; }
        else if ((r -= I3) < I4) { const int z = r / 512; item = r % 512; src = INP(13) + (size_t)z * D * D; ld = D; N = D; dst = (bf16_t*)(ws + WS_WOB) + (size_t)z * D * D; }
        else if ((r -= I4) < I5) { const int z = r / 256; item = r % 256; src = INP(19) + (size_t)z * D * FF; ld = FF; N = FF; dst = (bf16_t*)(ws + WS_WGU) + (size_t)z * 1024 * D; rs = 32; }
        else if ((r -= I5) < I6) { const int z = r / 256; item = r % 256; src = INP(20) + (size_t)z * D * FF; ld = FF; N = FF; dst = (bf16_t*)(ws + WS_WGU) + (size_t)z * 1024 * D; rs = 32; roff = 16; }
        else { r -= I6; const int z = r / 256; item = r % 256; src = INP(21) + (size_t)z * FF * D; ld = D; K = FF; N = D; dst = (bf16_t*)(ws + WS_WD) + (size_t)z * D * FF; }
        tr_item(src, ld, K, N, dst, rs, roff, scale, nscale, scr, item, lane);
    }
}

__device__ __forceinline__ void kdec_ref_phase(bf16_t* qkvr, const float* lr, const float* w_gate2, const float* b_gate, float* dec, unsigned char* lds, int tid) {
    float (*slr)[16] = (float (*)[16])lds;
    const int ch = tid;
    for (int bc = blockIdx.x; bc < NB * NCH; bc += gridDim.x) {
        const size_t tok0 = (size_t)bc * CHUNK;
        __syncthreads();
        for (int i = tid; i < 64 * 16; i += NTHREADS) slr[i >> 4][i & 15] = lr[tok0 * 16 + i];
        float wg[16];
#pragma unroll
        for (int j = 0; j < 16; ++j) wg[j] = w_gate2[j * GHK + ch];
        const float bg = b_gate[ch];
        __syncthreads();
        float cum[64]; float run = 0.f;
#pragma unroll
        for (int t = 0; t < 64; ++t) {
            float z = bg;
#pragma unroll
            for (int j = 0; j < 16; ++j) z += slr[t][j] * wg[j];
            const float ls = fminf(z, 0.f) - __logf(1.f + __expf(-fabsf(z)));
            run += ls * (1.f / 16.f); cum[t] = run;
        }
#pragma unroll
        for (int t = 0; t < 64; ++t) { bf16_t* kp = qkvr + (tok0 + t) * GQKVR + GHK + ch; *kp = f2bf(bf2f(*kp) * __expf(run - cum[t])); }
        dec[(size_t)bc * GHK + ch] = __expf(run);
    }
    __syncthreads();
}
constexpr size_t WS_O1 = WS_R1 + (size_t)T * D * 2, WS_O2 = WS_R1 + (size_t)2 * T * D * 2;
#define PTRS unsigned char* const ws = (unsigned char*)ldptr(ptab, 25); float* const outp = (float*)ldptr(ptab, 24); int* const CTL = (int*)(ws + WS_CTL); \
    bf16_t *WIN = (bf16_t*)(ws + WS_WIN), *WOA = (bf16_t*)(ws + WS_WOA), *WKV = (bf16_t*)(ws + WS_WKV), *WQ = (bf16_t*)(ws + WS_WQ), *WOB = (bf16_t*)(ws + WS_WOB), *WGU = (bf16_t*)(ws + WS_WGU), *WD = (bf16_t*)(ws + WS_WD); \
    bf16_t *HB = (bf16_t*)(ws + WS_HB), *R1 = (bf16_t*)(ws + WS_R1), *MIX = (bf16_t*)(ws + WS_MIX), *HBUF = (bf16_t*)(ws + WS_HBUF), *YSLOT = (bf16_t*)(ws + WS_YSLOT), *QB = (bf16_t*)(ws + WS_QB); \
    bf16_t *O1 = (bf16_t*)(ws + WS_O1), *O2 = (bf16_t*)(ws + WS_O2); float *LR = (float*)(ws + WS_LR), *DEC = (float*)(ws + WS_DEC), *TOKW = (float*)(ws + WS_TOKW); \
    int *LIST = (int*)(ws + WS_LIST), *TOKE = (int*)(ws + WS_TOKE), *TOKP = (int*)(ws + WS_TOKP); bf16_t* KV = (bf16_t*)outp; float* OBUF = outp; int* cnt = CTL + CW_CNT + 64 * l; \
    (void)WIN; (void)WOA; (void)WKV; (void)WQ; (void)WOB; (void)WGU; (void)WD; (void)HB; (void)R1; (void)MIX; (void)HBUF; (void)YSLOT; (void)QB; (void)O1; (void)O2; (void)LR; (void)DEC; (void)TOKW; (void)LIST; (void)TOKE; (void)TOKP; (void)KV; (void)OBUF; (void)cnt;
#define PHASE(id, ...) do { if ((id) >= lo && (id) < hi) { int lane; asm volatile("v_mbcnt_lo_u32_b32 %0, -1, 0\n\tv_mbcnt_hi_u32_b32 %0, -1, %0" : "=v"(lane)); const int wave = wave0, tid = wave0 * 64 + lane, gw = blockIdx.x * NWAVES + wave; (void)lane; (void)gw; PTRS \
        __VA_ARGS__; if ((id) + 1 < hi) { XcdBarrier bl = bar; asm volatile("" : "+s"(bl.bar), "+s"(bl.x)); xcd_barrier(bl, tid); } } } while (0)

template <int l> __device__ __forceinline__ void layer_phases(volatile LAS unsigned long long* const ptab, unsigned char* const lds, LAS unsigned char* const ldsl, const XcdBarrier& bar,
                                                            const int lo, const int hi, const int wave0, const int G, const int NGW) {
        const int pb = 1 + 12 * l;
        if (l < 2) {
            PHASE(pb + 0, { const pg8::Gemm g{HB, WIN + (size_t)l * GQKVR * D, D, D, D, 0}; pg8::DenseOrder S; S.init(T, GQKVR, G, (int)blockIdx.x); const pg8::EpiBf16 E{R1, GQKVR}; pg8::gemm_phase(ldsl, g, S, E, tid); });
            PHASE(pb + 1, kdec_ref_phase(R1, LR, INP(2) + (size_t)l * 16 * GHK, INP(3) + (size_t)l * GHK, DEC, lds, tid));
            PHASE(pb + 2, gla::scan_unit<false>(R1, DEC, (float*)MIX, (float*)MIX + (size_t)gla::NUNIT * gla::LS_UNIT, nullptr, nullptr, 0, (int)blockIdx.x, (char*)lds, tid));
            PHASE(pb + 3, gla::scan_groups((float*)MIX, (const float*)MIX + (size_t)gla::NUNIT * gla::LS_UNIT, (int)blockIdx.x * NTHREADS + tid, G * NTHREADS));
            PHASE(pb + 4, gla::scan_unit<true>(R1, DEC, (float*)MIX, nullptr, INP(4) + (size_t)l * GHV, R1 + 1024, GQKVR, (int)blockIdx.x, (char*)lds, tid));
            PHASE(pb + 5, { const pg8::Gemm g{R1 + 1024, WOA + (size_t)l * D * D, GQKVR, D, D, 0}; pg8::DenseOrder S; S.init(T, D, G, (int)blockIdx.x); const pg8::EpiBf16 E{MIX, D}; pg8::gemm_phase(ldsl, g, S, E, tid); });
        } else {
            const int j = l - 2; const float lambda_init = l == 2 ? 0.47071302f : 0.55605820f;
            PHASE(pb + 0, { { const pg8::Gemm g{HB, WQ + (size_t)j * D * D, D, D, D, 0}; pg8::DenseOrder S; S.init(T, D, G, (int)blockIdx.x); const pg8::EpiBf16 E{QB, D}; pg8::gemm_phase(ldsl, g, S, E, tid); }
                            if (l == 2) { const pg8::Gemm g{HB, WKV, D, D, D, 0}; pg8::DenseOrder S; S.init(T, 2048, G, (int)blockIdx.x); const pg8::EpiBf16 E{KV, 2048}; pg8::gemm_phase(ldsl, g, S, E, tid); } });
            PHASE(pb + 1, att::attn_phase(QB, KV, (float*)O1, O2, INP(14), INP(8) + j * 64, INP(9) + j * 64, INP(10) + j * 64, INP(11) + j * 64, INP(12) + j * ADV, lambda_init, (char*)lds, tid));
            PHASE(pb + 5, { const pg8::Gemm g{O2, WOB + (size_t)j * D * D, D, D, D, 0}; pg8::DenseOrder S; S.init(T, D, G, (int)blockIdx.x); const pg8::EpiBf16 E{MIX, D}; pg8::gemm_phase(ldsl, g, S, E, tid); });
        }
        PHASE(pb + 6, { RowArgs r{}; r.mode = 1; r.hb = HB; r.mix = MIX; r.ln_g = INP(22) + (size_t)(l * 2) * D; r.ln_b = INP(23) + (size_t)(l * 2) * D;
                        r.w_group = INP(15) + (size_t)l * D * 4; r.b_group = INP(16) + l * 4; r.w_router = INP(17) + (size_t)l * D * 16; r.b_router = INP(18) + l * 16;
                        r.cnt = cnt; r.list = LIST; r.tok_e = TOKE; r.tok_pos = TOKP; r.tok_w = TOKW;
                        row_phase<NTHREADS, 20>(r, lds, G, blockIdx.x, tid); });
        PHASE(pb + 7, { const pg8::Gemm g{HB, WGU + (size_t)l * NE * 1024 * D, D, D, D, (size_t)1024 * D}; const pg8::MoeOrder<true> S{cnt, LIST, 4, G, (int)blockIdx.x}; const pg8::EpiSwiglu E{HBUF, FF}; pg8::gemm_phase(ldsl, g, S, E, tid); });
        PHASE(pb + 8, { const pg8::Gemm g{HBUF, WD + (size_t)l * NE * D * FF, FF, FF, FF, (size_t)D * FF}; const pg8::MoeOrder<false> S{cnt, LIST, 4, G, (int)blockIdx.x}; const pg8::EpiBf16 E{YSLOT, D}; pg8::gemm_phase(ldsl, g, S, E, tid); });
        PHASE(pb + 9, { RowArgs r{}; r.mode = 2; r.hb = HB; r.Y = YSLOT; r.ln_g = INP(22) + (size_t)(l * 2 + 1) * D; r.ln_b = INP(23) + (size_t)(l * 2 + 1) * D;
                        r.cnt = cnt; r.tok_e = TOKE; r.tok_pos = TOKP; r.tok_w = TOKW;
                        if (l == 0) { r.lr_w = INP(1) + (size_t)D * GIN + 3072; r.lr_out = LR; }
                        if (l == 3) r.out = outp;
                        row_phase<NTHREADS, (l == 0 ? 16 : 0)>(r, lds, G, blockIdx.x, tid); });
}

__global__ void __launch_bounds__(NTHREADS, 2) fwd(MArgs a) {
    extern __shared__ __attribute__((aligned(16))) unsigned char lds[];
    const int tid0 = threadIdx.x, wave0 = __builtin_amdgcn_readfirstlane(tid0 >> 6);
    const int G = gridDim.x, NGW = G * NWAVES;
    volatile LAS unsigned long long* const ptab = (volatile LAS unsigned long long*)(lds + LDS_XB + 16);
    if (tid0 < 4) ((volatile LAS unsigned*)(lds + LDS_XB))[tid0] = 0u;
    if (tid0 < 24) ptab[tid0] = (unsigned long long)a.in[tid0];
    if (tid0 == 24) ptab[24] = (unsigned long long)a.out;
    if (tid0 == 25) ptab[25] = (unsigned long long)a.ws;
    __syncthreads();
    XcdBarrier bar = xcd_barrier_post((unsigned*)(a.ws + WS_CTL) + CW_BAR + a.li * XCD_BAR_WORDS, (volatile LAS unsigned*)(lds + LDS_XB));
    const int lo = a.ph_lo, hi = a.ph_hi;
    PG8_LAS unsigned char* const ldsl = (PG8_LAS unsigned char*)lds;
    { const int l = 0;
    PHASE(0, { ph_convert(ptab, ws, lds, gw, NGW, wave, lane); __syncthreads();
               RowArgs r{}; r.mode = 0; r.x = INP(0); r.hb = HB; r.lr_w = INP(1) + 3072; r.lr_out = LR; row_phase<NTHREADS, 16>(r, lds, G, blockIdx.x, tid); }); }
    layer_phases<0>(ptab, lds, ldsl, bar, lo, hi, wave0, G, NGW);
    layer_phases<1>(ptab, lds, ldsl, bar, lo, hi, wave0, G, NGW);
    layer_phases<2>(ptab, lds, ldsl, bar, lo, hi, wave0, G, NGW);
    layer_phases<3>(ptab, lds, ldsl, bar, lo, hi, wave0, G, NGW);
}
#undef PHASE

#ifndef RUN_MODE
#define RUN_MODE 1
#endif
extern "C" void kernel_launch(void* const* d_in, const int* in_sizes, int n_in, void* d_out, int out_size, void* d_ws, size_t ws_size, hipStream_t stream) {
    static int grid = 0;
    if (grid == 0) {
        if (n_in != 24 || out_size != T * D || ws_size < WS_END) { fprintf(stderr, "kernel_launch: unexpected sizes n_in %d out %d ws %zu (need %zu)\n", n_in, out_size, ws_size, (size_t)WS_END); grid = -1; return; }
        int dev = 0, cus = 0, per_cu = 0;
        if (hipGetDevice(&dev) != hipSuccess || hipDeviceGetAttribute(&cus, hipDeviceAttributeMultiprocessorCount, dev) != hipSuccess) { grid = -1; return; }
        if (hipFuncSetAttribute((const void*)fwd, hipFuncAttributeMaxDynamicSharedMemorySize, LDS_BYTES) != hipSuccess) { fprintf(stderr, "hipFuncSetAttribute failed\n"); grid = -1; return; }
        if (hipOccupancyMaxActiveBlocksPerMultiprocessor(&per_cu, (const void*)fwd, NTHREADS, LDS_BYTES) != hipSuccess || per_cu < 1) { fprintf(stderr, "occupancy query: %d blocks per CU\n", per_cu); grid = -1; return; }
        (void)hipGetLastError();
        grid = cus;
        if (grid != 256 || T % (grid * NWAVES * 4) != 0) { fprintf(stderr, "unsupported CU count %d\n", cus); grid = -1; return; }
    }
    if (grid < 0) return;
    (void)hipMemsetAsync((unsigned char*)d_ws + WS_CTL, 0, CTL_BYTES, stream);
    MArgs a{};
    for (int i = 0; i < 24; ++i) a.in[i] = (const float*)d_in[i];
    a.out = (float*)d_out; a.ws = (unsigned char*)d_ws;
#if RUN_MODE == 1
    a.ph_lo = 0; a.ph_hi = N_PHASES - 1; a.li = 0;
    hipLaunchKernelGGL(fwd, dim3(grid), dim3(NTHREADS), LDS_BYTES, stream, a);
#else
    int li = 0;
    for (int p = 0; p < N_PHASES - 1; ++p) {
        const int k = (p - 1) % 12, l = (p - 1) / 12;
        if (p > 0) { if (k >= 10) continue; if (l >= 2 && (k == 2 || k == 3 || k == 4)) continue; }
        a.ph_lo = p; a.ph_hi = p + 1; a.li = li++;
        hipLaunchKernelGGL(fwd, dim3(grid), dim3(NTHREADS), LDS_BYTES, stream, a);
    }
#endif
}
```

```cpp
#include <hip/hip_runtime.h>
#include <cstdio>
#include <cstdint>
#include <cmath>

typedef unsigned short bf16_t;
typedef short bf16x8 __attribute__((ext_vector_type(8)));
typedef float f32x4 __attribute__((ext_vector_type(4)));
typedef float f32x2 __attribute__((ext_vector_type(2)));

constexpr int NB = 2, SEQ = 16384, T = NB * SEQ, D = 1024;
constexpr int CHUNK = 64, NCH = SEQ / CHUNK;
constexpr int GH = 4, GDK = 128, GDV = 256, GHK = 512, GHV = 1024, GIN = 3088, GQKVR = 3072;
constexpr int AH = 8, ADH = 64, ADV = 128;
constexpr int NE = 16, FF = 512;
constexpr int NSLOT = 2 * T + NE * 256;
constexpr float ALPHA = 1.6817928305074290f;
constexpr float LN_EPS = 1e-5f;

constexpr size_t al256(size_t x) { return (x + 255) & ~(size_t)255; }
constexpr size_t WS_CTL = 0;
constexpr size_t CTL_BYTES = 1u << 20;
constexpr size_t WS_WIN = WS_CTL + CTL_BYTES;
constexpr size_t WS_WOA = WS_WIN + (size_t)2 * GQKVR * D * 2;
constexpr size_t WS_WKV = WS_WOA + (size_t)2 * D * D * 2;
constexpr size_t WS_WQ = WS_WKV + (size_t)2048 * D * 2;
constexpr size_t WS_WOB = WS_WQ + (size_t)2 * D * D * 2;
constexpr size_t WS_WGU = WS_WOB + (size_t)2 * D * D * 2;
constexpr size_t WS_WD = WS_WGU + (size_t)4 * NE * 1024 * D * 2;
constexpr size_t WS_HB = WS_WD + (size_t)4 * NE * D * FF * 2;
constexpr size_t WS_R1 = WS_HB + (size_t)T * D * 2;
constexpr size_t WS_MIX = WS_R1 + (size_t)T * GQKVR * 2;
constexpr size_t WS_LR = WS_MIX + (size_t)T * D * 2;
constexpr size_t WS_DEC = WS_LR + (size_t)T * 16 * 4;
constexpr size_t WS_LIST = WS_DEC + (size_t)NB * NCH * GHK * 4;
constexpr size_t WS_TOKE = WS_LIST + (size_t)NE * T * 4;
constexpr size_t WS_TOKP = WS_TOKE + (size_t)T * 2 * 4;
constexpr size_t WS_TOKW = WS_TOKP + (size_t)T * 2 * 4;
constexpr size_t WS_END = WS_TOKW + (size_t)T * 2 * 4;
static_assert(WS_TOKP == WS_TOKE + (size_t)T * 2 * 4 && WS_TOKW == WS_TOKP + (size_t)T * 2 * 4, "the row phase reads tok_e | tok_pos | tok_w as one array");
constexpr size_t WS_HBUF = WS_R1;
constexpr size_t WS_YSLOT = WS_R1 + al256((size_t)NSLOT * FF * 2);
static_assert(WS_YSLOT + (size_t)NSLOT * D * 2 <= WS_LR, "MoE overlay fits R1|MIX");
constexpr size_t WS_QB = WS_R1;
constexpr size_t WS_OB = WS_R1 + (size_t)T * D * 2;
constexpr int CW_CNT = 64;

__device__ __forceinline__ float bf2f(bf16_t v) { return __uint_as_float(((unsigned)v) << 16); }
__device__ __forceinline__ bf16_t f2bf(float f) { return __builtin_bit_cast(bf16_t, (__bf16)f); }
__device__ __forceinline__ float wave_sum(float v) {
#pragma unroll
    for (int o = 1; o < 64; o <<= 1) v += __shfl_xor(v, o);
    return v;
}
__device__ __forceinline__ float silu_f(float x) { return x * __builtin_amdgcn_rcpf(1.f + __expf(-x)); }

struct RowArgs {
    int mode;
    int pad0;
    const float* x; bf16_t* hb; bf16_t* hb_out; const bf16_t* mix; const bf16_t* Y;
    const float* ln_g; const float* ln_b;
    const float* w_group; const float* b_group; const float* w_router; const float* b_router;
    int* cnt; int* list; int* tok_e; int* tok_pos; float* tok_w;
    const float* lr_w; float* lr_out;
    float* out;
};

constexpr int ROW_LDS_W = 36 * 1024 * 4;
constexpr int ROW_LDS_BYTES = ROW_LDS_W + 4096;

template <int O> __device__ __forceinline__ float xor_get(float v, int lane) {
    if constexpr (O == 32) { const auto rr = __builtin_amdgcn_permlane32_swap(__float_as_uint(v), __float_as_uint(v), false, false); return __uint_as_float(lane < 32 ? rr[1] : rr[0]); }
    else return __int_as_float(__builtin_amdgcn_ds_swizzle(__float_as_int(v), (O << 10) | 0x1f));
}
template <int O> __device__ __forceinline__ float xor_add(float v) {
    if constexpr (O == 32) { const auto rr = __builtin_amdgcn_permlane32_swap(__float_as_uint(v), __float_as_uint(v), false, false); return __uint_as_float(rr[0]) + __uint_as_float(rr[1]); }
    else return v + __int_as_float(__builtin_amdgcn_ds_swizzle(__float_as_int(v), (O << 10) | 0x1f));
}
template <int N, int MASK> __device__ __forceinline__ void halve_step(float* a, int lane) {
    const bool up = (lane & MASK) != 0;
#pragma unroll
    for (int i = 0; i < N / 2; ++i) { const float send = up ? a[i] : a[N / 2 + i], keep = up ? a[N / 2 + i] : a[i]; a[i] = keep + xor_get<MASK>(send, lane); }
}
#define ROW_SUM4(x) do { _Pragma("unroll") for (int rr = 0; rr < 4; ++rr) x[rr] = xor_add<1>(x[rr]); _Pragma("unroll") for (int rr = 0; rr < 4; ++rr) x[rr] = xor_add<2>(x[rr]); \
    _Pragma("unroll") for (int rr = 0; rr < 4; ++rr) x[rr] = xor_add<4>(x[rr]); _Pragma("unroll") for (int rr = 0; rr < 4; ++rr) x[rr] = xor_add<8>(x[rr]); \
    _Pragma("unroll") for (int rr = 0; rr < 4; ++rr) x[rr] = xor_add<16>(x[rr]); _Pragma("unroll") for (int rr = 0; rr < 4; ++rr) x[rr] = xor_add<32>(x[rr]); } while (0)
typedef unsigned u32x2_nt __attribute__((ext_vector_type(2)));
__device__ __forceinline__ ushort4 ld_nt8(const bf16_t* p) { const u32x2_nt v = __builtin_nontemporal_load((const u32x2_nt*)p); ushort4 r; r.x = (unsigned short)v[0]; r.y = (unsigned short)(v[0] >> 16); r.z = (unsigned short)v[1]; r.w = (unsigned short)(v[1] >> 16); return r; }
__device__ __forceinline__ int wt_idx(int jj, int c) { return ((((jj >> 1) * 4 + (c >> 8)) * 2 + ((c >> 1) & 1)) * 256) + 4 * ((c >> 2) & 63) + (c & 1) * 2 + (jj & 1); }
template <int NTHR, int NDOT> __device__ __forceinline__ void row_phase(const RowArgs& a, unsigned char* lds_raw, int nblocks, int bid, int tid) {
    float* Wt = (float*)lds_raw;
    float* GB = Wt + 24 * 1024;
    int* lcnt = (int*)(lds_raw + ROW_LDS_W);
    int* lbase = lcnt + 16;
    int* offs = lbase + 16;
    int* ent = offs + 16;
    constexpr int nthr = NTHR, nw = NTHR / 64; const int lane = tid & 63, wave = tid >> 6;
    bf16_t* const hbo = a.hb_out ? a.hb_out : a.hb;
    const int rows_per_block = T / nblocks;
    if (a.mode == 1) {
        for (int i = tid; i < 1024 * 4; i += nthr) { const int c = i >> 2, j = i & 3; Wt[wt_idx(j, c)] = a.w_group[i]; }
        for (int i = tid; i < 1024 * 16; i += nthr) { const int c = i >> 4, j = i & 15; Wt[wt_idx(4 + j, c)] = a.w_router[i]; }
        if (tid < 16) lcnt[tid] = 0;
    } else if (a.lr_w) {
        for (int i = tid; i < 1024 * 16; i += nthr) { const int c = i >> 4, j = i & 15; Wt[wt_idx(j, c)] = a.lr_w[(size_t)c * GIN + j]; }
    }
    if (a.mode != 0) for (int i = tid; i < 2048; i += nthr) GB[i] = i < 1024 ? a.ln_g[i] : a.ln_b[i - 1024];
    int offv = 0;
    if (a.mode == 2) { const int myc = a.cnt[lane & (NE - 1)]; int o = 0;
#pragma unroll
        for (int e = 0; e < NE; ++e) { if (lane == e) offv = o; o += (__builtin_amdgcn_readlane(myc, e) + 255) & ~255; } }
    __syncthreads();
    const int iters = rows_per_block / (nw * 4);
    for (int it = 0; it < iters; ++it) {
        const int lr0 = (it * nw + wave) * 4;
        const size_t rowb = ((size_t)it * nblocks + bid) * (nw * 4) + wave * 4;
        float v[4][16];
        if (a.mode == 0) {
            f32x4 xr[4][4];
#pragma unroll
            for (int rr = 0; rr < 4; ++rr)
#pragma unroll
                for (int i = 0; i < 4; ++i) xr[rr][i] = __builtin_nontemporal_load((const f32x4*)(a.x + (rowb + rr) * D + 256 * i + 4 * lane));
#pragma unroll
            for (int rr = 0; rr < 4; ++rr)
#pragma unroll
                for (int i = 0; i < 4; ++i) { v[rr][4 * i] = xr[rr][i][0]; v[rr][4 * i + 1] = xr[rr][i][1]; v[rr][4 * i + 2] = xr[rr][i][2]; v[rr][4 * i + 3] = xr[rr][i][3]; }
        } else {
            ushort4 hr[4][4], ar[4][4], br[4][4]; float w0[4], w1[4];
            const bf16_t* pa[4]; const bf16_t* pb[4];
            if (a.mode == 1) {
#pragma unroll
                for (int rr = 0; rr < 4; ++rr) { pa[rr] = a.mix + (rowb + rr) * D; pb[rr] = pa[rr]; w0[rr] = 1.f; w1[rr] = 0.f; }
            } else {
                const int k_ = (lane >> 3) > 2 ? 2 : (lane >> 3); const int m = a.tok_e[(size_t)k_ * (2 * T) + rowb * 2 + (lane & 7)];
#pragma unroll
                for (int rr = 0; rr < 4; ++rr) { const int e0 = __builtin_amdgcn_readlane(m, 2 * rr), e1 = __builtin_amdgcn_readlane(m, 2 * rr + 1), p0 = __builtin_amdgcn_readlane(m, 8 + 2 * rr), p1 = __builtin_amdgcn_readlane(m, 9 + 2 * rr);
                    w0[rr] = __int_as_float(__builtin_amdgcn_readlane(m, 16 + 2 * rr)); w1[rr] = __int_as_float(__builtin_amdgcn_readlane(m, 17 + 2 * rr));
                    pa[rr] = a.Y + (size_t)(__builtin_amdgcn_readlane(offv, e0) + p0) * D; pb[rr] = a.Y + (size_t)(__builtin_amdgcn_readlane(offv, e1) + p1) * D; }
            }
#pragma unroll
            for (int rr = 0; rr < 4; ++rr)
#pragma unroll
                for (int i = 0; i < 4; ++i) { hr[rr][i] = *(const ushort4*)(a.hb + (rowb + rr) * D + 256 * i + 4 * lane); ar[rr][i] = ld_nt8(pa[rr] + 256 * i + 4 * lane);
                    if (a.mode == 2) br[rr][i] = ld_nt8(pb[rr] + 256 * i + 4 * lane); }
#pragma unroll
            for (int rr = 0; rr < 4; ++rr) { __builtin_amdgcn_sched_barrier(0);
#pragma unroll
                for (int i = 0; i < 4; ++i) {
                    v[rr][4 * i] = ALPHA * bf2f(hr[rr][i].x) + w0[rr] * bf2f(ar[rr][i].x); v[rr][4 * i + 1] = ALPHA * bf2f(hr[rr][i].y) + w0[rr] * bf2f(ar[rr][i].y);
                    v[rr][4 * i + 2] = ALPHA * bf2f(hr[rr][i].z) + w0[rr] * bf2f(ar[rr][i].z); v[rr][4 * i + 3] = ALPHA * bf2f(hr[rr][i].w) + w0[rr] * bf2f(ar[rr][i].w);
                    if (a.mode == 2) { v[rr][4 * i] += w1[rr] * bf2f(br[rr][i].x); v[rr][4 * i + 1] += w1[rr] * bf2f(br[rr][i].y); v[rr][4 * i + 2] += w1[rr] * bf2f(br[rr][i].z); v[rr][4 * i + 3] += w1[rr] * bf2f(br[rr][i].w); } } }
            __builtin_amdgcn_sched_barrier(0);
            float mu[4], rstd[4];
#pragma unroll
            for (int rr = 0; rr < 4; ++rr) { float s = 0.f;
#pragma unroll
                for (int i = 0; i < 16; ++i) s += v[rr][i];
                mu[rr] = s; }
            ROW_SUM4(mu);
#pragma unroll
            for (int rr = 0; rr < 4; ++rr) { mu[rr] *= (1.f / D); float q = 0.f;
#pragma unroll
                for (int i = 0; i < 16; ++i) { v[rr][i] -= mu[rr]; q += v[rr][i] * v[rr][i]; }
                rstd[rr] = q; }
            ROW_SUM4(rstd);
#pragma unroll
            for (int rr = 0; rr < 4; ++rr) rstd[rr] = rsqrtf(rstd[rr] * (1.f / D) + LN_EPS);
#pragma unroll
            for (int i = 0; i < 4; ++i) { int gl = 4 * lane; asm volatile("" : "+v"(gl));
                const f32x4 gg = *(const f32x4*)(GB + 256 * i + gl), bb = *(const f32x4*)(GB + 1024 + 256 * i + gl);
#pragma unroll
                for (int rr = 0; rr < 4; ++rr)
#pragma unroll
                    for (int qd = 0; qd < 4; ++qd) v[rr][4 * i + qd] = v[rr][4 * i + qd] * rstd[rr] * gg[qd] + bb[qd]; }
        }
#pragma unroll
        for (int rr = 0; rr < 4; ++rr)
#pragma unroll
            for (int i = 0; i < 4; ++i) { ushort4 t; t.x = f2bf(v[rr][4 * i]); t.y = f2bf(v[rr][4 * i + 1]); t.z = f2bf(v[rr][4 * i + 2]); t.w = f2bf(v[rr][4 * i + 3]);
                if (!a.out) *(ushort4*)(hbo + (rowb + rr) * D + 256 * i + 4 * lane) = t;
                if (a.out) { f32x4 o; o[0] = v[rr][4 * i]; o[1] = v[rr][4 * i + 1]; o[2] = v[rr][4 * i + 2]; o[3] = v[rr][4 * i + 3]; __builtin_nontemporal_store(o, (f32x4*)(a.out + (rowb + rr) * D + 256 * i + 4 * lane)); } }
        if constexpr (NDOT == 20) {
            float* res = Wt + 32 * 1024 + wave * 80;
            const int nb = ((lane >> 5) & 1) * 8 + ((lane >> 4) & 1) * 4 + ((lane >> 3) & 1) * 2 + ((lane >> 2) & 1);
#define ROW_FMA4(T_, RR, I, WA, WB) do { T_ = __builtin_elementwise_fma((f32x2){v[RR][4 * (I)], v[RR][4 * (I)]}, (f32x2){WA[0], WA[1]}, T_); T_ = __builtin_elementwise_fma((f32x2){v[RR][4 * (I) + 1], v[RR][4 * (I) + 1]}, (f32x2){WA[2], WA[3]}, T_); \
                T_ = __builtin_elementwise_fma((f32x2){v[RR][4 * (I) + 2], v[RR][4 * (I) + 2]}, (f32x2){WB[0], WB[1]}, T_); T_ = __builtin_elementwise_fma((f32x2){v[RR][4 * (I) + 3], v[RR][4 * (I) + 3]}, (f32x2){WB[2], WB[3]}, T_); } while (0)
#define ROW_RED16(X, SLOT) do { halve_step<16, 32>(X, lane); halve_step<8, 16>(X, lane); halve_step<4, 8>(X, lane); halve_step<2, 4>(X, lane); X[0] = xor_add<2>(X[0]); X[0] = xor_add<1>(X[0]); \
                if ((lane & 3) == 0) res[(SLOT) + nb] = X[0]; asm volatile("s_waitcnt lgkmcnt(0)" ::: "memory"); } while (0)
            f32x2 g2[8];
#pragma unroll
            for (int n = 0; n < 8; ++n) g2[n] = (f32x2){0.f, 0.f};
#pragma unroll
            for (int i = 0; i < 4; ++i)
#pragma unroll
                for (int jp = 0; jp < 2; ++jp) { const f32x4 wa = *(const f32x4*)(Wt + ((jp * 4 + i) * 2) * 256 + 4 * lane), wb = *(const f32x4*)(Wt + ((jp * 4 + i) * 2 + 1) * 256 + 4 * lane);
#pragma unroll
                    for (int rr = 0; rr < 4; ++rr) ROW_FMA4(g2[rr * 2 + jp], rr, i, wa, wb); }
            float ga[16];
#pragma unroll
            for (int n = 0; n < 8; ++n) { ga[2 * n] = g2[n][0]; ga[2 * n + 1] = g2[n][1]; }
            ROW_RED16(ga, 0);
            int gi[4];
            const float bg0 = a.b_group[0], bg1 = a.b_group[1], bg2 = a.b_group[2], bg3 = a.b_group[3];
#pragma unroll
            for (int rr = 0; rr < 4; ++rr) { const f32x4 t = *(const f32x4*)(res + 4 * rr); const float gl[4] = {t[0] + bg0, t[1] + bg1, t[2] + bg2, t[3] + bg3};
                int g_ = 0; float gm = gl[0];
#pragma unroll
                for (int j = 1; j < 4; ++j) if (gl[j] > gm) { gm = gl[j]; g_ = j; }
                gi[rr] = g_; }
            f32x2 e2[8];
#pragma unroll
            for (int n = 0; n < 8; ++n) e2[n] = (f32x2){0.f, 0.f};
#pragma unroll
            for (int rr = 0; rr < 4; ++rr) { const float* wr_ = Wt + (2 + 2 * gi[rr]) * 2048 + 4 * lane;
#pragma unroll
                for (int i = 0; i < 4; ++i)
#pragma unroll
                    for (int q = 0; q < 2; ++q) { const f32x4 wa = *(const f32x4*)(wr_ + q * 2048 + (i * 2) * 256), wb = *(const f32x4*)(wr_ + q * 2048 + (i * 2 + 1) * 256);
                        ROW_FMA4(e2[rr * 2 + q], rr, i, wa, wb); } }
            float ea[16];
#pragma unroll
            for (int n = 0; n < 8; ++n) { ea[2 * n] = e2[n][0]; ea[2 * n + 1] = e2[n][1]; }
            ROW_RED16(ea, 16);
#undef ROW_FMA4
#undef ROW_RED16
            if (lane < 4) {
                const f32x4 tg = *(const f32x4*)(res + 4 * lane), te = *(const f32x4*)(res + 16 + 4 * lane);
                const float gl[4] = {tg[0] + bg0, tg[1] + bg1, tg[2] + bg2, tg[3] + bg3};
                int gq = 0; float gm = gl[0];
#pragma unroll
                for (int j = 1; j < 4; ++j) if (gl[j] > gm) { gm = gl[j]; gq = j; }
                float gs = 0.f;
#pragma unroll
                for (int j = 0; j < 4; ++j) gs += __expf(gl[j] - gm);
                const float gw = 1.f / gs;
                float l4[4];
#pragma unroll
                for (int j = 0; j < 4; ++j) l4[j] = te[j] + a.b_router[gq * 4 + j];
                int ia = 0; float la = l4[0];
#pragma unroll
                for (int j = 1; j < 4; ++j) if (l4[j] > la) { la = l4[j]; ia = j; }
                int ib = -1; float lb = -3.0e38f;
#pragma unroll
                for (int j = 0; j < 4; ++j) if (j != ia && l4[j] > lb) { lb = l4[j]; ib = j; }
                const float eb = __expf(lb - la), wa = 1.f / (1.f + eb), wb = eb / (1.f + eb);
                const int e1 = gq * 4 + ia, e2_ = gq * 4 + ib;
                const int p1 = atomicAdd(&lcnt[e1], 1), p2 = atomicAdd(&lcnt[e2_], 1);
                const int lrow = lr0 + lane; const size_t row = rowb + lane;
                ent[lrow * 4 + 0] = e1; ent[lrow * 4 + 1] = p1; ent[lrow * 4 + 2] = e2_; ent[lrow * 4 + 3] = p2;
                a.tok_e[row * 2] = e1; a.tok_e[row * 2 + 1] = e2_; a.tok_w[row * 2] = gw * wa; a.tok_w[row * 2 + 1] = gw * wb;
            }
        } else if constexpr (NDOT > 0) {
            constexpr int NV = 4 * NDOT, NP = NDOT / 2;
            f32x2 acc2[4 * NP];
#pragma unroll
            for (int n = 0; n < 4 * NP; ++n) acc2[n] = (f32x2){0.f, 0.f};
#pragma unroll
            for (int i = 0; i < 4; ++i) {
#pragma unroll
                for (int jp = 0; jp < NP; ++jp) { const f32x4 wa = *(const f32x4*)(Wt + ((jp * 4 + i) * 2) * 256 + 4 * lane), wb = *(const f32x4*)(Wt + ((jp * 4 + i) * 2 + 1) * 256 + 4 * lane);
#pragma unroll
                    for (int rr = 0; rr < 4; ++rr) { f32x2 t = acc2[rr * NP + jp];
                        t = __builtin_elementwise_fma((f32x2){v[rr][4 * i], v[rr][4 * i]}, (f32x2){wa[0], wa[1]}, t); t = __builtin_elementwise_fma((f32x2){v[rr][4 * i + 1], v[rr][4 * i + 1]}, (f32x2){wa[2], wa[3]}, t);
                        t = __builtin_elementwise_fma((f32x2){v[rr][4 * i + 2], v[rr][4 * i + 2]}, (f32x2){wb[0], wb[1]}, t); t = __builtin_elementwise_fma((f32x2){v[rr][4 * i + 3], v[rr][4 * i + 3]}, (f32x2){wb[2], wb[3]}, t);
                        acc2[rr * NP + jp] = t; }
                    asm volatile("" : "+v"(acc2[jp]), "+v"(acc2[NP + jp]), "+v"(acc2[2 * NP + jp]), "+v"(acc2[3 * NP + jp]) :: "memory"); }
            }
            float acc[NV];
#pragma unroll
            for (int n = 0; n < 4 * NP; ++n) { acc[2 * n] = acc2[n][0]; acc[2 * n + 1] = acc2[n][1]; }
            halve_step<NV, 32>(acc, lane); halve_step<NV / 2, 16>(acc, lane); halve_step<NV / 4, 8>(acc, lane); halve_step<NV / 8, 4>(acc, lane);
            constexpr int NR = NV / 16;
#pragma unroll
            for (int i = 0; i < NR; ++i) { acc[i] = xor_add<2>(acc[i]); acc[i] = xor_add<1>(acc[i]); }
            float* res = Wt + 32 * 1024 + wave * 80;
            if ((lane & 3) == 0) { const int nb = ((lane >> 5) & 1) * (NV / 2) + ((lane >> 4) & 1) * (NV / 4) + ((lane >> 3) & 1) * (NV / 8) + ((lane >> 2) & 1) * (NV / 16);
#pragma unroll
                for (int i = 0; i < NR; ++i) res[nb + i] = acc[i]; }
            asm volatile("s_waitcnt lgkmcnt(0)" ::: "memory");
            if (a.mode != 1) {
                if (lane < NV) a.lr_out[rowb * 16 + lane] = res[lane];
            } else if (lane < 4) {
                const float* rp = res + lane * NDOT;
                float gl[4], el[16];
#pragma unroll
                for (int j = 0; j < 4; ++j) gl[j] = rp[j] + a.b_group[j];
#pragma unroll
                for (int j = 0; j < 16; ++j) el[j] = rp[4 + j] + a.b_router[j];
                int gi = 0; float gm = gl[0];
#pragma unroll
                for (int j = 1; j < 4; ++j) if (gl[j] > gm) { gm = gl[j]; gi = j; }
                float gs = 0.f;
#pragma unroll
                for (int j = 0; j < 4; ++j) gs += __expf(gl[j] - gm);
                const float gw = 1.f / gs;
                float l4[4];
#pragma unroll
                for (int j = 0; j < 4; ++j) l4[j] = gi == 0 ? el[j] : gi == 1 ? el[4 + j] : gi == 2 ? el[8 + j] : el[12 + j];
                int ia = 0; float la = l4[0];
#pragma unroll
                for (int j = 1; j < 4; ++j) if (l4[j] > la) { la = l4[j]; ia = j; }
                int ib = -1; float lb = -3.0e38f;
#pragma unroll
                for (int j = 0; j < 4; ++j) if (j != ia && l4[j] > lb) { lb = l4[j]; ib = j; }
                const float eb = __expf(lb - la), wa = 1.f / (1.f + eb), wb = eb / (1.f + eb);
                const int e1 = gi * 4 + ia, e2 = gi * 4 + ib;
                const int p1 = atomicAdd(&lcnt[e1], 1), p2 = atomicAdd(&lcnt[e2], 1);
                const int lrow = lr0 + lane; const size_t row = rowb + lane;
                ent[lrow * 4 + 0] = e1; ent[lrow * 4 + 1] = p1; ent[lrow * 4 + 2] = e2; ent[lrow * 4 + 3] = p2;
                a.tok_e[row * 2] = e1; a.tok_e[row * 2 + 1] = e2; a.tok_w[row * 2] = gw * wa; a.tok_w[row * 2 + 1] = gw * wb;
            }
        }
    }
    if (a.mode == 1) {
        __syncthreads();
        if (tid < 16) lbase[tid] = atomicAdd(&a.cnt[tid], lcnt[tid]);
        __syncthreads();
        for (int r = tid; r < rows_per_block; r += nthr) {
            const int e1 = ent[r * 4], p1 = lbase[e1] + ent[r * 4 + 1], e2 = ent[r * 4 + 2], p2 = lbase[e2] + ent[r * 4 + 3];
            const int tok = ((r / (nw * 4)) * nblocks + bid) * (nw * 4) + (r % (nw * 4));
            a.list[(size_t)e1 * T + p1] = tok; a.list[(size_t)e2 * T + p2] = tok;
            a.tok_pos[tok * 2] = p1; a.tok_pos[tok * 2 + 1] = p2;
        }
    }
    __syncthreads();
}

__device__ __forceinline__ int rel_bucket_dev(int rel) {
    const int n = rel < 0 ? -rel : rel; int bk;
    if (n < 8) bk = n; else if (n >= 128) bk = 15; else { const int x = (n * n) >> 6; bk = 8 + (31 - __clz(x)); if (bk > 15) bk = 15; }
    return (rel > 0 ? 16 : 0) + bk;
}
namespace pg8 {
#define PG8_LAS __attribute__((address_space(3)))
typedef unsigned u32x4 __attribute__((ext_vector_type(4)));
typedef unsigned u32x2 __attribute__((ext_vector_type(2)));
constexpr int BM = 256, BK = 64, HALF = 128, HTB = HALF * BK * 2, STAGE_BYTES = 8 * HTB, NXCD = 8, WGM = 8;
__host__ __device__ __forceinline__ int lds_byte(int r, int c) { const int st = (r >> 4) * 2 + (c >> 5), rr = r & 15, cc = c & 31, ob = rr * 64 + cc * 2; return st * 1024 + (ob ^ (((ob >> 9) & 1) << 5)); }
__host__ __device__ __forceinline__ void stage_rc(int b, int& R, int& C) { const int st = b / 1024, sb = b % 1024, swz = sb ^ (((sb >> 9) & 1) << 5); R = (st >> 1) * 16 + swz / 64; C = (st & 1) * 32 + (swz % 64) / 2; }
__host__ __device__ __forceinline__ int perm32(int rho) { const int n = rho >> 4, i = rho & 15; return 8 * (i >> 2) + 4 * n + (i & 3); }

struct Unit { int pn, e, arow, orow, cnt; };
struct Gemm { const bf16_t* A; const bf16_t* Bt; int lda, ldb, K; size_t bt_estride; };

struct DenseOrder {
    int nM, nN, nwg, G, c;
    __device__ __forceinline__ void init(int M, int N, int G_, int c_) { nM = M / BM; nN = N / BM; nwg = nM * nN; G = G_; c = c_; }
    __device__ __forceinline__ bool next(int i, Unit& u) const {
        const long L = (long)i * G + c; if (L >= nwg) return false;
        int wgid = (int)L; { const int q = nwg / NXCD, r = nwg % NXCD, xcd = wgid % NXCD, off = wgid / NXCD; wgid = (xcd < r ? xcd * (q + 1) : r * (q + 1) + (xcd - r) * q) + off; }
        const int nig = WGM * nN, gid = wgid / nig, fm = gid * WGM, gsz = (nM - fm) < WGM ? (nM - fm) : WGM;
        const int pm = fm + ((wgid % nig) % gsz); u.pn = (wgid % nig) / gsz; u.e = 0; u.arow = pm * BM; u.orow = pm * BM; u.cnt = 0; return true;
    }
    __device__ __forceinline__ unsigned rowbyte(const Unit& u, int r, int lda) const { return (unsigned)(u.arow + r) * (unsigned)lda * 2u; }
};
template <bool GATHER> struct MoeOrder {
    const int* cnt; const int* list; int nN, G, c;
    __device__ __forceinline__ bool next(int i, Unit& u) const {
        const int lane = (int)__builtin_amdgcn_mbcnt_hi(~0u, __builtin_amdgcn_mbcnt_lo(~0u, 0u));
        const int myc = cnt[lane & (NE - 1)];
        const int x = c & 7, nwx = G >> 3; int L = __builtin_amdgcn_readfirstlane(i * nwx + (c >> 3)); bool found = false;
        u.pn = 0; u.e = 0; u.arow = 0; u.orow = 0; u.cnt = 0;
        int esel = -1, ce_sel = 0;
        { const int ce0 = __builtin_amdgcn_readlane(myc, x), nu0 = ((ce0 + 255) >> 8) * nN;
          if (L < nu0) { esel = x; ce_sel = ce0; }
          else { L -= nu0; const int ce1 = __builtin_amdgcn_readlane(myc, x + 8), nu1 = ((ce1 + 255) >> 8) * nN; if (L < nu1) { esel = x + 8; ce_sel = ce1; } } }
        if (esel >= 0) { int off = 0;
#pragma unroll
            for (int e = 0; e < NE; ++e) { const int nt = (__builtin_amdgcn_readlane(myc, e) + 255) >> 8; if (e < esel) off += nt * BM; }
            const int pm = L / nN; u.pn = L - pm * nN; u.e = esel; u.arow = pm * BM; u.orow = off + pm * BM; u.cnt = ce_sel; found = true; }
        return found;
    }
    __device__ __forceinline__ unsigned rowbyte(const Unit& u, int r, int lda) const {
        if (GATHER) { const int li = u.arow + r; const int tok = li < u.cnt ? list[(size_t)u.e * T + li] : 0; return (unsigned)tok * (unsigned)lda * 2u; }
        return (unsigned)(u.orow + r) * (unsigned)lda * 2u;
    }
};

__device__ __forceinline__ unsigned cvt_pk_bf16(float lo, float hi) { unsigned r; asm volatile("v_cvt_pk_bf16_f32 %0, %1, %2" : "=v"(r) : "v"(lo), "v"(hi)); return r; }
struct EpiBf16 {
    static constexpr bool PERM = true;
    bf16_t* O; int ldc;
    __device__ __forceinline__ void operator()(const f32x4 (&acc)[2][2][4][2], const Unit& u, int wr, int wc, int fr, int fq) const {
        const int row0 = u.orow + wr * 64 + fr, col0 = u.pn * BM + wc * 32 + 8 * fq;
#pragma unroll
        for (int ai = 0; ai < 2; ++ai)
#pragma unroll
            for (int m = 0; m < 4; ++m) { bf16_t* rowp = O + (size_t)(row0 + ai * HALF + m * 16) * ldc + col0;
#pragma unroll
                for (int bj = 0; bj < 2; ++bj) { const f32x4 v0 = acc[ai][bj][m][0], v1 = acc[ai][bj][m][1];
                    u32x4 w; w.x = cvt_pk_bf16(v0[0], v0[1]); w.y = cvt_pk_bf16(v0[2], v0[3]); w.z = cvt_pk_bf16(v1[0], v1[1]); w.w = cvt_pk_bf16(v1[2], v1[3]);
                    *(u32x4*)(rowp + bj * HALF) = w; } }
    }
};
struct EpiSwiglu {
    static constexpr bool PERM = false;
    bf16_t* O; int ldc;
    __device__ __forceinline__ void operator()(const f32x4 (&acc)[2][2][4][2], const Unit& u, int wr, int wc, int fr, int fq) const {
        const int row0 = u.orow + wr * 64 + fr, col0 = u.pn * (BM / 2) + wc * 16 + 4 * fq;
#pragma unroll
        for (int ai = 0; ai < 2; ++ai)
#pragma unroll
            for (int m = 0; m < 4; ++m) { bf16_t* rowp = O + (size_t)(row0 + ai * HALF + m * 16) * ldc + col0;
#pragma unroll
                for (int bj = 0; bj < 2; ++bj) { const f32x4 g = acc[ai][bj][m][0], v = acc[ai][bj][m][1];
                    u32x2 w; w.x = cvt_pk_bf16(silu_f(g[0]) * v[0], silu_f(g[1]) * v[1]); w.y = cvt_pk_bf16(silu_f(g[2]) * v[2], silu_f(g[3]) * v[3]);
                    *(u32x2*)(rowp + bj * (HALF / 2)) = w; } }
    }
};

template <class Epi, class Sched>
__device__ __forceinline__ void gemm_phase(PG8_LAS unsigned char* lds, const Gemm g, const Sched& S, const Epi& E, int tid) {
    const int wid = __builtin_amdgcn_readfirstlane(tid >> 6), lane = tid & 63, wr = wid >> 2, wc = wid & 3, fr = lane & 15, fq = lane >> 4;
    const int K = g.K, nt = K / BK;
    unsigned voffB[2];
#pragma unroll
    for (int i = 0; i < 2; ++i) { int R, C; stage_rc(tid * 16 + i * 8192, R, C); const int Rb = Epi::PERM ? ((R & ~31) + perm32(R & 31)) : R;
        voffB[i] = (unsigned)(Rb * g.ldb + C) * 2u; }
    const size_t kstep = (size_t)(BK * 2);
    const size_t hstepB = (size_t)HALF * g.ldb * 2, tstepB = 2 * hstepB;
    const unsigned ldsw = (unsigned)wid * 1024u;
    const int aoff = lds_byte(wr * 64 + fr, fq * 8), boff = lds_byte(wc * 32 + fr, fq * 8);
#define PG8_SA(b, h) (((b) * 2 + (h)) * HTB)
#define PG8_SB(b, h) ((4 + (b) * 2 + (h)) * HTB)
#define PG8_STAGE(bufoff, gbase, voff) do { _Pragma("unroll") for (int _i = 0; _i < 2; ++_i) \
        __builtin_amdgcn_global_load_lds((const unsigned*)((const char*)(gbase) + (voff)[_i]), (PG8_LAS unsigned*)(lds + (bufoff) + ldsw + _i * 8192), 16, 0, 0); } while (0)
#define PG8_LDA(dst, b, h) do { _Pragma("unroll") for (int m = 0; m < 4; ++m) _Pragma("unroll") for (int k = 0; k < 2; ++k) dst[m][k] = *(const PG8_LAS bf16x8*)(lds + PG8_SA(b, h) + aoff + m * 2048 + k * 1024); } while (0)
#define PG8_LDB(dst, b, h) do { _Pragma("unroll") for (int n = 0; n < 2; ++n) _Pragma("unroll") for (int k = 0; k < 2; ++k) dst[n][k] = *(const PG8_LAS bf16x8*)(lds + PG8_SB(b, h) + boff + n * 2048 + k * 1024); } while (0)
#define PG8_MMA(ai, bj, At, Bt) do { __builtin_amdgcn_s_setprio(1); _Pragma("unroll") for (int m = 0; m < 4; ++m) _Pragma("unroll") for (int n = 0; n < 2; ++n) _Pragma("unroll") for (int k = 0; k < 2; ++k) \
        acc[ai][bj][m][n] = __builtin_amdgcn_mfma_f32_16x16x32_bf16(Bt[n][k], At[m][k], acc[ai][bj][m][n], 0, 0, 0); __builtin_amdgcn_s_setprio(0); } while (0)
#define PG8_WAIT_V(n) asm volatile("s_waitcnt vmcnt(" #n ")" ::: "memory")
#define PG8_WAIT_L(n) asm volatile("s_waitcnt lgkmcnt(" #n ")" ::: "memory")
#define PG8_BAR __builtin_amdgcn_s_barrier()
#define PG8_SCHED __builtin_amdgcn_sched_barrier(0)
#define PG8_ROWS(dst, u) do { int _t = tid; asm volatile("" : "+v"(_t)); _Pragma("unroll") for (int _i = 0; _i < 2; ++_i) { int _R, _C; stage_rc(_t * 16 + _i * 8192, _R, _C); \
        _Pragma("unroll") for (int _h = 0; _h < 2; ++_h) dst[_h][_i] = S.rowbyte(u, _h * HALF + _R, g.lda) + (unsigned)(_C * 2); } } while (0)
    Unit cur, nxt; int ui = 0;
    if (!S.next(0, cur)) return;
    f32x4 acc[2][2][4][2];
#pragma unroll
    for (int a = 0; a < 2; ++a)
#pragma unroll
        for (int b = 0; b < 2; ++b)
#pragma unroll
            for (int m = 0; m < 4; ++m)
#pragma unroll
                for (int n = 0; n < 2; ++n) acc[a][b][m][n] = (f32x4){0.f, 0.f, 0.f, 0.f};
    bf16x8 At[4][2], B0[2][2], B1[2][2];
    unsigned cvA[2][2], nvA[2][2];
    PG8_ROWS(cvA, cur);
    const char* const gA = (const char*)g.A;
    const char* cB = (const char*)g.Bt + (size_t)cur.e * g.bt_estride * 2 + (size_t)cur.pn * tstepB;
    PG8_STAGE(PG8_SB(0, 0), cB, voffB); PG8_STAGE(PG8_SB(0, 1), cB + hstepB, voffB); PG8_STAGE(PG8_SA(0, 0), gA, cvA[0]); PG8_STAGE(PG8_SA(0, 1), gA, cvA[1]);
    if (wr == 1) PG8_BAR;
    PG8_WAIT_V(2); PG8_BAR;
    PG8_STAGE(PG8_SB(1, 0), cB + kstep, voffB); PG8_STAGE(PG8_SA(1, 0), gA + kstep, cvA[0]); PG8_STAGE(PG8_SB(1, 1), cB + hstepB + kstep, voffB);
    PG8_WAIT_V(6); PG8_BAR;
    for (;;) {
        const bool has_next = S.next(ui + 1, nxt);
        const char* nB = has_next ? (const char*)g.Bt + (size_t)nxt.e * g.bt_estride * 2 + (size_t)nxt.pn * tstepB : cB;
        if (has_next) { PG8_ROWS(nvA, nxt); }
        else {
#pragma unroll
            for (int _h = 0; _h < 2; ++_h)
#pragma unroll
                for (int _i = 0; _i < 2; ++_i) nvA[_h][_i] = cvA[_h][_i];
        }
        for (int t = 0; t < nt; t += 2) {
            const bool last = (t == nt - 2);
            const char* a1 = gA + (size_t)(t + 1) * kstep;
            const char* a2 = last ? gA : gA + (size_t)(t + 2) * kstep; const char* b2 = last ? nB : cB + (size_t)(t + 2) * kstep;
            const char* a3 = a2 + kstep; const char* b3 = b2 + kstep;
            PG8_LDB(B0, 0, 0); PG8_LDB(B1, 0, 1); PG8_SCHED; PG8_LDA(At, 0, 0); PG8_STAGE(PG8_SA(1, 1), a1, cvA[1]);
            PG8_WAIT_V(8); PG8_WAIT_L(0); PG8_BAR; PG8_MMA(0, 0, At, B0); PG8_MMA(0, 1, At, B1); PG8_BAR; PG8_SCHED;
            PG8_LDA(At, 0, 1); PG8_STAGE(PG8_SB(0, 0), b2, voffB); PG8_STAGE(PG8_SB(0, 1), b2 + hstepB, voffB); if (last) PG8_STAGE(PG8_SA(0, 0), a2, nvA[0]); else PG8_STAGE(PG8_SA(0, 0), a2, cvA[0]);
            PG8_WAIT_V(8); PG8_WAIT_L(0); PG8_BAR; PG8_MMA(1, 0, At, B0); PG8_MMA(1, 1, At, B1); PG8_BAR; PG8_SCHED;
            PG8_LDB(B0, 1, 0); PG8_LDB(B1, 1, 1); PG8_SCHED; PG8_LDA(At, 1, 0); if (last) PG8_STAGE(PG8_SA(0, 1), a2, nvA[1]); else PG8_STAGE(PG8_SA(0, 1), a2, cvA[1]);
            PG8_WAIT_V(8); PG8_WAIT_L(0); PG8_BAR; PG8_MMA(0, 0, At, B0); PG8_MMA(0, 1, At, B1); PG8_BAR; PG8_SCHED;
            PG8_LDA(At, 1, 1); PG8_STAGE(PG8_SB(1, 0), b3, voffB); PG8_STAGE(PG8_SB(1, 1), b3 + hstepB, voffB); if (last) PG8_STAGE(PG8_SA(1, 0), a3, nvA[0]); else PG8_STAGE(PG8_SA(1, 0), a3, cvA[0]);
            PG8_WAIT_V(8); PG8_WAIT_L(0); PG8_BAR; PG8_MMA(1, 0, At, B0); PG8_MMA(1, 1, At, B1); PG8_BAR; PG8_SCHED;
        }
        if (wr == 0) PG8_BAR;
        E(acc, cur, wr, wc, fr, fq);
        if (!has_next) break;
#pragma unroll
        for (int a = 0; a < 2; ++a)
#pragma unroll
            for (int b = 0; b < 2; ++b)
#pragma unroll
                for (int m = 0; m < 4; ++m)
#pragma unroll
                    for (int n = 0; n < 2; ++n) acc[a][b][m][n] = (f32x4){0.f, 0.f, 0.f, 0.f};
        cur = nxt; cB = nB; ++ui;
#pragma unroll
        for (int _h = 0; _h < 2; ++_h)
#pragma unroll
            for (int _i = 0; _i < 2; ++_i) cvA[_h][_i] = nvA[_h][_i];
        if (wr == 1) PG8_BAR;
    }
    PG8_WAIT_V(0);
    PG8_BAR;
#undef PG8_SA
#undef PG8_SB
#undef PG8_STAGE
#undef PG8_LDA
#undef PG8_LDB
#undef PG8_MMA
#undef PG8_WAIT_V
#undef PG8_WAIT_L
#undef PG8_BAR
#undef PG8_SCHED
#undef PG8_ROWS
}
}

namespace att {
using s16x4  = __attribute__((ext_vector_type(4))) short;
using f32x16 = __attribute__((ext_vector_type(16))) float;
using f32x2  = __attribute__((ext_vector_type(2))) float;
using u32x4  = __attribute__((ext_vector_type(4))) unsigned;
constexpr int NW = 8, QBLK = 32, KVBLK = 64, LDKV = 2048, LDQ = 1024;
constexpr int SHM_V = KVBLK * ADV * 2, SHM_K = KVBLK * ADH * 2;
constexpr int OFF_V = 0, OFF_K = 4 * SHM_V, OFF_WS = OFF_K + 4 * SHM_K, OFF_LUT = OFF_WS + NW * 64 * 4, LDS_ATT = OFF_LUT + 1024;
constexpr float LOG2E = 1.4426950408889634f, THR2 = 8.f * LOG2E;
#define KSWZ64(row, colB) ((row) * 128 + ((colB) ^ ((((row) >> 1) & 7) << 4)))
#define SBAR() __builtin_amdgcn_sched_barrier(0)
__device__ __forceinline__ int crow(int r, int hi) { return (r & 3) + 8 * (r >> 2) + 4 * hi; }
typedef __bf16 bf2_t __attribute__((ext_vector_type(2)));
__device__ __forceinline__ unsigned cvtpk(float lo, float hi) { const f32x2 v = {lo, hi}; return __builtin_bit_cast(unsigned, __builtin_convertvector(v, bf2_t)); }

__device__ __forceinline__ void sm_max0(const f32x16& p0, float& pmax) {
  pmax = p0[0];
#pragma unroll
  for (int r = 1; r < 16; ++r) pmax = fmaxf(pmax, p0[r]);
}
__device__ __forceinline__ void sm_decide(f32x16& p0, f32x16& p1, float& pmax, float& m_reg, float& alpha, f32x16& ct) {
#pragma unroll
  for (int r = 0; r < 16; ++r) pmax = fmaxf(pmax, p1[r]);
  { auto rr = __builtin_amdgcn_permlane32_swap(__float_as_uint(pmax), __float_as_uint(pmax), false, false);
    pmax = fmaxf(__uint_as_float(rr[0]), __uint_as_float(rr[1])); }
  if (__builtin_expect(__all(pmax <= THR2), 1)) { alpha = 1.f; }
  else { const float d = fmaxf(pmax, 0.f); alpha = __builtin_amdgcn_exp2f(-d); m_reg += d;
#pragma unroll
    for (int r = 0; r < 16; ++r) { p0[r] -= d; p1[r] -= d; ct[r] -= d; } }
}
__device__ __forceinline__ void sm_exp(f32x16& p) {
#pragma unroll
  for (int r = 0; r < 16; ++r) p[r] = __builtin_amdgcn_exp2f(p[r]);
}
__device__ __forceinline__ void sm_first(f32x16& p0, f32x16& p1, float& m_reg) {
  float pmax; sm_max0(p0, pmax);
#pragma unroll
  for (int r = 0; r < 16; ++r) pmax = fmaxf(pmax, p1[r]);
  { auto rr = __builtin_amdgcn_permlane32_swap(__float_as_uint(pmax), __float_as_uint(pmax), false, false);
    pmax = fmaxf(__uint_as_float(rr[0]), __uint_as_float(rr[1])); }
  m_reg = pmax;
#pragma unroll
  for (int r = 0; r < 16; ++r) { p0[r] = __builtin_amdgcn_exp2f(p0[r] - pmax); p1[r] = __builtin_amdgcn_exp2f(p1[r] - pmax); }
}
__device__ __forceinline__ void finishSM(const f32x16& p0, const f32x16& p1, float alpha, float& l_reg, bf16x8& pa0, bf16x8& pa1, bf16x8& pa2, bf16x8& pa3) {
  f32x2 a = {p0[0], p0[1]}, b = {p0[2], p0[3]};
#pragma unroll
  for (int r = 4; r < 16; r += 4) { a += (f32x2){p0[r], p0[r + 1]}; b += (f32x2){p0[r + 2], p0[r + 3]}; }
#pragma unroll
  for (int r = 0; r < 16; r += 4) { a += (f32x2){p1[r], p1[r + 1]}; b += (f32x2){p1[r + 2], p1[r + 3]}; }
  float ps = (a[0] + a[1]) + (b[0] + b[1]);
  { auto rr = __builtin_amdgcn_permlane32_swap(__float_as_uint(ps), __float_as_uint(ps), false, false);
    ps = __uint_as_float(rr[0]) + __uint_as_float(rr[1]); }
  l_reg = l_reg * alpha + ps;
#define PK4(P, BASE, OUT) do { u32x4 w = {cvtpk(P[BASE + 0], P[BASE + 1]), cvtpk(P[BASE + 2], P[BASE + 3]), cvtpk(P[BASE + 4], P[BASE + 5]), cvtpk(P[BASE + 6], P[BASE + 7])}; OUT = *reinterpret_cast<bf16x8*>(&w); } while (0)
  PK4(p0, 0, pa0); PK4(p0, 8, pa1); PK4(p1, 0, pa2); PK4(p1, 8, pa3);
#undef PK4
}
#ifndef ATT_BIGSUM_LOG2
#define ATT_BIGSUM_LOG2 17.5f
#endif
template <int A, int B> __device__ __forceinline__ void sm_expr(f32x16& p) {
#pragma unroll
  for (int r = A; r < B; ++r) p[r] = __builtin_amdgcn_exp2f(p[r]);
}
template <int H> __device__ __forceinline__ void sm_exp8(f32x16& p) {
#pragma unroll
  for (int r = 8 * H; r < 8 * H + 8; ++r) p[r] = __builtin_amdgcn_exp2f(p[r]);
}
__device__ __forceinline__ float sm_rowsum(const f32x16& p0, const f32x16& p1) {
  f32x2 a = {p0[0], p0[1]}, b = {p0[2], p0[3]};
#pragma unroll
  for (int r = 4; r < 16; r += 4) { a += (f32x2){p0[r], p0[r + 1]}; b += (f32x2){p0[r + 2], p0[r + 3]}; }
#pragma unroll
  for (int r = 0; r < 16; r += 4) { a += (f32x2){p1[r], p1[r + 1]}; b += (f32x2){p1[r + 2], p1[r + 3]}; }
  float ps = (a[0] + a[1]) + (b[0] + b[1]);
  { auto rr = __builtin_amdgcn_permlane32_swap(__float_as_uint(ps), __float_as_uint(ps), false, false);
    ps = __uint_as_float(rr[0]) + __uint_as_float(rr[1]); }
  return ps;
}
__device__ __forceinline__ void sm_pack(const f32x16& p0, const f32x16& p1, bf16x8& pa0, bf16x8& pa1, bf16x8& pa2, bf16x8& pa3) {
#define PK4(P, BASE, OUT) do { u32x4 w = {cvtpk(P[BASE + 0], P[BASE + 1]), cvtpk(P[BASE + 2], P[BASE + 3]), cvtpk(P[BASE + 4], P[BASE + 5]), cvtpk(P[BASE + 6], P[BASE + 7])}; OUT = *reinterpret_cast<bf16x8*>(&w); } while (0)
  PK4(p0, 0, pa0); PK4(p0, 8, pa1); PK4(p1, 0, pa2); PK4(p1, 8, pa3);
#undef PK4
}
template <int KOFF> __device__ __forceinline__ void qkt_far(f32x16& p0, f32x16& p1, const f32x16& ct, const int* kb, const bf16x8* qr) {
  bf16x8 b0[4], b1[4];
#pragma unroll
  for (int d0 = 0; d0 < 4; ++d0) { b0[d0] = *(const PG8_LAS bf16x8*)(unsigned)(kb[d0] + KOFF); b1[d0] = *(const PG8_LAS bf16x8*)(unsigned)(kb[d0] + KOFF + 4096); }
  SBAR();
#pragma unroll
  for (int d0 = 0; d0 < 4; ++d0) {
    if (d0 == 0) { p0 = __builtin_amdgcn_mfma_f32_32x32x16_bf16(b0[0], qr[0], ct, 0, 0, 0); p1 = __builtin_amdgcn_mfma_f32_32x32x16_bf16(b1[0], qr[0], ct, 0, 0, 0); }
    else { p0 = __builtin_amdgcn_mfma_f32_32x32x16_bf16(b0[d0], qr[d0], p0, 0, 0, 0); p1 = __builtin_amdgcn_mfma_f32_32x32x16_bf16(b1[d0], qr[d0], p1, 0, 0, 0); } }
}
template <int MODE> __device__ __forceinline__ void qkt(f32x16& p0, f32x16& p1, const f32x16& ct, const char* Ks, const bf16x8* qr, int r32, int hi) {
  bf16x8 b0[4], b1[4];
#pragma unroll
  for (int d0 = 0; d0 < 4; ++d0) { const int cb = (d0 * 16 + hi * 8) * 2;
    b0[d0] = *reinterpret_cast<const bf16x8*>(Ks + KSWZ64(r32, cb)); b1[d0] = *reinterpret_cast<const bf16x8*>(Ks + KSWZ64(32 + r32, cb)); }
  SBAR();
#pragma unroll
  for (int d0 = 0; d0 < 4; ++d0) {
    if (MODE == 0 && d0 == 0) { p0 = __builtin_amdgcn_mfma_f32_32x32x16_bf16(b0[0], qr[0], ct, 0, 0, 0); p1 = __builtin_amdgcn_mfma_f32_32x32x16_bf16(b1[0], qr[0], ct, 0, 0, 0); }
    else { p0 = __builtin_amdgcn_mfma_f32_32x32x16_bf16(b0[d0], qr[d0], p0, 0, 0, 0); p1 = __builtin_amdgcn_mfma_f32_32x32x16_bf16(b1[d0], qr[d0], p1, 0, 0, 0); } }
}
__device__ __forceinline__ void p_init(f32x16& p0, f32x16& p1, int j, int cq, int qoff, int hi, const float* lut, float m_reg) {
  if (j > cq) {
#pragma unroll
    for (int r = 0; r < 16; ++r) { p0[r] = -1e30f; p1[r] = -1e30f; }
  } else {
    const float* lp = lut + (64 * (j - cq) - qoff + 192 + 4 * hi);
#pragma unroll
    for (int r = 0; r < 16; ++r) { p0[r] = lp[(r & 3) + 8 * (r >> 2)] - m_reg; p1[r] = lp[32 + (r & 3) + 8 * (r >> 2)] - m_reg; }
  }
}
#define QK_TILE(p0, p1, j, Ks) do { if ((j) < cq - 2) qkt<0>(p0, p1, ct, Ks, qr, r32, hi); else { p_init(p0, p1, j, cq, qoff, hi, lut, m_reg); qkt<1>(p0, p1, ct, Ks, qr, r32, hi); } } while (0)
__device__ __forceinline__ int v_st(int k, int c) { const int kk = (k & ~0xC) | ((k & 4) << 1) | ((k & 8) >> 1); return ((kk >> 3) * 4 + (c >> 5)) * 512 + ((kk & 7) * 32 + (c & 31)) * 2; }
__device__ __forceinline__ int v_rd_base(int lane) { return ((lane & 3) << 3) | (((lane >> 2) & 3) << 6) | (((lane >> 4) & 1) << 5) | (((lane >> 5) & 1) << 11); }
constexpr int v_rd_off(int d0, int ks, int half) { return d0 * 512 + ks * 4096 + half * 256; }
template <int OFF> __device__ __forceinline__ s16x4 tr_read(int vb) {
  s16x4 r; asm volatile("ds_read_b64_tr_b16 %0, %1 offset:%2" : "=&v"(r) : "v"(vb), "i"(OFF) : "memory"); return r;
}
struct VFrag { s16x4 l0, h0, l1, h1, l2, h2, l3, h3; };
template <int D0, int SOFF = 0> __device__ __forceinline__ void pv_load(VFrag& f, int vb) {
  f.l0 = tr_read<SOFF + v_rd_off(D0, 0, 0)>(vb); f.h0 = tr_read<SOFF + v_rd_off(D0, 0, 1)>(vb); f.l1 = tr_read<SOFF + v_rd_off(D0, 1, 0)>(vb); f.h1 = tr_read<SOFF + v_rd_off(D0, 1, 1)>(vb);
  f.l2 = tr_read<SOFF + v_rd_off(D0, 2, 0)>(vb); f.h2 = tr_read<SOFF + v_rd_off(D0, 2, 1)>(vb); f.l3 = tr_read<SOFF + v_rd_off(D0, 3, 0)>(vb); f.h3 = tr_read<SOFF + v_rd_off(D0, 3, 1)>(vb);
}
__device__ __forceinline__ void pv_mma(f32x16& od, const VFrag& f, bf16x8 pa0, bf16x8 pa1, bf16x8 pa2, bf16x8 pa3) {
#define PK(L, H) (bf16x8){L[0], L[1], L[2], L[3], H[0], H[1], H[2], H[3]}
  od = __builtin_amdgcn_mfma_f32_32x32x16_bf16(pa0, PK(f.l0, f.h0), od, 0, 0, 0);
  od = __builtin_amdgcn_mfma_f32_32x32x16_bf16(pa1, PK(f.l1, f.h1), od, 0, 0, 0);
  od = __builtin_amdgcn_mfma_f32_32x32x16_bf16(pa2, PK(f.l2, f.h2), od, 0, 0, 0);
  od = __builtin_amdgcn_mfma_f32_32x32x16_bf16(pa3, PK(f.l3, f.h3), od, 0, 0, 0);
#undef PK
}
#define PV_LGK(n) do { asm volatile("s_waitcnt lgkmcnt(" #n ")" ::: "memory"); SBAR(); } while (0)
#define PV_PRE(vb) VFrag fA_, fB_; pv_load<0>(fA_, vb); pv_load<1>(fB_, vb)
#define PV_PRE_S(SO) VFrag fA_, fB_; pv_load<0, SO>(fA_, vb0); pv_load<1, SO>(fB_, vb0)
#define PV_WITH_SM_S(o, SO, pa0, pa1, pa2, pa3, q0, q1) do {   \
    PV_LGK(8); pv_mma(o[0], fA_, pa0, pa1, pa2, pa3); sm_expr<0, 11>(q0); asm volatile("" : "+v"(q0)); \
    pv_load<2, SO>(fA_, vb0); PV_LGK(8); pv_mma(o[1], fB_, pa0, pa1, pa2, pa3); sm_expr<11, 16>(q0); sm_expr<0, 6>(q1); asm volatile("" : "+v"(q0), "+v"(q1)); \
    pv_load<3, SO>(fB_, vb0); PV_LGK(8); pv_mma(o[2], fA_, pa0, pa1, pa2, pa3); sm_expr<6, 16>(q1); asm volatile("" : "+v"(q1)); \
    PV_LGK(0); pv_mma(o[3], fB_, pa0, pa1, pa2, pa3); } while (0)
#define PV_WITH_SM(o, vb, pa0, pa1, pa2, pa3, q0, q1) do { \
    PV_LGK(8); pv_mma(o[0], fA_, pa0, pa1, pa2, pa3); sm_exp8<0>(q0); asm volatile("" : "+v"(q0)); \
    pv_load<2>(fA_, vb); PV_LGK(8); pv_mma(o[1], fB_, pa0, pa1, pa2, pa3); sm_exp8<1>(q0); asm volatile("" : "+v"(q0)); \
    pv_load<3>(fB_, vb); PV_LGK(8); pv_mma(o[2], fA_, pa0, pa1, pa2, pa3); sm_exp8<0>(q1); asm volatile("" : "+v"(q1)); \
    PV_LGK(0); pv_mma(o[3], fB_, pa0, pa1, pa2, pa3); sm_exp8<1>(q1); asm volatile("" : "+v"(q1)); } while (0)
#define PV_ONLY(o, vb, pa0, pa1, pa2, pa3) do { \
    PV_LGK(8); pv_mma(o[0], fA_, pa0, pa1, pa2, pa3); pv_load<2>(fA_, vb); PV_LGK(8); pv_mma(o[1], fB_, pa0, pa1, pa2, pa3); \
    pv_load<3>(fB_, vb); PV_LGK(8); pv_mma(o[2], fA_, pa0, pa1, pa2, pa3); PV_LGK(0); pv_mma(o[3], fB_, pa0, pa1, pa2, pa3); } while (0)

__device__ __forceinline__ void attn_unit(const int FIN, const bf16_t* __restrict__ Qb, const bf16_t* __restrict__ Kh, const bf16_t* __restrict__ Vh, bf16_t* __restrict__ Ob, float* __restrict__ park,
                                                             float lam, const float* __restrict__ g_sub, float gscale, int qb, char* lds, int tid) {
  const int wid = __builtin_amdgcn_readfirstlane(tid >> 6), lane = tid & 63, r32 = lane & 31, hi = lane >> 5;
  char* V_lds = lds + OFF_V; char* K_lds = lds + OFF_K;
  float* ws = (float*)(lds + OFF_WS) + wid * 64; float* li_l = ws; float* al_l = ws + 32;
  const float* lut = (const float*)(lds + OFF_LUT);
  const float cfar = lut[0];
  const int cq = 4 * qb + (wid >> 1), qoff = 32 * (wid & 1) + r32;
  float m_reg = 0.f, l_reg = 0; f32x16 o[4] = {}; bf16x8 qr[4]; f32x16 ct;
  const bf16_t* Qw = Qb + (size_t)(wid * QBLK + r32) * LDQ + hi * 8;
#pragma unroll
  for (int d0 = 0; d0 < 4; ++d0) qr[d0] = *reinterpret_cast<const bf16x8*>(Qw + d0 * 16);
  const int kq = wid * 64 + lane, krow = kq >> 3, kcs = (kq & 7) ^ ((krow >> 1) & 7);
  const unsigned kgb = (unsigned)(krow * LDKV + kcs * 8) * 2u;
  unsigned vgb[2];
#pragma unroll
  for (int i = 0; i < 2; ++i) { const int P = ((i * 8 + wid) * 64 + lane) * 16, sub = P >> 9, rem = P & 511, kk = (sub >> 2) * 8 + (rem >> 6), c = (sub & 3) * 32 + ((rem & 63) >> 1);
    const int k = (kk & ~0xC) | ((kk & 4) << 1) | ((kk & 8) >> 1); vgb[i] = (unsigned)(k * LDKV + c) * 2u; }
  const __amdgpu_buffer_rsrc_t krs = __builtin_amdgcn_make_buffer_rsrc((void*)Kh, 0, 0x08000000, 0x00020000), vrs = __builtin_amdgcn_make_buffer_rsrc((void*)Vh, 0, 0x08000000, 0x00020000);
  const int vb0 = (int)(uintptr_t)V_lds + v_rd_base(lane);
  PG8_LAS unsigned char* const ldsl = (PG8_LAS unsigned char*)lds;
#define GLD(t) do { const unsigned so_ = (unsigned)(t) * (unsigned)(KVBLK * LDKV * 2); const int sl_ = (t) & 3; \
    __builtin_amdgcn_raw_ptr_buffer_load_lds(krs, (PG8_LAS void*)(ldsl + OFF_K + sl_ * SHM_K + wid * 1024), 16, kgb, so_, 0, 0); \
    __builtin_amdgcn_raw_ptr_buffer_load_lds(vrs, (PG8_LAS void*)(ldsl + OFF_V + sl_ * SHM_V + wid * 1024), 16, vgb[0], so_, 0, 0); \
    __builtin_amdgcn_raw_ptr_buffer_load_lds(vrs, (PG8_LAS void*)(ldsl + OFF_V + sl_ * SHM_V + (8 + wid) * 1024), 16, vgb[1], so_, 0, 0); } while (0)
#define TILE_BAR(n) do { asm volatile("s_waitcnt vmcnt(" #n ")" ::: "memory"); __builtin_amdgcn_s_barrier(); asm volatile("" ::: "memory"); } while (0)
#define RESC(a) do { if (__any((a) < 1.f)) { if (hi == 0) al_l[r32] = (a); asm volatile("s_waitcnt lgkmcnt(0)" ::: "memory"); \
    _Pragma("unroll") for (int d = 0; d < 4; ++d) _Pragma("unroll") for (int r = 0; r < 16; ++r) o[d][r] *= al_l[crow(r, hi)]; } } while (0)
  f32x16 pA0, pA1, pB0, pB1; float alA = 1.f, alB; bf16x8 pa0, pa1, pa2, pa3; const int NT = 4 * qb + 4;
  constexpr int SE = 0, SO = 1;
  GLD(0); GLD(1); TILE_BAR(3);
  if (0 < cq - 2) {
#pragma unroll
    for (int r = 0; r < 16; ++r) { pA0[r] = cfar; pA1[r] = cfar; }
  } else p_init(pA0, pA1, 0, cq, qoff, hi, lut, 0.f);
  qkt<1>(pA0, pA1, ct, K_lds, qr, r32, hi); sm_first(pA0, pA1, m_reg);
#pragma unroll
  for (int r = 0; r < 16; ++r) ct[r] = cfar - m_reg;
  GLD(2); TILE_BAR(3);
#define FIN_SM(pC0, pC1, pN0, pN1, HASN) do { float ps_ = sm_rowsum(pC0, pC1); \
    if (__builtin_expect(__any(ps_ > BIGSUM), 0)) { const float d_ = ps_ > BIGSUM ? __builtin_amdgcn_logf(ps_) : 0.f, a_ = __builtin_amdgcn_exp2f(-d_); \
      m_reg += d_; ps_ *= a_; l_reg *= a_; \
      _Pragma("unroll") for (int r = 0; r < 16; ++r) { pC0[r] *= a_; pC1[r] *= a_; ct[r] -= d_; if (HASN) { pN0[r] -= d_; pN1[r] -= d_; } } \
      RESC(a_); } \
    l_reg += ps_; sm_pack(pC0, pC1, pa0, pa1, pa2, pa3); } while (0)
  const float BIGSUM = __builtin_amdgcn_exp2f(ATT_BIGSUM_LOG2);
#define GLD_S(t, SL) do { const unsigned so_ = (unsigned)(t) * (unsigned)(KVBLK * LDKV * 2); \
    __builtin_amdgcn_raw_ptr_buffer_load_lds(krs, (PG8_LAS void*)(ldsl + OFF_K + (SL) * SHM_K + wid * 1024), 16, kgb, so_, 0, 0); \
    __builtin_amdgcn_raw_ptr_buffer_load_lds(vrs, (PG8_LAS void*)(ldsl + OFF_V + (SL) * SHM_V + wid * 1024), 16, vgb[0], so_, 0, 0); \
    __builtin_amdgcn_raw_ptr_buffer_load_lds(vrs, (PG8_LAS void*)(ldsl + OFF_V + (SL) * SHM_V + (8 + wid) * 1024), 16, vgb[1], so_, 0, 0); } while (0)
#define FAR_STEP(pN0, pN1, pC0, pC1, T_, SK, SV, CHK) do { { SBAR(); qkt_far<(SK) * SHM_K>(pN0, pN1, ct, kbl, qr); \
    asm volatile("s_waitcnt lgkmcnt(0)" ::: "memory"); SBAR(); PV_PRE_S((SV) * SHM_V); SBAR(); \
    FIN_SM(pC0, pC1, pN0, pN1, true); SBAR(); \
    GLD_S((T_) + 2, ((SK) + 2) & 3); SBAR(); \
    PV_WITH_SM_S(o, (SV) * SHM_V, pa0, pa1, pa2, pa3, pN0, pN1); } \
    TILE_BAR(3); } while (0)
  int kbl[4];
#pragma unroll
  for (int d0 = 0; d0 < 4; ++d0) { kbl[d0] = (int)(uintptr_t)K_lds + KSWZ64(r32, (d0 * 16 + hi * 8) * 2); asm volatile("" : "+v"(kbl[d0])); }
  const int nfar4 = qb > 0 ? qb - 1 : 0;
#pragma unroll 1
  for (int g4 = 0; g4 < nfar4; ++g4) { const int t0_ = 4 * g4 + 1;
    FAR_STEP(pB0, pB1, pA0, pA1, t0_, 1, 0, 0); FAR_STEP(pA0, pA1, pB0, pB1, t0_ + 1, 2, 1, 0); FAR_STEP(pB0, pB1, pA0, pA1, t0_ + 2, 3, 2, 0); FAR_STEP(pA0, pA1, pB0, pB1, t0_ + 3, 0, 3, 0); }
#undef FAR_STEP
#undef GLD_S
  for (int j = 4 * nfar4 + 1; j + 1 < NT; j += 2) {
    { SBAR(); QK_TILE(pB0, pB1, j, K_lds + (j & 3) * SHM_K);
    asm volatile("s_waitcnt lgkmcnt(0)" ::: "memory"); SBAR(); PV_PRE(vb0 + ((j - 1) & 3) * SHM_V); SBAR();
    FIN_SM(pA0, pA1, pB0, pB1, true); SBAR();
    GLD(j + 2); SBAR();
    PV_WITH_SM(o, vb0 + ((j - 1) & 3) * SHM_V, pa0, pa1, pa2, pa3, pB0, pB1); }
    TILE_BAR(3);
    { SBAR(); QK_TILE(pA0, pA1, j + 1, K_lds + ((j + 1) & 3) * SHM_K);
    asm volatile("s_waitcnt lgkmcnt(0)" ::: "memory"); SBAR(); PV_PRE(vb0 + (j & 3) * SHM_V); SBAR();
    FIN_SM(pB0, pB1, pA0, pA1, true); SBAR();
    if (j + 3 < NT) { GLD(j + 3); } SBAR();
    PV_WITH_SM(o, vb0 + (j & 3) * SHM_V, pa0, pa1, pa2, pa3, pA0, pA1); }
    if (j + 3 < NT) TILE_BAR(3); else TILE_BAR(0);
  }
  { SBAR(); QK_TILE(pB0, pB1, NT - 1, K_lds + ((NT - 1) & 3) * SHM_K);
  { asm volatile("s_waitcnt lgkmcnt(0)" ::: "memory"); SBAR(); PV_PRE(vb0 + ((NT - 2) & 3) * SHM_V); SBAR();
  FIN_SM(pA0, pA1, pB0, pB1, true); SBAR();
  PV_WITH_SM(o, vb0 + ((NT - 2) & 3) * SHM_V, pa0, pa1, pa2, pa3, pB0, pB1); }
  { asm volatile("s_waitcnt lgkmcnt(0)" ::: "memory"); SBAR(); PV_PRE(vb0 + ((NT - 1) & 3) * SHM_V); SBAR();
  FIN_SM(pB0, pB1, pB0, pB1, false); SBAR();
  PV_ONLY(o, vb0 + ((NT - 1) & 3) * SHM_V, pa0, pa1, pa2, pa3); } }
#undef FIN_SM
  if (hi == 0) li_l[r32] = l_reg; asm volatile("s_waitcnt lgkmcnt(0)" ::: "memory");
  float rli[16];
#pragma unroll
  for (int r = 0; r < 16; ++r) rli[r] = __builtin_amdgcn_rcpf(li_l[crow(r, hi)]);
  float* pk = park + (size_t)wid * 4096 + lane;
  if (FIN == 0) {
#pragma unroll
    for (int r = 0; r < 16; ++r)
#pragma unroll
      for (int d0 = 0; d0 < 4; ++d0) pk[(r * 4 + d0) * 64] = o[d0][r] * rli[r];
  } else {
    float ss[16];
#pragma unroll
    for (int r = 0; r < 16; ++r) { float q = 0.f;
#pragma unroll
      for (int d0 = 0; d0 < 4; ++d0) { const float x = pk[(r * 4 + d0) * 64] - lam * (o[d0][r] * rli[r]); o[d0][r] = x; q += x * x; }
      ss[r] = q; }
    halve_step<16, 16>(ss, lane); halve_step<8, 8>(ss, lane); halve_step<4, 4>(ss, lane); halve_step<2, 2>(ss, lane); ss[0] += __shfl_xor(ss[0], 1);
    if ((lane & 1) == 0) al_l[hi * 16 + ((lane >> 4) & 1) * 8 + ((lane >> 3) & 1) * 4 + ((lane >> 2) & 1) * 2 + ((lane >> 1) & 1)] = rsqrtf(ss[0] * (1.f / ADV) + LN_EPS) * gscale;
    asm volatile("s_waitcnt lgkmcnt(0)" ::: "memory");
    float gs[4];
#pragma unroll
    for (int d0 = 0; d0 < 4; ++d0) gs[d0] = g_sub[d0 * 32 + r32];
    bf16_t* Ow = Ob + (size_t)(wid * QBLK) * LDQ;
#pragma unroll
    for (int r = 0; r < 16; ++r) { const int orow = crow(r, hi); const float rs = al_l[hi * 16 + r];
#pragma unroll
      for (int d0 = 0; d0 < 4; ++d0) Ow[(size_t)orow * LDQ + d0 * 32 + r32] = f2bf(o[d0][r] * rs * gs[d0]); }
  }
  __syncthreads();
#undef GLD
#undef TILE_BAR
#undef RESC
}
__device__ __forceinline__ void attn_phase(const bf16_t* Q, const bf16_t* KV, float* park, bf16_t* OB, const float* rel_table, const float* lq1, const float* lk1, const float* lq2, const float* lk2, const float* g_sub,
                                           float lambda_init, char* lds, int tid) {
  const int bx = blockIdx.x, xcd = bx & 7, slot = bx >> 3, combo = xcd * 2 + (slot >> 4), wi = slot & 15;
  const int h = combo & 7, b = combo >> 3, lane = tid & 63;
  float* lut = (float*)(lds + OFF_LUT);
  if (tid < 256) lut[tid] = rel_table[rel_bucket_dev(tid - 192) * AH + h] * LOG2E;
  __syncthreads();
  const float lam = __uint_as_float(__builtin_amdgcn_readfirstlane(__float_as_uint(__expf(wave_sum(lq1[lane] * lk1[lane])) - __expf(wave_sum(lq2[lane] * lk2[lane])) + lambda_init)));
  const bf16_t* K1 = KV + (size_t)b * SEQ * LDKV + h * ADH;
  const bf16_t* Vh = KV + (size_t)b * SEQ * LDKV + 1024 + h * ADV;
  float* pk = park + (size_t)bx * (NW * 4096);
#pragma unroll 1
  for (int u = 0; u < 8; ++u) {
    const int i = u >> 1, m = u & 1, g = i >> 1, qb = (i & 1) ? (32 * g + 31 - wi) : (32 * g + wi);
    const size_t row0 = (size_t)b * SEQ + (size_t)qb * 256;
    int t2 = tid; asm volatile("" : "+v"(t2));
    attn_unit(m, Q + row0 * LDQ + m * 512 + h * ADH, K1 + m * 512, Vh, OB + row0 * LDQ + h * ADV, pk, lam, g_sub, 1.f - lambda_init, qb, lds, t2);
  }
}
#undef KSWZ64
#undef SBAR
#undef QK_TILE
#undef PV_LGK
#undef PV_PRE
#undef PV_WITH_SM
#undef PV_ONLY
}

namespace gla {
using s16x4  = __attribute__((ext_vector_type(4))) short;
using f32x16 = __attribute__((ext_vector_type(16))) float;
using u32x4  = __attribute__((ext_vector_type(4))) unsigned;
typedef __bf16 bf2_t __attribute__((ext_vector_type(2)));
typedef float f2_t __attribute__((ext_vector_type(2)));
constexpr int GRP = 8, NGRP = NCH / GRP, NUNIT = NB * GH * NGRP;
constexpr int KP = 320, VP = 576, QP = 272;
constexpr int OFF_KD = 0, OFF_V = OFF_KD + 64 * KP, OFF_Q = OFF_V + 64 * VP, OFF_DEC = OFF_Q + 64 * QP, OFF_SS = OFF_DEC + 512, OFF_RS = OFF_SS + 8 * 64 * 4, LDS_GLA = OFF_RS + 256;
constexpr size_t LS_UNIT = (size_t)GDK * GDV;
__device__ __forceinline__ int crow(int r, int hi) { return (r & 3) + 8 * (r >> 2) + 4 * hi; }
__device__ __forceinline__ unsigned cvtpk2(float lo, float hi) { const f2_t v = {lo, hi}; return __builtin_bit_cast(unsigned, __builtin_convertvector(v, bf2_t)); }
template <int OFF> __device__ __forceinline__ s16x4 tr_read(int a) { s16x4 r; asm volatile("ds_read_b64_tr_b16 %0, %1 offset:%2" : "=&v"(r) : "v"(a), "i"(OFF) : "memory"); return r; }
#define GLA_PK(L, H) (bf16x8){L[0], L[1], L[2], L[3], H[0], H[1], H[2], H[3]}

template <bool WITH_O>
__device__ __forceinline__ void scan_unit(bf16_t* __restrict__ qkvr, const float* __restrict__ dec, float* __restrict__ LS, float* __restrict__ GD, const float* __restrict__ g_norm, bf16_t* __restrict__ yout, int ystride, int u, char* lds, int tid) {
  const int wid = __builtin_amdgcn_readfirstlane(tid >> 6), lane = tid & 63, r32 = lane & 31, hi = lane >> 5;
  const int g = u & (NGRP - 1), h = (u >> 5) & 3, b = u >> 7;
  const size_t tokg = (size_t)b * SEQ + (size_t)g * GRP * CHUNK;
  const int ldsb = (int)(uintptr_t)lds;
  const int i16 = lane & 15, tq = i16 >> 2, tp = i16 & 3, blk = (lane >> 4) & 1;
  const int kbase = ldsb + OFF_KD + (8 * hi + tq) * KP + (16 * blk + 4 * tp) * 2;
  const int vbase = ldsb + OFF_V + (8 * hi + tq) * VP + (32 * wid + 16 * blk + 4 * tp) * 2;
  f32x16 st[4];
  float* Lu = LS + (size_t)u * LS_UNIT;
  if (WITH_O) {
#pragma unroll
    for (int kt = 0; kt < 4; ++kt)
#pragma unroll
      for (int r = 0; r < 16; ++r) st[kt][r] = Lu[(size_t)(32 * kt + crow(r, hi)) * GDV + 32 * wid + r32];
  } else {
#pragma unroll
    for (int kt = 0; kt < 4; ++kt)
#pragma unroll
      for (int r = 0; r < 16; ++r) st[kt][r] = 0.f;
  }
  float gdec = 1.f;
  uint4 kd0, kd1, v0, v1, v2, v3, q0, q1; f32x4 dc_r;
  const int pr = tid >> 4, pc = (tid & 15) * 8;
  const int vr = tid >> 5, vc = (tid & 31) * 8;
#define GLA_LOAD(c) do { const bf16_t* gp = qkvr + (tokg + (size_t)(c) * CHUNK) * GQKVR; \
    kd0 = *(const uint4*)(gp + (size_t)pr * GQKVR + GHK + h * GDK + pc); kd1 = *(const uint4*)(gp + (size_t)(pr + 32) * GQKVR + GHK + h * GDK + pc); \
    if (WITH_O) { q0 = *(const uint4*)(gp + (size_t)pr * GQKVR + h * GDK + pc); q1 = *(const uint4*)(gp + (size_t)(pr + 32) * GQKVR + h * GDK + pc); } \
    v0 = *(const uint4*)(gp + (size_t)vr * GQKVR + 1024 + h * GDV + vc); v1 = *(const uint4*)(gp + (size_t)(vr + 16) * GQKVR + 1024 + h * GDV + vc); \
    v2 = *(const uint4*)(gp + (size_t)(vr + 32) * GQKVR + 1024 + h * GDV + vc); v3 = *(const uint4*)(gp + (size_t)(vr + 48) * GQKVR + 1024 + h * GDV + vc); \
    if (tid < 32) dc_r = *(const f32x4*)(dec + ((size_t)b * NCH + (size_t)g * GRP + (c)) * GHK + h * GDK + tid * 4); } while (0)
#define GLA_STORE() do { \
    *(uint4*)(lds + OFF_KD + pr * KP + pc * 2) = kd0; *(uint4*)(lds + OFF_KD + (pr + 32) * KP + pc * 2) = kd1; \
    if (WITH_O) { *(uint4*)(lds + OFF_Q + pr * QP + pc * 2) = q0; *(uint4*)(lds + OFF_Q + (pr + 32) * QP + pc * 2) = q1; } \
    *(uint4*)(lds + OFF_V + vr * VP + vc * 2) = v0; *(uint4*)(lds + OFF_V + (vr + 16) * VP + vc * 2) = v1; \
    *(uint4*)(lds + OFF_V + (vr + 32) * VP + vc * 2) = v2; *(uint4*)(lds + OFF_V + (vr + 48) * VP + vc * 2) = v3; \
    if (tid < 32) *(f32x4*)(lds + OFF_DEC + tid * 16) = dc_r; } while (0)
  GLA_LOAD(0);
#pragma unroll 1
  for (int c = 0; c < GRP; ++c) {
    const size_t t0 = tokg + (size_t)c * CHUNK;
    GLA_STORE();
    __syncthreads();
    if (!WITH_O && tid < 128) gdec *= ((const float*)(lds + OFF_DEC))[tid];
    if (c + 1 < GRP) GLA_LOAD(c + 1);
#pragma unroll
    for (int kt = 0; kt < 4; ++kt)
#pragma unroll
      for (int g4 = 0; g4 < 4; ++g4) { const f32x4 d = *(const f32x4*)(lds + OFF_DEC + (32 * kt + 8 * g4 + 4 * hi) * 4);
#pragma unroll
        for (int i = 0; i < 4; ++i) st[kt][4 * g4 + i] *= d[i]; }
#define GLA_STEP(S) do { const s16x4 bl = tr_read<(16 * (S)) * VP>(vbase), bh_ = tr_read<(16 * (S) + 4) * VP>(vbase); \
      const s16x4 a0l = tr_read<(16 * (S)) * KP + 0>(kbase), a0h = tr_read<(16 * (S) + 4) * KP + 0>(kbase), a1l = tr_read<(16 * (S)) * KP + 64>(kbase), a1h = tr_read<(16 * (S) + 4) * KP + 64>(kbase); \
      const s16x4 a2l = tr_read<(16 * (S)) * KP + 128>(kbase), a2h = tr_read<(16 * (S) + 4) * KP + 128>(kbase), a3l = tr_read<(16 * (S)) * KP + 192>(kbase), a3h = tr_read<(16 * (S) + 4) * KP + 192>(kbase); \
      asm volatile("s_waitcnt lgkmcnt(0)" ::: "memory"); __builtin_amdgcn_sched_barrier(0); \
      const bf16x8 bv = GLA_PK(bl, bh_); \
      st[0] = __builtin_amdgcn_mfma_f32_32x32x16_bf16(GLA_PK(a0l, a0h), bv, st[0], 0, 0, 0); st[1] = __builtin_amdgcn_mfma_f32_32x32x16_bf16(GLA_PK(a1l, a1h), bv, st[1], 0, 0, 0); \
      st[2] = __builtin_amdgcn_mfma_f32_32x32x16_bf16(GLA_PK(a2l, a2h), bv, st[2], 0, 0, 0); st[3] = __builtin_amdgcn_mfma_f32_32x32x16_bf16(GLA_PK(a3l, a3h), bv, st[3], 0, 0, 0); } while (0)
    GLA_STEP(0); GLA_STEP(1); GLA_STEP(2); GLA_STEP(3);
#undef GLA_STEP
    if (WITH_O) {
      f32x16 oa[2];
#pragma unroll
      for (int rt = 0; rt < 2; ++rt)
#pragma unroll
        for (int r = 0; r < 16; ++r) oa[rt][r] = 0.f;
#pragma unroll
      for (int kt = 0; kt < 4; ++kt)
#pragma unroll
        for (int s = 0; s < 2; ++s) {
          u32x4 pw; pw.x = cvtpk2(st[kt][8 * s + 0], st[kt][8 * s + 1]); pw.y = cvtpk2(st[kt][8 * s + 2], st[kt][8 * s + 3]); pw.z = cvtpk2(st[kt][8 * s + 4], st[kt][8 * s + 5]); pw.w = cvtpk2(st[kt][8 * s + 6], st[kt][8 * s + 7]);
          const bf16x8 bs = __builtin_bit_cast(bf16x8, pw);
#pragma unroll
          for (int rt = 0; rt < 2; ++rt) {
            const char* qp = lds + OFF_Q + (32 * rt + r32) * QP + (32 * kt + 16 * s + 4 * hi) * 2;
            const s16x4 ql = *(const s16x4*)qp, qh = *(const s16x4*)(qp + 16);
            oa[rt] = __builtin_amdgcn_mfma_f32_32x32x16_bf16(GLA_PK(ql, qh), bs, oa[rt], 0, 0, 0);
          }
        }
      float* SS = (float*)(lds + OFF_SS); float* RS = (float*)(lds + OFF_RS);
      { float x[32];
#pragma unroll
        for (int rt = 0; rt < 2; ++rt)
#pragma unroll
          for (int r = 0; r < 16; ++r) x[rt * 16 + r] = oa[rt][r] * oa[rt][r];
        halve_step<32, 16>(x, lane); halve_step<16, 8>(x, lane); halve_step<8, 4>(x, lane); halve_step<4, 2>(x, lane); halve_step<2, 1>(x, lane);
        SS[wid * 64 + 32 * (r32 >> 4) + crow(r32 & 15, hi)] = x[0]; }
      __syncthreads();
      if (tid < 64) { float s = 0.f;
#pragma unroll
        for (int w = 0; w < 8; ++w) s += SS[w * 64 + tid];
        RS[tid] = rsqrtf(s * (1.f / GDV) + LN_EPS); }
      __syncthreads();
      constexpr int YP = 528;
#pragma unroll
      for (int rt = 0; rt < 2; ++rt)
#pragma unroll
        for (int g4 = 0; g4 < 4; ++g4) { const f32x4 rs = *(const f32x4*)(RS + 32 * rt + 8 * g4 + 4 * hi);
#pragma unroll
          for (int i = 0; i < 4; ++i) *(bf16_t*)(lds + OFF_V + (32 * rt + 8 * g4 + 4 * hi + i) * YP + (32 * wid + r32) * 2) = f2bf(oa[rt][4 * g4 + i] * rs[i]); }
      __syncthreads();
#pragma unroll
      for (int i = 0; i < 4; ++i) { const int p = tid + 512 * i, tt = p >> 5, c8 = (p & 31) * 8;
        const uint4 yv = *(const uint4*)(lds + OFF_V + tt * YP + c8 * 2);
        const size_t tok = t0 + tt;
        const uint4 rv = *(const uint4*)(qkvr + tok * GQKVR + 2048 + h * GDV + c8);
        const f32x4 ga = *(const f32x4*)(g_norm + h * GDV + c8), gb = *(const f32x4*)(g_norm + h * GDV + c8 + 4);
        const unsigned yw[4] = {yv.x, yv.y, yv.z, yv.w}, rw[4] = {rv.x, rv.y, rv.z, rv.w}; unsigned ow[4];
#pragma unroll
        for (int k = 0; k < 4; ++k) { const float y0 = __uint_as_float(yw[k] << 16), y1 = __uint_as_float(yw[k] & 0xffff0000u), r0 = __uint_as_float(rw[k] << 16), r1 = __uint_as_float(rw[k] & 0xffff0000u);
          const float g0 = k < 2 ? ga[2 * k] : gb[2 * k - 4], g1 = k < 2 ? ga[2 * k + 1] : gb[2 * k - 3];
          ow[k] = cvtpk2(y0 * g0 * silu_f(r0), y1 * g1 * silu_f(r1)); }
        uint4 o4; o4.x = ow[0]; o4.y = ow[1]; o4.z = ow[2]; o4.w = ow[3];
        *(uint4*)(yout + tok * (size_t)ystride + h * GDV + c8) = o4; }
    }
    __syncthreads();
  }
  if (!WITH_O) {
#pragma unroll
    for (int kt = 0; kt < 4; ++kt)
#pragma unroll
      for (int r = 0; r < 16; ++r) Lu[(size_t)(32 * kt + crow(r, hi)) * GDV + 32 * wid + r32] = st[kt][r];
    if (tid < 128) GD[(size_t)u * GDK + tid] = gdec;
  }
#undef GLA_LOAD
#undef GLA_STORE
}
__device__ __forceinline__ void scan_groups(float* __restrict__ LS, const float* __restrict__ GD, int gtid, int nthreads) {
  for (int i = gtid; i < NB * GH * (GDK * GDV / 2); i += nthreads) {
    const int bh = i >> 14, e2 = i & 16383, k = e2 >> 7, v2 = e2 & 127;
    float* p = LS + (size_t)bh * NGRP * LS_UNIT + (size_t)k * GDV + 2 * v2;
    const float* gd = GD + (size_t)bh * NGRP * GDK + k;
    f2_t s = {0.f, 0.f};
#pragma unroll 8
    for (int g = 0; g < NGRP; ++g) { const f2_t l = *(const f2_t*)(p + (size_t)g * LS_UNIT); const float d = gd[(size_t)g * GDK];
      *(f2_t*)(p + (size_t)g * LS_UNIT) = s; s = s * d + l; }
  }
}
#undef GLA_PK
}

#define LAS __attribute__((address_space(3)))
constexpr int NWAVES = 8, NTHREADS = NWAVES * 64;
constexpr int LDS_XB = 151552;
constexpr int LDS_BYTES = LDS_XB + 256;
constexpr int CW_BAR = 4096;
constexpr int N_PHASES = 48;

#define XB_TMO      128
#define XB_XCNT(j)  (256  + 64 * (j))
#define XB_XSUB(j)  (1280 + 64 * (j))
#define XB_XGEN(j)  (2304 + 64 * (j))
#define XB_TOP      3328
#define XB_TOPGEN   3392
#define XCD_BAR_WORDS 3456
#define XB_SPIN_CAP (1u << 18)
__device__ __forceinline__ unsigned xb_ld(unsigned* p)              { return __hip_atomic_load(p, __ATOMIC_RELAXED, __HIP_MEMORY_SCOPE_AGENT); }
__device__ __forceinline__ unsigned xb_add(unsigned* p, unsigned v) { return __hip_atomic_fetch_add(p, v, __ATOMIC_RELAXED, __HIP_MEMORY_SCOPE_AGENT); }
__device__ __forceinline__ unsigned xb_xcc_id() { return (unsigned)__builtin_amdgcn_s_getreg((3 << 11) | 20) & 0xFu; }
#define XB_SPIN(cond, bar) do { unsigned _sp = 0; while (cond) { __builtin_amdgcn_s_sleep(1); \
    if ((++_sp & 255u) == 0u) { if (xb_ld(&(bar)[XB_TMO])) break; if (_sp > XB_SPIN_CAP) { atomicAdd(&(bar)[XB_TMO], 1u); break; } } } } while (0)
struct XcdBarrier { unsigned* bar; unsigned x; volatile LAS unsigned* st; };
__device__ __forceinline__ XcdBarrier xcd_barrier_post(unsigned* bar, volatile LAS unsigned* st) {
    XcdBarrier b; b.bar = bar; b.x = xb_xcc_id(); b.st = st;
    if (threadIdx.x == 0) (void)xb_add(&bar[XB_XCNT(b.x)], 1u);
    return b;
}
__device__ __forceinline__ void xcd_barrier_complete(unsigned* bar, unsigned x, unsigned& nloc, unsigned& nx) {
    const unsigned G = gridDim.x * gridDim.y * gridDim.z;
    unsigned sum, cnt, mine, sp = 0u;
    for (;;) {
        sum = 0u; cnt = 0u; mine = 0u;
#pragma unroll
        for (unsigned j = 0; j < 16; ++j) { const unsigned c = xb_ld(&bar[XB_XCNT(j)]); sum += c; cnt += (c > 0u) ? 1u : 0u; mine = (j == x) ? c : mine; }
        if (sum == G) break;
        __builtin_amdgcn_s_sleep(1);
        if ((++sp & 255u) == 0u) { if (xb_ld(&bar[XB_TMO])) break; if (sp > XB_SPIN_CAP) { atomicAdd(&bar[XB_TMO], 1u); break; } }
    }
    nloc = mine > 0u ? mine : 1u; nx = cnt > 0u ? cnt : 1u;
}
__device__ __forceinline__ void xcd_barrier(const XcdBarrier& b, int tid) {
    asm volatile("s_waitcnt vmcnt(0)" ::: "memory");
    __syncthreads();
    if (tid == 0) {
        unsigned* bar = b.bar;
        __builtin_amdgcn_s_waitcnt(0);
        unsigned nloc = b.st[0], nx = b.st[1];
        if (nloc == 0u) { xcd_barrier_complete(bar, b.x, nloc, nx); b.st[0] = nloc; b.st[1] = nx; }
        const unsigned old = xb_add(&bar[XB_XSUB(b.x)], 1u);
        const unsigned gen = old / nloc;
        if (old + 1u == (gen + 1u) * nloc) {
            __builtin_amdgcn_fence(__ATOMIC_RELEASE, "agent");
            asm volatile("s_waitcnt vmcnt(0)" ::: "memory");
            const unsigned og = xb_add(&bar[XB_TOP], 1u);
            const unsigned tg = og / nx;
            if (og + 1u == (tg + 1u) * nx) xb_add(&bar[XB_TOPGEN], 1u);
            else XB_SPIN(xb_ld(&bar[XB_TOPGEN]) == tg, bar);
            __builtin_amdgcn_fence(__ATOMIC_ACQUIRE, "agent");
            xb_add(&bar[XB_XGEN(b.x)], 1u);
            asm volatile("s_waitcnt vmcnt(0)" ::: "memory");
        } else {
            XB_SPIN(xb_ld(&bar[XB_XGEN(b.x)]) == gen, bar);
            __builtin_amdgcn_fence(__ATOMIC_ACQUIRE, "agent");
            asm volatile("s_waitcnt vmcnt(0)" ::: "memory");
        }
    }
    __syncthreads();
}

struct MArgs { const float* in[24]; float* out; unsigned char* ws; int ph_lo, ph_hi, li, pad; };

__device__ __forceinline__ unsigned pk2(float lo, float hi) { return (unsigned)f2bf(lo) | ((unsigned)f2bf(hi) << 16); }
__device__ __forceinline__ void tr_item(const float* W, int ld, int K, int N, bf16_t* WT, int rs, int roff, float scale, int nscale, float* scr, int item, int lane) {
    const int nblk = N / 32, kb = item / nblk, nb = item % nblk, k0 = 64 * kb, n0 = 32 * nb;
    const float sc = (n0 + (lane & 31)) < nscale ? scale : 1.f;
#pragma unroll 8
    for (int i = 0; i < 32; ++i) { const int kk = 2 * i + (lane >> 5); scr[kk * 33 + (lane & 31)] = __builtin_nontemporal_load(W + (size_t)(k0 + kk) * ld + n0 + (lane & 31)) * sc; }
    asm volatile("s_waitcnt lgkmcnt(0)" ::: "memory");
    const int c = lane & 7;
#pragma unroll
    for (int j = 0; j < 4; ++j) { const int n = (lane >> 3) + 8 * j; const float* s = scr + (8 * c) * 33 + n;
        uint4 o; o.x = pk2(s[0 * 33], s[1 * 33]); o.y = pk2(s[2 * 33], s[3 * 33]); o.z = pk2(s[4 * 33], s[5 * 33]); o.w = pk2(s[6 * 33], s[7 * 33]);
        const int ng = n0 + n, drow = (ng >> 4) * rs + (ng & 15) + roff;
        *(uint4*)(WT + (size_t)drow * K + k0 + 8 * c) = o; }
    asm volatile("s_waitcnt lgkmcnt(0)" ::: "memory");
}
__device__ __forceinline__ const void* ldptr(volatile LAS unsigned long long* tab, int i) { const unsigned long long v = tab[i];
    const unsigned lo = __builtin_amdgcn_readfirstlane((unsigned)v), hi = __builtin_amdgcn_readfirstlane((unsigned)(v >> 32)); return (const void*)(const __attribute__((address_space(1))) char*)(((unsigned long long)hi << 32) | lo); }
#define INP(i) ((const float*)ldptr(ptab, (i)))
__device__ __forceinline__ void ph_convert(volatile LAS unsigned long long* ptab, unsigned char* ws, unsigned char* lds, int gw, int NGW, int wave, int lane) {
    float* scr = (float*)(lds + wave * 16384);
    constexpr int I0 = 2 * 16 * 96, I1 = 2 * 16 * 32, I2 = 16 * 64, I3 = 2 * 16 * 32, I4 = 2 * 16 * 32, I5 = 64 * 16 * 16, I6 = I5, I7 = 64 * 8 * 32;
    constexpr int NIT = I0 + I1 + I2 + I3 + I4 + I5 + I6 + I7;
    for (int it = gw; it < NIT; it += NGW) {
        int r = it; const float* src; bf16_t* dst; int ld, K = D, N, rs = 16, roff = 0, nscale = 0, item; float scale = 1.f;
        if (r < I0) { const int z = r / (16 * 96); item = r % (16 * 96); src = INP(1) + (size_t)z * D * GIN; ld = GIN; N = GQKVR; dst = (bf16_t*)(ws + WS_WIN) + (size_t)z * GQKVR * D; scale = 0.08838834764831845f; nscale = 512; }
        else if ((r -= I0) < I1) { const int z = r / 512; item = r % 512; src = INP(5) + (size_t)z * D * D; ld = D; N = D; dst = (bf16_t*)(ws + WS_WOA) + (size_t)z * D * D; }
        else if ((r -= I1) < I2) { item = r; src = INP(6); ld = 2048; N = 2048; dst = (bf16_t*)(ws + WS_WKV); }
        else if ((r -= I2) < I3) { const int z = r / 512; item = r % 512; src = INP(7) + (size_t)z * D * D; ld = D; N = D; dst = (bf16_t*)(ws + WS_WQ) + (size_t)z * D * D; scale = 0.125f * 1.4426950408889634f; nscale = 1024; }
        else if ((r -= I3) < I4) { const int z = r / 512; item = r % 512; src = INP(13) + (size_t)z * D * D; ld = D; N = D; dst = (bf16_t*)(ws + WS_WOB) + (size_t)z * D * D; }
        else if ((r -= I4) < I5) { const int z = r / 256; item = r % 256; src = INP(19) + (size_t)z * D * FF; ld = FF; N = FF; dst = (bf16_t*)(ws + WS_WGU) + (size_t)z * 1024 * D; rs = 32; }
        else if ((r -= I5) < I6) { const int z = r / 256; item = r % 256; src = INP(20) + (size_t)z * D * FF; ld = FF; N = FF; dst = (bf16_t*)(ws + WS_WGU) + (size_t)z * 1024 * D; rs = 32; roff = 16; }
        else { r -= I6; const int z = r / 256; item = r % 256; src = INP(21) + (size_t)z * FF * D; ld = D; K = FF; N = D; dst = (bf16_t*)(ws + WS_WD) + (size_t)z * D * FF; }
        tr_item(src, ld, K, N, dst, rs, roff, scale, nscale, scr, item, lane);
    }
}

__device__ __forceinline__ void kdec_ref_phase(bf16_t* qkvr, const float* lr, const float* w_gate2, const float* b_gate, float* dec, unsigned char* lds, int tid) {
    float (*slr)[16] = (float (*)[16])lds;
    const int ch = tid;
    for (int bc = blockIdx.x; bc < NB * NCH; bc += gridDim.x) {
        const size_t tok0 = (size_t)bc * CHUNK;
        __syncthreads();
        for (int i = tid; i < 64 * 16; i += NTHREADS) slr[i >> 4][i & 15] = lr[tok0 * 16 + i];
        float wg[16];
#pragma unroll
        for (int j = 0; j < 16; ++j) wg[j] = w_gate2[j * GHK + ch];
        const float bg = b_gate[ch];
        __syncthreads();
        float cum[64]; float run = 0.f;
#pragma unroll
        for (int t = 0; t < 64; ++t) {
            float z = bg;
#pragma unroll
            for (int j = 0; j < 16; ++j) z += slr[t][j] * wg[j];
            const float ls = fminf(z, 0.f) - __logf(1.f + __expf(-fabsf(z)));
            run += ls * (1.f / 16.f); cum[t] = run;
        }
#pragma unroll
        for (int t = 0; t < 64; ++t) { bf16_t* kp = qkvr + (tok0 + t) * GQKVR + GHK + ch; *kp = f2bf(bf2f(*kp) * __expf(run - cum[t])); }
        dec[(size_t)bc * GHK + ch] = __expf(run);
    }
    __syncthreads();
}
constexpr size_t WS_O1 = WS_R1 + (size_t)T * D * 2, WS_O2 = WS_R1 + (size_t)2 * T * D * 2;
#define PTRS unsigned char* const ws = (unsigned char*)ldptr(ptab, 25); float* const outp = (float*)ldptr(ptab, 24); int* const CTL = (int*)(ws + WS_CTL); \
    bf16_t *WIN = (bf16_t*)(ws + WS_WIN), *WOA = (bf16_t*)(ws + WS_WOA), *WKV = (bf16_t*)(ws + WS_WKV), *WQ = (bf16_t*)(ws + WS_WQ), *WOB = (bf16_t*)(ws + WS_WOB), *WGU = (bf16_t*)(ws + WS_WGU), *WD = (bf16_t*)(ws + WS_WD); \
    bf16_t *HB = (bf16_t*)(ws + WS_HB), *R1 = (bf16_t*)(ws + WS_R1), *MIX = (bf16_t*)(ws + WS_MIX), *HBUF = (bf16_t*)(ws + WS_HBUF), *YSLOT = (bf16_t*)(ws + WS_YSLOT), *QB = (bf16_t*)(ws + WS_QB); \
    bf16_t *O1 = (bf16_t*)(ws + WS_O1), *O2 = (bf16_t*)(ws + WS_O2); float *LR = (float*)(ws + WS_LR), *DEC = (float*)(ws + WS_DEC), *TOKW = (float*)(ws + WS_TOKW); \
    int *LIST = (int*)(ws + WS_LIST), *TOKE = (int*)(ws + WS_TOKE), *TOKP = (int*)(ws + WS_TOKP); bf16_t* KV = (bf16_t*)outp; float* OBUF = outp; int* cnt = CTL + CW_CNT + 64 * l; \
    (void)WIN; (void)WOA; (void)WKV; (void)WQ; (void)WOB; (void)WGU; (void)WD; (void)HB; (void)R1; (void)MIX; (void)HBUF; (void)YSLOT; (void)QB; (void)O1; (void)O2; (void)LR; (void)DEC; (void)TOKW; (void)LIST; (void)TOKE; (void)TOKP; (void)KV; (void)OBUF; (void)cnt;
#define PHASE(id, ...) do { if ((id) >= lo && (id) < hi) { int lane; asm volatile("v_mbcnt_lo_u32_b32 %0, -1, 0\n\tv_mbcnt_hi_u32_b32 %0, -1, %0" : "=v"(lane)); const int wave = wave0, tid = wave0 * 64 + lane, gw = blockIdx.x * NWAVES + wave; (void)lane; (void)gw; PTRS \
        __VA_ARGS__; if ((id) + 1 < hi) { XcdBarrier bl = bar; asm volatile("" : "+s"(bl.bar), "+s"(bl.x)); xcd_barrier(bl, tid); } } } while (0)

template <int l> __device__ __forceinline__ void layer_phases(volatile LAS unsigned long long* const ptab, unsigned char* const lds, LAS unsigned char* const ldsl, const XcdBarrier& bar,
                                                            const int lo, const int hi, const int wave0, const int G, const int NGW) {
        const int pb = 1 + 12 * l;
        if (l < 2) {
            PHASE(pb + 0, { const pg8::Gemm g{HB, WIN + (size_t)l * GQKVR * D, D, D, D, 0}; pg8::DenseOrder S; S.init(T, GQKVR, G, (int)blockIdx.x); const pg8::EpiBf16 E{R1, GQKVR}; pg8::gemm_phase(ldsl, g, S, E, tid); });
            PHASE(pb + 1, kdec_ref_phase(R1, LR, INP(2) + (size_t)l * 16 * GHK, INP(3) + (size_t)l * GHK, DEC, lds, tid));
            PHASE(pb + 2, gla::scan_unit<false>(R1, DEC, (float*)MIX, (float*)MIX + (size_t)gla::NUNIT * gla::LS_UNIT, nullptr, nullptr, 0, (int)blockIdx.x, (char*)lds, tid));
            PHASE(pb + 3, gla::scan_groups((float*)MIX, (const float*)MIX + (size_t)gla::NUNIT * gla::LS_UNIT, (int)blockIdx.x * NTHREADS + tid, G * NTHREADS));
            PHASE(pb + 4, gla::scan_unit<true>(R1, DEC, (float*)MIX, nullptr, INP(4) + (size_t)l * GHV, R1 + 1024, GQKVR, (int)blockIdx.x, (char*)lds, tid));
            PHASE(pb + 5, { const pg8::Gemm g{R1 + 1024, WOA + (size_t)l * D * D, GQKVR, D, D, 0}; pg8::DenseOrder S; S.init(T, D, G, (int)blockIdx.x); const pg8::EpiBf16 E{MIX, D}; pg8::gemm_phase(ldsl, g, S, E, tid); });
        } else {
            const int j = l - 2; const float lambda_init = l == 2 ? 0.47071302f : 0.55605820f;
            PHASE(pb + 0, { { const pg8::Gemm g{HB, WQ + (size_t)j * D * D, D, D, D, 0}; pg8::DenseOrder S; S.init(T, D, G, (int)blockIdx.x); const pg8::EpiBf16 E{QB, D}; pg8::gemm_phase(ldsl, g, S, E, tid); }
                            if (l == 2) { const pg8::Gemm g{HB, WKV, D, D, D, 0}; pg8::DenseOrder S; S.init(T, 2048, G, (int)blockIdx.x); const pg8::EpiBf16 E{KV, 2048}; pg8::gemm_phase(ldsl, g, S, E, tid); } });
            PHASE(pb + 1, att::attn_phase(QB, KV, (float*)O1, O2, INP(14), INP(8) + j * 64, INP(9) + j * 64, INP(10) + j * 64, INP(11) + j * 64, INP(12) + j * ADV, lambda_init, (char*)lds, tid));
            PHASE(pb + 5, { const pg8::Gemm g{O2, WOB + (size_t)j * D * D, D, D, D, 0}; pg8::DenseOrder S; S.init(T, D, G, (int)blockIdx.x); const pg8::EpiBf16 E{MIX, D}; pg8::gemm_phase(ldsl, g, S, E, tid); });
        }
        PHASE(pb + 6, { RowArgs r{}; r.mode = 1; r.hb = HB; r.mix = MIX; r.ln_g = INP(22) + (size_t)(l * 2) * D; r.ln_b = INP(23) + (size_t)(l * 2) * D;
                        r.w_group = INP(15) + (size_t)l * D * 4; r.b_group = INP(16) + l * 4; r.w_router = INP(17) + (size_t)l * D * 16; r.b_router = INP(18) + l * 16;
                        r.cnt = cnt; r.list = LIST; r.tok_e = TOKE; r.tok_pos = TOKP; r.tok_w = TOKW;
                        row_phase<NTHREADS, 20>(r, lds, G, blockIdx.x, tid); });
        PHASE(pb + 7, { const pg8::Gemm g{HB, WGU + (size_t)l * NE * 1024 * D, D, D, D, (size_t)1024 * D}; const pg8::MoeOrder<true> S{cnt, LIST, 4, G, (int)blockIdx.x}; const pg8::EpiSwiglu E{HBUF, FF}; pg8::gemm_phase(ldsl, g, S, E, tid); });
        PHASE(pb + 8, { const pg8::Gemm g{HBUF, WD + (size_t)l * NE * D * FF, FF, FF, FF, (size_t)D * FF}; const pg8::MoeOrder<false> S{cnt, LIST, 4, G, (int)blockIdx.x}; const pg8::EpiBf16 E{YSLOT, D}; pg8::gemm_phase(ldsl, g, S, E, tid); });
        PHASE(pb + 9, { RowArgs r{}; r.mode = 2; r.hb = HB; r.Y = YSLOT; r.ln_g = INP(22) + (size_t)(l * 2 + 1) * D; r.ln_b = INP(23) + (size_t)(l * 2 + 1) * D;
                        r.cnt = cnt; r.tok_e = TOKE; r.tok_pos = TOKP; r.tok_w = TOKW;
                        if (l == 0) { r.lr_w = INP(1) + (size_t)D * GIN + 3072; r.lr_out = LR; }
                        if (l == 3) r.out = outp;
                        row_phase<NTHREADS, (l == 0 ? 16 : 0)>(r, lds, G, blockIdx.x, tid); });
}

__global__ void __launch_bounds__(NTHREADS, 2) fwd(MArgs a) {
    extern __shared__ __attribute__((aligned(16))) unsigned char lds[];
    const int tid0 = threadIdx.x, wave0 = __builtin_amdgcn_readfirstlane(tid0 >> 6);
    const int G = gridDim.x, NGW = G * NWAVES;
    volatile LAS unsigned long long* const ptab = (volatile LAS unsigned long long*)(lds + LDS_XB + 16);
    if (tid0 < 4) ((volatile LAS unsigned*)(lds + LDS_XB))[tid0] = 0u;
    if (tid0 < 24) ptab[tid0] = (unsigned long long)a.in[tid0];
    if (tid0 == 24) ptab[24] = (unsigned long long)a.out;
    if (tid0 == 25) ptab[25] = (unsigned long long)a.ws;
    __syncthreads();
    XcdBarrier bar = xcd_barrier_post((unsigned*)(a.ws + WS_CTL) + CW_BAR + a.li * XCD_BAR_WORDS, (volatile LAS unsigned*)(lds + LDS_XB));
    const int lo = a.ph_lo, hi = a.ph_hi;
    PG8_LAS unsigned char* const ldsl = (PG8_LAS unsigned char*)lds;
    { const int l = 0;
    PHASE(0, { ph_convert(ptab, ws, lds, gw, NGW, wave, lane); __syncthreads();
               RowArgs r{}; r.mode = 0; r.x = INP(0); r.hb = HB; r.lr_w = INP(1) + 3072; r.lr_out = LR; row_phase<NTHREADS, 16>(r, lds, G, blockIdx.x, tid); }); }
    layer_phases<0>(ptab, lds, ldsl, bar, lo, hi, wave0, G, NGW);
    layer_phases<1>(ptab, lds, ldsl, bar, lo, hi, wave0, G, NGW);
    layer_phases<2>(ptab, lds, ldsl, bar, lo, hi, wave0, G, NGW);
    layer_phases<3>(ptab, lds, ldsl, bar, lo, hi, wave0, G, NGW);
}
#undef PHASE

#ifndef RUN_MODE
#define RUN_MODE 1
#endif
extern "C" void kernel_launch(void* const* d_in, const int* in_sizes, int n_in, void* d_out, int out_size, void* d_ws, size_t ws_size, hipStream_t stream) {
    static int grid = 0;
    if (grid == 0) {
        if (n_in != 24 || out_size != T * D || ws_size < WS_END) { fprintf(stderr, "kernel_launch: unexpected sizes n_in %d out %d ws %zu (need %zu)\n", n_in, out_size, ws_size, (size_t)WS_END); grid = -1; return; }
        int dev = 0, cus = 0, per_cu = 0;
        if (hipGetDevice(&dev) != hipSuccess || hipDeviceGetAttribute(&cus, hipDeviceAttributeMultiprocessorCount, dev) != hipSuccess) { grid = -1; return; }
        if (hipFuncSetAttribute((const void*)fwd, hipFuncAttributeMaxDynamicSharedMemorySize, LDS_BYTES) != hipSuccess) { fprintf(stderr, "hipFuncSetAttribute failed\n"); grid = -1; return; }
        if (hipOccupancyMaxActiveBlocksPerMultiprocessor(&per_cu, (const void*)fwd, NTHREADS, LDS_BYTES) != hipSuccess || per_cu < 1) { fprintf(stderr, "occupancy query: %d blocks per CU\n", per_cu); grid = -1; return; }
        (void)hipGetLastError();
        grid = cus;
        if (grid != 256 || T % (grid * NWAVES * 4) != 0) { fprintf(stderr, "unsupported CU count %d\n", cus); grid = -1; return; }
    }
    if (grid < 0) return;
    (void)hipMemsetAsync((unsigned char*)d_ws + WS_CTL, 0, CTL_BYTES, stream);
    MArgs a{};
    for (int i = 0; i < 24; ++i) a.in[i] = (const float*)d_in[i];
    a.out = (float*)d_out; a.ws = (unsigned char*)d_ws;
#if RUN_MODE == 1
    a.ph_lo = 0; a.ph_hi = N_PHASES - 1; a.li = 0;
    hipLaunchKernelGGL(fwd, dim3(grid), dim3(NTHREADS), LDS_BYTES, stream, a);
#else
    int li = 0;
    for (int p = 0; p < N_PHASES - 1; ++p) {
        const int k = (p - 1) % 12, l = (p - 1) / 12;
        if (p > 0) { if (k >= 10) continue; if (l >= 2 && (k == 2 || k == 3 || k == 4)) continue; }
        a.ph_lo = p; a.ph_hi = p + 1; a.li = li++;
        hipLaunchKernelGGL(fwd, dim3(grid), dim3(NTHREADS), LDS_BYTES, stream, a);
    }
#endif
}
```

```cpp
#include <hip/hip_runtime.h>
#include <cstdio>
#include <cstdint>
#include <cmath>

typedef unsigned short bf16_t;
typedef short bf16x8 __attribute__((ext_vector_type(8)));
typedef float f32x4 __attribute__((ext_vector_type(4)));
typedef float f32x2 __attribute__((ext_vector_type(2)));

constexpr int NB = 2, SEQ = 16384, T = NB * SEQ, D = 1024;
constexpr int CHUNK = 64, NCH = SEQ / CHUNK;
constexpr int GH = 4, GDK = 128, GDV = 256, GHK = 512, GHV = 1024, GIN = 3088, GQKVR = 3072;
constexpr int AH = 8, ADH = 64, ADV = 128;
constexpr int NE = 16, FF = 512;
constexpr int NSLOT = 2 * T + NE * 256;
constexpr float ALPHA = 1.6817928305074290f;
constexpr float LN_EPS = 1e-5f;

constexpr size_t al256(size_t x) { return (x + 255) & ~(size_t)255; }
constexpr size_t WS_CTL = 0;
constexpr size_t CTL_BYTES = 1u << 20;
constexpr size_t WS_WIN = WS_CTL + CTL_BYTES;
constexpr size_t WS_WOA = WS_WIN + (size_t)2 * GQKVR * D * 2;
constexpr size_t WS_WKV = WS_WOA + (size_t)2 * D * D * 2;
constexpr size_t WS_WQ = WS_WKV + (size_t)2048 * D * 2;
constexpr size_t WS_WOB = WS_WQ + (size_t)2 * D * D * 2;
constexpr size_t WS_WGU = WS_WOB + (size_t)2 * D * D * 2;
constexpr size_t WS_WD = WS_WGU + (size_t)4 * NE * 1024 * D * 2;
constexpr size_t WS_HB = WS_WD + (size_t)4 * NE * D * FF * 2;
constexpr size_t WS_R1 = WS_HB + (size_t)T * D * 2;
constexpr size_t WS_MIX = WS_R1 + (size_t)T * GQKVR * 2;
constexpr size_t WS_LR = WS_MIX + (size_t)T * D * 2;
constexpr size_t WS_DEC = WS_LR + (size_t)T * 16 * 4;
constexpr size_t WS_LIST = WS_DEC + (size_t)NB * NCH * GHK * 4;
constexpr size_t WS_TOKE = WS_LIST + (size_t)NE * T * 4;
constexpr size_t WS_TOKP = WS_TOKE + (size_t)T * 2 * 4;
constexpr size_t WS_TOKW = WS_TOKP + (size_t)T * 2 * 4;
constexpr size_t WS_END = WS_TOKW + (size_t)T * 2 * 4;
static_assert(WS_TOKP == WS_TOKE + (size_t)T * 2 * 4 && WS_TOKW == WS_TOKP + (size_t)T * 2 * 4, "the row phase reads tok_e | tok_pos | tok_w as one array");
constexpr size_t WS_HBUF = WS_R1;
constexpr size_t WS_YSLOT = WS_R1 + al256((size_t)NSLOT * FF * 2);
static_assert(WS_YSLOT + (size_t)NSLOT * D * 2 <= WS_LR, "MoE overlay fits R1|MIX");
constexpr size_t WS_QB = WS_R1;
constexpr size_t WS_OB = WS_R1 + (size_t)T * D * 2;
constexpr int CW_CNT = 64;

__device__ __forceinline__ float bf2f(bf16_t v) { return __uint_as_float(((unsigned)v) << 16); }
__device__ __forceinline__ bf16_t f2bf(float f) { return __builtin_bit_cast(bf16_t, (__bf16)f); }
__device__ __forceinline__ float wave_sum(float v) {
#pragma unroll
    for (int o = 1; o < 64; o <<= 1) v += __shfl_xor(v, o);
    return v;
}
__device__ __forceinline__ float silu_f(float x) { return x * __builtin_amdgcn_rcpf(1.f + __expf(-x)); }

struct RowArgs {
    int mode;
    int pad0;
    const float* x; bf16_t* hb; bf16_t* hb_out; const bf16_t* mix; const bf16_t* Y;
    const float* ln_g; const float* ln_b;
    const float* w_group; const float* b_group; const float* w_router; const float* b_router;
    int* cnt; int* list; int* tok_e; int* tok_pos; float* tok_w;
    const float* lr_w; float* lr_out;
    float* out;
};

constexpr int ROW_LDS_W = 36 * 1024 * 4;
constexpr int ROW_LDS_BYTES = ROW_LDS_W + 4096;

template <int O> __device__ __forceinline__ float xor_get(float v, int lane) {
    if constexpr (O == 32) { const auto rr = __builtin_amdgcn_permlane32_swap(__float_as_uint(v), __float_as_uint(v), false, false); return __uint_as_float(lane < 32 ? rr[1] : rr[0]); }
    else return __int_as_float(__builtin_amdgcn_ds_swizzle(__float_as_int(v), (O << 10) | 0x1f));
}
template <int O> __device__ __forceinline__ float xor_add(float v) {
    if constexpr (O == 32) { const auto rr = __builtin_amdgcn_permlane32_swap(__float_as_uint(v), __float_as_uint(v), false, false); return __uint_as_float(rr[0]) + __uint_as_float(rr[1]); }
    else return v + __int_as_float(__builtin_amdgcn_ds_swizzle(__float_as_int(v), (O << 10) | 0x1f));
}
template <int N, int MASK> __device__ __forceinline__ void halve_step(float* a, int lane) {
    const bool up = (lane & MASK) != 0;
#pragma unroll
    for (int i = 0; i < N / 2; ++i) { const float send = up ? a[i] : a[N / 2 + i], keep = up ? a[N / 2 + i] : a[i]; a[i] = keep + xor_get<MASK>(send, lane); }
}
#define ROW_SUM4(x) do { _Pragma("unroll") for (int rr = 0; rr < 4; ++rr) x[rr] = xor_add<1>(x[rr]); _Pragma("unroll") for (int rr = 0; rr < 4; ++rr) x[rr] = xor_add<2>(x[rr]); \
    _Pragma("unroll") for (int rr = 0; rr < 4; ++rr) x[rr] = xor_add<4>(x[rr]); _Pragma("unroll") for (int rr = 0; rr < 4; ++rr) x[rr] = xor_add<8>(x[rr]); \
    _Pragma("unroll") for (int rr = 0; rr < 4; ++rr) x[rr] = xor_add<16>(x[rr]); _Pragma("unroll") for (int rr = 0; rr < 4; ++rr) x[rr] = xor_add<32>(x[rr]); } while (0)
typedef unsigned u32x2_nt __attribute__((ext_vector_type(2)));
__device__ __forceinline__ ushort4 ld_nt8(const bf16_t* p) { const u32x2_nt v = __builtin_nontemporal_load((const u32x2_nt*)p); ushort4 r; r.x = (unsigned short)v[0]; r.y = (unsigned short)(v[0] >> 16); r.z = (unsigned short)v[1]; r.w = (unsigned short)(v[1] >> 16); return r; }
__device__ __forceinline__ int wt_idx(int jj, int c) { return ((((jj >> 1) * 4 + (c >> 8)) * 2 + ((c >> 1) & 1)) * 256) + 4 * ((c >> 2) & 63) + (c & 1) * 2 + (jj & 1); }
template <int NTHR, int NDOT> __device__ __forceinline__ void row_phase(const RowArgs& a, unsigned char* lds_raw, int nblocks, int bid, int tid) {
    float* Wt = (float*)lds_raw;
    float* GB = Wt + 24 * 1024;
    int* lcnt = (int*)(lds_raw + ROW_LDS_W);
    int* lbase = lcnt + 16;
    int* offs = lbase + 16;
    int* ent = offs + 16;
    constexpr int nthr = NTHR, nw = NTHR / 64; const int lane = tid & 63, wave = tid >> 6;
    bf16_t* const hbo = a.hb_out ? a.hb_out : a.hb;
    const int rows_per_block = T / nblocks;
    if (a.mode == 1) {
        for (int i = tid; i < 1024 * 4; i += nthr) { const int c = i >> 2, j = i & 3; Wt[wt_idx(j, c)] = a.w_group[i]; }
        for (int i = tid; i < 1024 * 16; i += nthr) { const int c = i >> 4, j = i & 15; Wt[wt_idx(4 + j, c)] = a.w_router[i]; }
        if (tid < 16) lcnt[tid] = 0;
    } else if (a.lr_w) {
        for (int i = tid; i < 1024 * 16; i += nthr) { const int c = i >> 4, j = i & 15; Wt[wt_idx(j, c)] = a.lr_w[(size_t)c * GIN + j]; }
    }
    if (a.mode != 0) for (int i = tid; i < 2048; i += nthr) GB[i] = i < 1024 ? a.ln_g[i] : a.ln_b[i - 1024];
    int offv = 0;
    if (a.mode == 2) { const int myc = a.cnt[lane & (NE - 1)]; int o = 0;
#pragma unroll
        for (int e = 0; e < NE; ++e) { if (lane == e) offv = o; o += (__builtin_amdgcn_readlane(myc, e) + 255) & ~255; } }
    __syncthreads();
    const int iters = rows_per_block / (nw * 4);
    for (int it = 0; it < iters; ++it) {
        const int lr0 = (it * nw + wave) * 4;
        const size_t rowb = ((size_t)it * nblocks + bid) * (nw * 4) + wave * 4;
        float v[4][16];
        if (a.mode == 0) {
            f32x4 xr[4][4];
#pragma unroll
            for (int rr = 0; rr < 4; ++rr)
#pragma unroll
                for (int i = 0; i < 4; ++i) xr[rr][i] = __builtin_nontemporal_load((const f32x4*)(a.x + (rowb + rr) * D + 256 * i + 4 * lane));
#pragma unroll
            for (int rr = 0; rr < 4; ++rr)
#pragma unroll
                for (int i = 0; i < 4; ++i) { v[rr][4 * i] = xr[rr][i][0]; v[rr][4 * i + 1] = xr[rr][i][1]; v[rr][4 * i + 2] = xr[rr][i][2]; v[rr][4 * i + 3] = xr[rr][i][3]; }
        } else {
            ushort4 hr[4][4], ar[4][4], br[4][4]; float w0[4], w1[4];
            const bf16_t* pa[4]; const bf16_t* pb[4];
            if (a.mode == 1) {
#pragma unroll
                for (int rr = 0; rr < 4; ++rr) { pa[rr] = a.mix + (rowb + rr) * D; pb[rr] = pa[rr]; w0[rr] = 1.f; w1[rr] = 0.f; }
            } else {
                const int k_ = (lane >> 3) > 2 ? 2 : (lane >> 3); const int m = a.tok_e[(size_t)k_ * (2 * T) + rowb * 2 + (lane & 7)];
#pragma unroll
                for (int rr = 0; rr < 4; ++rr) { const int e0 = __builtin_amdgcn_readlane(m, 2 * rr), e1 = __builtin_amdgcn_readlane(m, 2 * rr + 1), p0 = __builtin_amdgcn_readlane(m, 8 + 2 * rr), p1 = __builtin_amdgcn_readlane(m, 9 + 2 * rr);
                    w0[rr] = __int_as_float(__builtin_amdgcn_readlane(m, 16 + 2 * rr)); w1[rr] = __int_as_float(__builtin_amdgcn_readlane(m, 17 + 2 * rr));
                    pa[rr] = a.Y + (size_t)(__builtin_amdgcn_readlane(offv, e0) + p0) * D; pb[rr] = a.Y + (size_t)(__builtin_amdgcn_readlane(offv, e1) + p1) * D; }
            }
#pragma unroll
            for (int rr = 0; rr < 4; ++rr)
#pragma unroll
                for (int i = 0; i < 4; ++i) { hr[rr][i] = *(const ushort4*)(a.hb + (rowb + rr) * D + 256 * i + 4 * lane); ar[rr][i] = ld_nt8(pa[rr] + 256 * i + 4 * lane);
                    if (a.mode == 2) br[rr][i] = ld_nt8(pb[rr] + 256 * i + 4 * lane); }
#pragma unroll
            for (int rr = 0; rr < 4; ++rr) { __builtin_amdgcn_sched_barrier(0);
#pragma unroll
                for (int i = 0; i < 4; ++i) {
                    v[rr][4 * i] = ALPHA * bf2f(hr[rr][i].x) + w0[rr] * bf2f(ar[rr][i].x); v[rr][4 * i + 1] = ALPHA * bf2f(hr[rr][i].y) + w0[rr] * bf2f(ar[rr][i].y);
                    v[rr][4 * i + 2] = ALPHA * bf2f(hr[rr][i].z) + w0[rr] * bf2f(ar[rr][i].z); v[rr][4 * i + 3] = ALPHA * bf2f(hr[rr][i].w) + w0[rr] * bf2f(ar[rr][i].w);
                    if (a.mode == 2) { v[rr][4 * i] += w1[rr] * bf2f(br[rr][i].x); v[rr][4 * i + 1] += w1[rr] * bf2f(br[rr][i].y); v[rr][4 * i + 2] += w1[rr] * bf2f(br[rr][i].z); v[rr][4 * i + 3] += w1[rr] * bf2f(br[rr][i].w); } } }
            __builtin_amdgcn_sched_barrier(0);
            float mu[4], rstd[4];
#pragma unroll
            for (int rr = 0; rr < 4; ++rr) { float s = 0.f;
#pragma unroll
                for (int i = 0; i < 16; ++i) s += v[rr][i];
                mu[rr] = s; }
            ROW_SUM4(mu);
#pragma unroll
            for (int rr = 0; rr < 4; ++rr) { mu[rr] *= (1.f / D); float q = 0.f;
#pragma unroll
                for (int i = 0; i < 16; ++i) { v[rr][i] -= mu[rr]; q += v[rr][i] * v[rr][i]; }
                rstd[rr] = q; }
            ROW_SUM4(rstd);
#pragma unroll
            for (int rr = 0; rr < 4; ++rr) rstd[rr] = rsqrtf(rstd[rr] * (1.f / D) + LN_EPS);
#pragma unroll
            for (int i = 0; i < 4; ++i) { int gl = 4 * lane; asm volatile("" : "+v"(gl));
                const f32x4 gg = *(const f32x4*)(GB + 256 * i + gl), bb = *(const f32x4*)(GB + 1024 + 256 * i + gl);
#pragma unroll
                for (int rr = 0; rr < 4; ++rr)
#pragma unroll
                    for (int qd = 0; qd < 4; ++qd) v[rr][4 * i + qd] = v[rr][4 * i + qd] * rstd[rr] * gg[qd] + bb[qd]; }
        }
#pragma unroll
        for (int rr = 0; rr < 4; ++rr)
#pragma unroll
            for (int i = 0; i < 4; ++i) { ushort4 t; t.x = f2bf(v[rr][4 * i]); t.y = f2bf(v[rr][4 * i + 1]); t.z = f2bf(v[rr][4 * i + 2]); t.w = f2bf(v[rr][4 * i + 3]);
                if (!a.out) *(ushort4*)(hbo + (rowb + rr) * D + 256 * i + 4 * lane) = t;
                if (a.out) { f32x4 o; o[0] = v[rr][4 * i]; o[1] = v[rr][4 * i + 1]; o[2] = v[rr][4 * i + 2]; o[3] = v[rr][4 * i + 3]; __builtin_nontemporal_store(o, (f32x4*)(a.out + (rowb + rr) * D + 256 * i + 4 * lane)); } }
        if constexpr (NDOT == 20) {
            float* res = Wt + 32 * 1024 + wave * 80;
            const int nb = ((lane >> 5) & 1) * 8 + ((lane >> 4) & 1) * 4 + ((lane >> 3) & 1) * 2 + ((lane >> 2) & 1);
#define ROW_FMA4(T_, RR, I, WA, WB) do { T_ = __builtin_elementwise_fma((f32x2){v[RR][4 * (I)], v[RR][4 * (I)]}, (f32x2){WA[0], WA[1]}, T_); T_ = __builtin_elementwise_fma((f32x2){v[RR][4 * (I) + 1], v[RR][4 * (I) + 1]}, (f32x2){WA[2], WA[3]}, T_); \
                T_ = __builtin_elementwise_fma((f32x2){v[RR][4 * (I) + 2], v[RR][4 * (I) + 2]}, (f32x2){WB[0], WB[1]}, T_); T_ = __builtin_elementwise_fma((f32x2){v[RR][4 * (I) + 3], v[RR][4 * (I) + 3]}, (f32x2){WB[2], WB[3]}, T_); } while (0)
#define ROW_RED16(X, SLOT) do { halve_step<16, 32>(X, lane); halve_step<8, 16>(X, lane); halve_step<4, 8>(X, lane); halve_step<2, 4>(X, lane); X[0] = xor_add<2>(X[0]); X[0] = xor_add<1>(X[0]); \
                if ((lane & 3) == 0) res[(SLOT) + nb] = X[0]; asm volatile("s_waitcnt lgkmcnt(0)" ::: "memory"); } while (0)
            f32x2 g2[8];
#pragma unroll
            for (int n = 0; n < 8; ++n) g2[n] = (f32x2){0.f, 0.f};
#pragma unroll
            for (int i = 0; i < 4; ++i)
#pragma unroll
                for (int jp = 0; jp < 2; ++jp) { const f32x4 wa = *(const f32x4*)(Wt + ((jp * 4 + i) * 2) * 256 + 4 * lane), wb = *(const f32x4*)(Wt + ((jp * 4 + i) * 2 + 1) * 256 + 4 * lane);
#pragma unroll
                    for (int rr = 0; rr < 4; ++rr) ROW_FMA4(g2[rr * 2 + jp], rr, i, wa, wb); }
            float ga[16];
#pragma unroll
            for (int n = 0; n < 8; ++n) { ga[2 * n] = g2[n][0]; ga[2 * n + 1] = g2[n][1]; }
            ROW_RED16(ga, 0);
            int gi[4];
            const float bg0 = a.b_group[0], bg1 = a.b_group[1], bg2 = a.b_group[2], bg3 = a.b_group[3];
#pragma unroll
            for (int rr = 0; rr < 4; ++rr) { const f32x4 t = *(const f32x4*)(res + 4 * rr); const float gl[4] = {t[0] + bg0, t[1] + bg1, t[2] + bg2, t[3] + bg3};
                int g_ = 0; float gm = gl[0];
#pragma unroll
                for (int j = 1; j < 4; ++j) if (gl[j] > gm) { gm = gl[j]; g_ = j; }
                gi[rr] = g_; }
            f32x2 e2[8];
#pragma unroll
            for (int n = 0; n < 8; ++n) e2[n] = (f32x2){0.f, 0.f};
#pragma unroll
            for (int rr = 0; rr < 4; ++rr) { const float* wr_ = Wt + (2 + 2 * gi[rr]) * 2048 + 4 * lane;
#pragma unroll
                for (int i = 0; i < 4; ++i)
#pragma unroll
                    for (int q = 0; q < 2; ++q) { const f32x4 wa = *(const f32x4*)(wr_ + q * 2048 + (i * 2) * 256), wb = *(const f32x4*)(wr_ + q * 2048 + (i * 2 + 1) * 256);
                        ROW_FMA4(e2[rr * 2 + q], rr, i, wa, wb); } }
            float ea[16];
#pragma unroll
            for (int n = 0; n < 8; ++n) { ea[2 * n] = e2[n][0]; ea[2 * n + 1] = e2[n][1]; }
            ROW_RED16(ea, 16);
#undef ROW_FMA4
#undef ROW_RED16
            if (lane < 4) {
                const f32x4 tg = *(const f32x4*)(res + 4 * lane), te = *(const f32x4*)(res + 16 + 4 * lane);
                const float gl[4] = {tg[0] + bg0, tg[1] + bg1, tg[2] + bg2, tg[3] + bg3};
                int gq = 0; float gm = gl[0];
#pragma unroll
                for (int j = 1; j < 4; ++j) if (gl[j] > gm) { gm = gl[j]; gq = j; }
                float gs = 0.f;
#pragma unroll
                for (int j = 0; j < 4; ++j) gs += __expf(gl[j] - gm);
                const float gw = 1.f / gs;
                float l4[4];
#pragma unroll
                for (int j = 0; j < 4; ++j) l4[j] = te[j] + a.b_router[gq * 4 + j];
                int ia = 0; float la = l4[0];
#pragma unroll
                for (int j = 1; j < 4; ++j) if (l4[j] > la) { la = l4[j]; ia = j; }
                int ib = -1; float lb = -3.0e38f;
#pragma unroll
                for (int j = 0; j < 4; ++j) if (j != ia && l4[j] > lb) { lb = l4[j]; ib = j; }
                const float eb = __expf(lb - la), wa = 1.f / (1.f + eb), wb = eb / (1.f + eb);
                const int e1 = gq * 4 + ia, e2_ = gq * 4 + ib;
                const int p1 = atomicAdd(&lcnt[e1], 1), p2 = atomicAdd(&lcnt[e2_], 1);
                const int lrow = lr0 + lane; const size_t row = rowb + lane;
                ent[lrow * 4 + 0] = e1; ent[lrow * 4 + 1] = p1; ent[lrow * 4 + 2] = e2_; ent[lrow * 4 + 3] = p2;
                a.tok_e[row * 2] = e1; a.tok_e[row * 2 + 1] = e2_; a.tok_w[row * 2] = gw * wa; a.tok_w[row * 2 + 1] = gw * wb;
            }
        } else if constexpr (NDOT > 0) {
            constexpr int NV = 4 * NDOT, NP = NDOT / 2;
            f32x2 acc2[4 * NP];
#pragma unroll
            for (int n = 0; n < 4 * NP; ++n) acc2[n] = (f32x2){0.f, 0.f};
#pragma unroll
            for (int i = 0; i < 4; ++i) {
#pragma unroll
                for (int jp = 0; jp < NP; ++jp) { const f32x4 wa = *(const f32x4*)(Wt + ((jp * 4 + i) * 2) * 256 + 4 * lane), wb = *(const f32x4*)(Wt + ((jp * 4 + i) * 2 + 1) * 256 + 4 * lane);
#pragma unroll
                    for (int rr = 0; rr < 4; ++rr) { f32x2 t = acc2[rr * NP + jp];
                        t = __builtin_elementwise_fma((f32x2){v[rr][4 * i], v[rr][4 * i]}, (f32x2){wa[0], wa[1]}, t); t = __builtin_elementwise_fma((f32x2){v[rr][4 * i + 1], v[rr][4 * i + 1]}, (f32x2){wa[2], wa[3]}, t);
                        t = __builtin_elementwise_fma((f32x2){v[rr][4 * i + 2], v[rr][4 * i + 2]}, (f32x2){wb[0], wb[1]}, t); t = __builtin_elementwise_fma((f32x2){v[rr][4 * i + 3], v[rr][4 * i + 3]}, (f32x2){wb[2], wb[3]}, t);
                        acc2[rr * NP + jp] = t; }
                    asm volatile("" : "+v"(acc2[jp]), "+v"(acc2[NP + jp]), "+v"(acc2[2 * NP + jp]), "+v"(acc2[3 * NP + jp]) :: "memory"); }
            }
            float acc[NV];
#pragma unroll
            for (int n = 0; n < 4 * NP; ++n) { acc[2 * n] = acc2[n][0]; acc[2 * n + 1] = acc2[n][1]; }
            halve_step<NV, 32>(acc, lane); halve_step<NV / 2, 16>(acc, lane); halve_step<NV / 4, 8>(acc, lane); halve_step<NV / 8, 4>(acc, lane);
            constexpr int NR = NV / 16;
#pragma unroll
            for (int i = 0; i < NR; ++i) { acc[i] = xor_add<2>(acc[i]); acc[i] = xor_add<1>(acc[i]); }
            float* res = Wt + 32 * 1024 + wave * 80;
            if ((lane & 3) == 0) { const int nb = ((lane >> 5) & 1) * (NV / 2) + ((lane >> 4) & 1) * (NV / 4) + ((lane >> 3) & 1) * (NV / 8) + ((lane >> 2) & 1) * (NV / 16);
#pragma unroll
                for (int i = 0; i < NR; ++i) res[nb + i] = acc[i]; }
            asm volatile("s_waitcnt lgkmcnt(0)" ::: "memory");
            if (a.mode != 1) {
                if (lane < NV) a.lr_out[rowb * 16 + lane] = res[lane];
            } else if (lane < 4) {
                const float* rp = res + lane * NDOT;
                float gl[4], el[16];
#pragma unroll
                for (int j = 0; j < 4; ++j) gl[j] = rp[j] + a.b_group[j];
#pragma unroll
                for (int j = 0; j < 16; ++j) el[j] = rp[4 + j] + a.b_router[j];
                int gi = 0; float gm = gl[0];
#pragma unroll
                for (int j = 1; j < 4; ++j) if (gl[j] > gm) { gm = gl[j]; gi = j; }
                float gs = 0.f;
#pragma unroll
                for (int j = 0; j < 4; ++j) gs += __expf(gl[j] - gm);
                const float gw = 1.f / gs;
                float l4[4];
#pragma unroll
                for (int j = 0; j < 4; ++j) l4[j] = gi == 0 ? el[j] : gi == 1 ? el[4 + j] : gi == 2 ? el[8 + j] : el[12 + j];
                int ia = 0; float la = l4[0];
#pragma unroll
                for (int j = 1; j < 4; ++j) if (l4[j] > la) { la = l4[j]; ia = j; }
                int ib = -1; float lb = -3.0e38f;
#pragma unroll
                for (int j = 0; j < 4; ++j) if (j != ia && l4[j] > lb) { lb = l4[j]; ib = j; }
                const float eb = __expf(lb - la), wa = 1.f / (1.f + eb), wb = eb / (1.f + eb);
                const int e1 = gi * 4 + ia, e2 = gi * 4 + ib;
                const int p1 = atomicAdd(&lcnt[e1], 1), p2 = atomicAdd(&lcnt[e2], 1);
                const int lrow = lr0 + lane; const size_t row = rowb + lane;
                ent[lrow * 4 + 0] = e1; ent[lrow * 4 + 1] = p1; ent[lrow * 4 + 2] = e2; ent[lrow * 4 + 3] = p2;
                a.tok_e[row * 2] = e1; a.tok_e[row * 2 + 1] = e2; a.tok_w[row * 2] = gw * wa; a.tok_w[row * 2 + 1] = gw * wb;
            }
        }
    }
    if (a.mode == 1) {
        __syncthreads();
        if (tid < 16) lbase[tid] = atomicAdd(&a.cnt[tid], lcnt[tid]);
        __syncthreads();
        for (int r = tid; r < rows_per_block; r += nthr) {
            const int e1 = ent[r * 4], p1 = lbase[e1] + ent[r * 4 + 1], e2 = ent[r * 4 + 2], p2 = lbase[e2] + ent[r * 4 + 3];
            const int tok = ((r / (nw * 4)) * nblocks + bid) * (nw * 4) + (r % (nw * 4));
            a.list[(size_t)e1 * T + p1] = tok; a.list[(size_t)e2 * T + p2] = tok;
            a.tok_pos[tok * 2] = p1; a.tok_pos[tok * 2 + 1] = p2;
        }
    }
    __syncthreads();
}

__device__ __forceinline__ int rel_bucket_dev(int rel) {
    const int n = rel < 0 ? -rel : rel; int bk;
    if (n < 8) bk = n; else if (n >= 128) bk = 15; else { const int x = (n * n) >> 6; bk = 8 + (31 - __clz(x)); if (bk > 15) bk = 15; }
    return (rel > 0 ? 16 : 0) + bk;
}
namespace pg8 {
#define PG8_LAS __attribute__((address_space(3)))
typedef unsigned u32x4 __attribute__((ext_vector_type(4)));
typedef unsigned u32x2 __attribute__((ext_vector_type(2)));
constexpr int BM = 256, BK = 64, HALF = 128, HTB = HALF * BK * 2, STAGE_BYTES = 8 * HTB, NXCD = 8, WGM = 8;
__host__ __device__ __forceinline__ int lds_byte(int r, int c) { const int st = (r >> 4) * 2 + (c >> 5), rr = r & 15, cc = c & 31, ob = rr * 64 + cc * 2; return st * 1024 + (ob ^ (((ob >> 9) & 1) << 5)); }
__host__ __device__ __forceinline__ void stage_rc(int b, int& R, int& C) { const int st = b / 1024, sb = b % 1024, swz = sb ^ (((sb >> 9) & 1) << 5); R = (st >> 1) * 16 + swz / 64; C = (st & 1) * 32 + (swz % 64) / 2; }
__host__ __device__ __forceinline__ int perm32(int rho) { const int n = rho >> 4, i = rho & 15; return 8 * (i >> 2) + 4 * n + (i & 3); }

struct Unit { int pn, e, arow, orow, cnt; };
struct Gemm { const bf16_t* A; const bf16_t* Bt; int lda, ldb, K; size_t bt_estride; };

struct DenseOrder {
    int nM, nN, nwg, G, c;
    __device__ __forceinline__ void init(int M, int N, int G_, int c_) { nM = M / BM; nN = N / BM; nwg = nM * nN; G = G_; c = c_; }
    __device__ __forceinline__ bool next(int i, Unit& u) const {
        const long L = (long)i * G + c; if (L >= nwg) return false;
        int wgid = (int)L; { const int q = nwg / NXCD, r = nwg % NXCD, xcd = wgid % NXCD, off = wgid / NXCD; wgid = (xcd < r ? xcd * (q + 1) : r * (q + 1) + (xcd - r) * q) + off; }
        const int nig = WGM * nN, gid = wgid / nig, fm = gid * WGM, gsz = (nM - fm) < WGM ? (nM - fm) : WGM;
        const int pm = fm + ((wgid % nig) % gsz); u.pn = (wgid % nig) / gsz; u.e = 0; u.arow = pm * BM; u.orow = pm * BM; u.cnt = 0; return true;
    }
    __device__ __forceinline__ unsigned rowbyte(const Unit& u, int r, int lda) const { return (unsigned)(u.arow + r) * (unsigned)lda * 2u; }
};
template <bool GATHER> struct MoeOrder {
    const int* cnt; const int* list; int nN, G, c;
    __device__ __forceinline__ bool next(int i, Unit& u) const {
        const int lane = (int)__builtin_amdgcn_mbcnt_hi(~0u, __builtin_amdgcn_mbcnt_lo(~0u, 0u));
        const int myc = cnt[lane & (NE - 1)];
        const int x = c & 7, nwx = G >> 3; int L = __builtin_amdgcn_readfirstlane(i * nwx + (c >> 3)); bool found = false;
        u.pn = 0; u.e = 0; u.arow = 0; u.orow = 0; u.cnt = 0;
        int esel = -1, ce_sel = 0;
        { const int ce0 = __builtin_amdgcn_readlane(myc, x), nu0 = ((ce0 + 255) >> 8) * nN;
          if (L < nu0) { esel = x; ce_sel = ce0; }
          else { L -= nu0; const int ce1 = __builtin_amdgcn_readlane(myc, x + 8), nu1 = ((ce1 + 255) >> 8) * nN; if (L < nu1) { esel = x + 8; ce_sel = ce1; } } }
        if (esel >= 0) { int off = 0;
#pragma unroll
            for (int e = 0; e < NE; ++e) { const int nt = (__builtin_amdgcn_readlane(myc, e) + 255) >> 8; if (e < esel) off += nt * BM; }
            const int pm = L / nN; u.pn = L - pm * nN; u.e = esel; u.arow = pm * BM; u.orow = off + pm * BM; u.cnt = ce_sel; found = true; }
        return found;
    }
    __device__ __forceinline__ unsigned rowbyte(const Unit& u, int r, int lda) const {
        if (GATHER) { const int li = u.arow + r; const int tok = li < u.cnt ? list[(size_t)u.e * T + li] : 0; return (unsigned)tok * (unsigned)lda * 2u; }
        return (unsigned)(u.orow + r) * (unsigned)lda * 2u;
    }
};

__device__ __forceinline__ unsigned cvt_pk_bf16(float lo, float hi) { unsigned r; asm volatile("v_cvt_pk_bf16_f32 %0, %1, %2" : "=v"(r) : "v"(lo), "v"(hi)); return r; }
struct EpiBf16 {
    static constexpr bool PERM = true;
    bf16_t* O; int ldc;
    __device__ __forceinline__ void operator()(const f32x4 (&acc)[2][2][4][2], const Unit& u, int wr, int wc, int fr, int fq) const {
        const int row0 = u.orow + wr * 64 + fr, col0 = u.pn * BM + wc * 32 + 8 * fq;
#pragma unroll
        for (int ai = 0; ai < 2; ++ai)
#pragma unroll
            for (int m = 0; m < 4; ++m) { bf16_t* rowp = O + (size_t)(row0 + ai * HALF + m * 16) * ldc + col0;
#pragma unroll
                for (int bj = 0; bj < 2; ++bj) { const f32x4 v0 = acc[ai][bj][m][0], v1 = acc[ai][bj][m][1];
                    u32x4 w; w.x = cvt_pk_bf16(v0[0], v0[1]); w.y = cvt_pk_bf16(v0[2], v0[3]); w.z = cvt_pk_bf16(v1[0], v1[1]); w.w = cvt_pk_bf16(v1[2], v1[3]);
                    *(u32x4*)(rowp + bj * HALF) = w; } }
    }
};
struct EpiSwiglu {
    static constexpr bool PERM = false;
    bf16_t* O; int ldc;
    __device__ __forceinline__ void operator()(const f32x4 (&acc)[2][2][4][2], const Unit& u, int wr, int wc, int fr, int fq) const {
        const int row0 = u.orow + wr * 64 + fr, col0 = u.pn * (BM / 2) + wc * 16 + 4 * fq;
#pragma unroll
        for (int ai = 0; ai < 2; ++ai)
#pragma unroll
            for (int m = 0; m < 4; ++m) { bf16_t* rowp = O + (size_t)(row0 + ai * HALF + m * 16) * ldc + col0;
#pragma unroll
                for (int bj = 0; bj < 2; ++bj) { const f32x4 g = acc[ai][bj][m][0], v = acc[ai][bj][m][1];
                    u32x2 w; w.x = cvt_pk_bf16(silu_f(g[0]) * v[0], silu_f(g[1]) * v[1]); w.y = cvt_pk_bf16(silu_f(g[2]) * v[2], silu_f(g[3]) * v[3]);
                    *(u32x2*)(rowp + bj * (HALF / 2)) = w; } }
    }
};

template <class Epi, class Sched>
__device__ __forceinline__ void gemm_phase(PG8_LAS unsigned char* lds, const Gemm g, const Sched& S, const Epi& E, int tid) {
    const int wid = __builtin_amdgcn_readfirstlane(tid >> 6), lane = tid & 63, wr = wid >> 2, wc = wid & 3, fr = lane & 15, fq = lane >> 4;
    const int K = g.K, nt = K / BK;
    unsigned voffB[2];
#pragma unroll
    for (int i = 0; i < 2; ++i) { int R, C; stage_rc(tid * 16 + i * 8192, R, C); const int Rb = Epi::PERM ? ((R & ~31) + perm32(R & 31)) : R;
        voffB[i] = (unsigned)(Rb * g.ldb + C) * 2u; }
    const size_t kstep = (size_t)(BK * 2);
    const size_t hstepB = (size_t)HALF * g.ldb * 2, tstepB = 2 * hstepB;
    const unsigned ldsw = (unsigned)wid * 1024u;
    const int aoff = lds_byte(wr * 64 + fr, fq * 8), boff = lds_byte(wc * 32 + fr, fq * 8);
#define PG8_SA(b, h) (((b) * 2 + (h)) * HTB)
#define PG8_SB(b, h) ((4 + (b) * 2 + (h)) * HTB)
#define PG8_STAGE(bufoff, gbase, voff) do { _Pragma("unroll") for (int _i = 0; _i < 2; ++_i) \
        __builtin_amdgcn_global_load_lds((const unsigned*)((const char*)(gbase) + (voff)[_i]), (PG8_LAS unsigned*)(lds + (bufoff) + ldsw + _i * 8192), 16, 0, 0); } while (0)
#define PG8_LDA(dst, b, h) do { _Pragma("unroll") for (int m = 0; m < 4; ++m) _Pragma("unroll") for (int k = 0; k < 2; ++k) dst[m][k] = *(const PG8_LAS bf16x8*)(lds + PG8_SA(b, h) + aoff + m * 2048 + k * 1024); } while (0)
#define PG8_LDB(dst, b, h) do { _Pragma("unroll") for (int n = 0; n < 2; ++n) _Pragma("unroll") for (int k = 0; k < 2; ++k) dst[n][k] = *(const PG8_LAS bf16x8*)(lds + PG8_SB(b, h) + boff + n * 2048 + k * 1024); } while (0)
#define PG8_MMA(ai, bj, At, Bt) do { __builtin_amdgcn_s_setprio(1); _Pragma("unroll") for (int m = 0; m < 4; ++m) _Pragma("unroll") for (int n = 0; n < 2; ++n) _Pragma("unroll") for (int k = 0; k < 2; ++k) \
        acc[ai][bj][m][n] = __builtin_amdgcn_mfma_f32_16x16x32_bf16(Bt[n][k], At[m][k], acc[ai][bj][m][n], 0, 0, 0); __builtin_amdgcn_s_setprio(0); } while (0)
#define PG8_WAIT_V(n) asm volatile("s_waitcnt vmcnt(" #n ")" ::: "memory")
#define PG8_WAIT_L(n) asm volatile("s_waitcnt lgkmcnt(" #n ")" ::: "memory")
#define PG8_BAR __builtin_amdgcn_s_barrier()
#define PG8_SCHED __builtin_amdgcn_sched_barrier(0)
#define PG8_ROWS(dst, u) do { int _t = tid; asm volatile("" : "+v"(_t)); _Pragma("unroll") for (int _i = 0; _i < 2; ++_i) { int _R, _C; stage_rc(_t * 16 + _i * 8192, _R, _C); \
        _Pragma("unroll") for (int _h = 0; _h < 2; ++_h) dst[_h][_i] = S.rowbyte(u, _h * HALF + _R, g.lda) + (unsigned)(_C * 2); } } while (0)
    Unit cur, nxt; int ui = 0;
    if (!S.next(0, cur)) return;
    f32x4 acc[2][2][4][2];
#pragma unroll
    for (int a = 0; a < 2; ++a)
#pragma unroll
        for (int b = 0; b < 2; ++b)
#pragma unroll
            for (int m = 0; m < 4; ++m)
#pragma unroll
                for (int n = 0; n < 2; ++n) acc[a][b][m][n] = (f32x4){0.f, 0.f, 0.f, 0.f};
    bf16x8 At[4][2], B0[2][2], B1[2][2];
    unsigned cvA[2][2], nvA[2][2];
    PG8_ROWS(cvA, cur);
    const char* const gA = (const char*)g.A;
    const char* cB = (const char*)g.Bt + (size_t)cur.e * g.bt_estride * 2 + (size_t)cur.pn * tstepB;
    PG8_STAGE(PG8_SB(0, 0), cB, voffB); PG8_STAGE(PG8_SB(0, 1), cB + hstepB, voffB); PG8_STAGE(PG8_SA(0, 0), gA, cvA[0]); PG8_STAGE(PG8_SA(0, 1), gA, cvA[1]);
    if (wr == 1) PG8_BAR;
    PG8_WAIT_V(2); PG8_BAR;
    PG8_STAGE(PG8_SB(1, 0), cB + kstep, voffB); PG8_STAGE(PG8_SA(1, 0), gA + kstep, cvA[0]); PG8_STAGE(PG8_SB(1, 1), cB + hstepB + kstep, voffB);
    PG8_WAIT_V(6); PG8_BAR;
    for (;;) {
        const bool has_next = S.next(ui + 1, nxt);
        const char* nB = has_next ? (const char*)g.Bt + (size_t)nxt.e * g.bt_estride * 2 + (size_t)nxt.pn * tstepB : cB;
        if (has_next) { PG8_ROWS(nvA, nxt); }
        else {
#pragma unroll
            for (int _h = 0; _h < 2; ++_h)
#pragma unroll
                for (int _i = 0; _i < 2; ++_i) nvA[_h][_i] = cvA[_h][_i];
        }
        for (int t = 0; t < nt; t += 2) {
            const bool last = (t == nt - 2);
            const char* a1 = gA + (size_t)(t + 1) * kstep;
            const char* a2 = last ? gA : gA + (size_t)(t + 2) * kstep; const char* b2 = last ? nB : cB + (size_t)(t + 2) * kstep;
            const char* a3 = a2 + kstep; const char* b3 = b2 + kstep;
            PG8_LDB(B0, 0, 0); PG8_LDB(B1, 0, 1); PG8_SCHED; PG8_LDA(At, 0, 0); PG8_STAGE(PG8_SA(1, 1), a1, cvA[1]);
            PG8_WAIT_V(8); PG8_WAIT_L(0); PG8_BAR; PG8_MMA(0, 0, At, B0); PG8_MMA(0, 1, At, B1); PG8_BAR; PG8_SCHED;
            PG8_LDA(At, 0, 1); PG8_STAGE(PG8_SB(0, 0), b2, voffB); PG8_STAGE(PG8_SB(0, 1), b2 + hstepB, voffB); if (last) PG8_STAGE(PG8_SA(0, 0), a2, nvA[0]); else PG8_STAGE(PG8_SA(0, 0), a2, cvA[0]);
            PG8_WAIT_V(8); PG8_WAIT_L(0); PG8_BAR; PG8_MMA(1, 0, At, B0); PG8_MMA(1, 1, At, B1); PG8_BAR; PG8_SCHED;
            PG8_LDB(B0, 1, 0); PG8_LDB(B1, 1, 1); PG8_SCHED; PG8_LDA(At, 1, 0); if (last) PG8_STAGE(PG8_SA(0, 1), a2, nvA[1]); else PG8_STAGE(PG8_SA(0, 1), a2, cvA[1]);
            PG8_WAIT_V(8); PG8_WAIT_L(0); PG8_BAR; PG8_MMA(0, 0, At, B0); PG8_MMA(0, 1, At, B1); PG8_BAR; PG8_SCHED;
            PG8_LDA(At, 1, 1); PG8_STAGE(PG8_SB(1, 0), b3, voffB); PG8_STAGE(PG8_SB(1, 1), b3 + hstepB, voffB); if (last) PG8_STAGE(PG8_SA(1, 0), a3, nvA[0]); else PG8_STAGE(PG8_SA(1, 0), a3, cvA[0]);
            PG8_WAIT_V(8); PG8_WAIT_L(0); PG8_BAR; PG8_MMA(1, 0, At, B0); PG8_MMA(1, 1, At, B1); PG8_BAR; PG8_SCHED;
        }
        if (wr == 0) PG8_BAR;
        E(acc, cur, wr, wc, fr, fq);
        if (!has_next) break;
#pragma unroll
        for (int a = 0; a < 2; ++a)
#pragma unroll
            for (int b = 0; b < 2; ++b)
#pragma unroll
                for (int m = 0; m < 4; ++m)
#pragma unroll
                    for (int n = 0; n < 2; ++n) acc[a][b][m][n] = (f32x4){0.f, 0.f, 0.f, 0.f};
        cur = nxt; cB = nB; ++ui;
#pragma unroll
        for (int _h = 0; _h < 2; ++_h)
#pragma unroll
            for (int _i = 0; _i < 2; ++_i) cvA[_h][_i] = nvA[_h][_i];
        if (wr == 1) PG8_BAR;
    }
    PG8_WAIT_V(0);
    PG8_BAR;
#undef PG8_SA
#undef PG8_SB
#undef PG8_STAGE
#undef PG8_LDA
#undef PG8_LDB
#undef PG8_MMA
#undef PG8_WAIT_V
#undef PG8_WAIT_L
#undef PG8_BAR
#undef PG8_SCHED
#undef PG8_ROWS
}
}

namespace att {
using s16x4  = __attribute__((ext_vector_type(4))) short;
using f32x16 = __attribute__((ext_vector_type(16))) float;
using f32x2  = __attribute__((ext_vector_type(2))) float;
using u32x4  = __attribute__((ext_vector_type(4))) unsigned;
constexpr int NW = 8, QBLK = 32, KVBLK = 64, LDKV = 2048, LDQ = 1024;
constexpr int SHM_V = KVBLK * ADV * 2, SHM_K = KVBLK * ADH * 2;
constexpr int OFF_V = 0, OFF_K = 4 * SHM_V, OFF_WS = OFF_K + 4 * SHM_K, OFF_LUT = OFF_WS + NW * 64 * 4, LDS_ATT = OFF_LUT + 1024;
constexpr float LOG2E = 1.4426950408889634f, THR2 = 8.f * LOG2E;
#define KSWZ64(row, colB) ((row) * 128 + ((colB) ^ ((((row) >> 1) & 7) << 4)))
#define SBAR() __builtin_amdgcn_sched_barrier(0)
__device__ __forceinline__ int crow(int r, int hi) { return (r & 3) + 8 * (r >> 2) + 4 * hi; }
typedef __bf16 bf2_t __attribute__((ext_vector_type(2)));
__device__ __forceinline__ unsigned cvtpk(float lo, float hi) { const f32x2 v = {lo, hi}; return __builtin_bit_cast(unsigned, __builtin_convertvector(v, bf2_t)); }

__device__ __forceinline__ void sm_max0(const f32x16& p0, float& pmax) {
  pmax = p0[0];
#pragma unroll
  for (int r = 1; r < 16; ++r) pmax = fmaxf(pmax, p0[r]);
}
__device__ __forceinline__ void sm_decide(f32x16& p0, f32x16& p1, float& pmax, float& m_reg, float& alpha, f32x16& ct) {
#pragma unroll
  for (int r = 0; r < 16; ++r) pmax = fmaxf(pmax, p1[r]);
  { auto rr = __builtin_amdgcn_permlane32_swap(__float_as_uint(pmax), __float_as_uint(pmax), false, false);
    pmax = fmaxf(__uint_as_float(rr[0]), __uint_as_float(rr[1])); }
  if (__builtin_expect(__all(pmax <= THR2), 1)) { alpha = 1.f; }
  else { const float d = fmaxf(pmax, 0.f); alpha = __builtin_amdgcn_exp2f(-d); m_reg += d;
#pragma unroll
    for (int r = 0; r < 16; ++r) { p0[r] -= d; p1[r] -= d; ct[r] -= d; } }
}
__device__ __forceinline__ void sm_exp(f32x16& p) {
#pragma unroll
  for (int r = 0; r < 16; ++r) p[r] = __builtin_amdgcn_exp2f(p[r]);
}
__device__ __forceinline__ void sm_first(f32x16& p0, f32x16& p1, float& m_reg) {
  float pmax; sm_max0(p0, pmax);
#pragma unroll
  for (int r = 0; r < 16; ++r) pmax = fmaxf(pmax, p1[r]);
  { auto rr = __builtin_amdgcn_permlane32_swap(__float_as_uint(pmax), __float_as_uint(pmax), false, false);
    pmax = fmaxf(__uint_as_float(rr[0]), __uint_as_float(rr[1])); }
  m_reg = pmax;
#pragma unroll
  for (int r = 0; r < 16; ++r) { p0[r] = __builtin_amdgcn_exp2f(p0[r] - pmax); p1[r] = __builtin_amdgcn_exp2f(p1[r] - pmax); }
}
__device__ __forceinline__ void finishSM(const f32x16& p0, const f32x16& p1, float alpha, float& l_reg, bf16x8& pa0, bf16x8& pa1, bf16x8& pa2, bf16x8& pa3) {
  f32x2 a = {p0[0], p0[1]}, b = {p0[2], p0[3]};
#pragma unroll
  for (int r = 4; r < 16; r += 4) { a += (f32x2){p0[r], p0[r + 1]}; b += (f32x2){p0[r + 2], p0[r + 3]}; }
#pragma unroll
  for (int r = 0; r < 16; r += 4) { a += (f32x2){p1[r], p1[r + 1]}; b += (f32x2){p1[r + 2], p1[r + 3]}; }
  float ps = (a[0] + a[1]) + (b[0] + b[1]);
  { auto rr = __builtin_amdgcn_permlane32_swap(__float_as_uint(ps), __float_as_uint(ps), false, false);
    ps = __uint_as_float(rr[0]) + __uint_as_float(rr[1]); }
  l_reg = l_reg * alpha + ps;
#define PK4(P, BASE, OUT) do { u32x4 w = {cvtpk(P[BASE + 0], P[BASE + 1]), cvtpk(P[BASE + 2], P[BASE + 3]), cvtpk(P[BASE + 4], P[BASE + 5]), cvtpk(P[BASE + 6], P[BASE + 7])}; OUT = *reinterpret_cast<bf16x8*>(&w); } while (0)
  PK4(p0, 0, pa0); PK4(p0, 8, pa1); PK4(p1, 0, pa2); PK4(p1, 8, pa3);
#undef PK4
}
#ifndef ATT_BIGSUM_LOG2
#define ATT_BIGSUM_LOG2 17.5f
#endif
template <int A, int B> __device__ __forceinline__ void sm_expr(f32x16& p) {
#pragma unroll
  for (int r = A; r < B; ++r) p[r] = __builtin_amdgcn_exp2f(p[r]);
}
template <int H> __device__ __forceinline__ void sm_exp8(f32x16& p) {
#pragma unroll
  for (int r = 8 * H; r < 8 * H + 8; ++r) p[r] = __builtin_amdgcn_exp2f(p[r]);
}
__device__ __forceinline__ float sm_rowsum(const f32x16& p0, const f32x16& p1) {
  f32x2 a = {p0[0], p0[1]}, b = {p0[2], p0[3]};
#pragma unroll
  for (int r = 4; r < 16; r += 4) { a += (f32x2){p0[r], p0[r + 1]}; b += (f32x2){p0[r + 2], p0[r + 3]}; }
#pragma unroll
  for (int r = 0; r < 16; r += 4) { a += (f32x2){p1[r], p1[r + 1]}; b += (f32x2){p1[r + 2], p1[r + 3]}; }
  float ps = (a[0] + a[1]) + (b[0] + b[1]);
  { auto rr = __builtin_amdgcn_permlane32_swap(__float_as_uint(ps), __float_as_uint(ps), false, false);
    ps = __uint_as_float(rr[0]) + __uint_as_float(rr[1]); }
  return ps;
}
__device__ __forceinline__ void sm_pack(const f32x16& p0, const f32x16& p1, bf16x8& pa0, bf16x8& pa1, bf16x8& pa2, bf16x8& pa3) {
#define PK4(P, BASE, OUT) do { u32x4 w = {cvtpk(P[BASE + 0], P[BASE + 1]), cvtpk(P[BASE + 2], P[BASE + 3]), cvtpk(P[BASE + 4], P[BASE + 5]), cvtpk(P[BASE + 6], P[BASE + 7])}; OUT = *reinterpret_cast<bf16x8*>(&w); } while (0)
  PK4(p0, 0, pa0); PK4(p0, 8, pa1); PK4(p1, 0, pa2); PK4(p1, 8, pa3);
#undef PK4
}
template <int KOFF> __device__ __forceinline__ void qkt_far(f32x16& p0, f32x16& p1, const f32x16& ct, const int* kb, const bf16x8* qr) {
  bf16x8 b0[4], b1[4];
#pragma unroll
  for (int d0 = 0; d0 < 4; ++d0) { b0[d0] = *(const PG8_LAS bf16x8*)(unsigned)(kb[d0] + KOFF); b1[d0] = *(const PG8_LAS bf16x8*)(unsigned)(kb[d0] + KOFF + 4096); }
  SBAR();
#pragma unroll
  for (int d0 = 0; d0 < 4; ++d0) {
    if (d0 == 0) { p0 = __builtin_amdgcn_mfma_f32_32x32x16_bf16(b0[0], qr[0], ct, 0, 0, 0); p1 = __builtin_amdgcn_mfma_f32_32x32x16_bf16(b1[0], qr[0], ct, 0, 0, 0); }
    else { p0 = __builtin_amdgcn_mfma_f32_32x32x16_bf16(b0[d0], qr[d0], p0, 0, 0, 0); p1 = __builtin_amdgcn_mfma_f32_32x32x16_bf16(b1[d0], qr[d0], p1, 0, 0, 0); } }
}
template <int MODE> __device__ __forceinline__ void qkt(f32x16& p0, f32x16& p1, const f32x16& ct, const char* Ks, const bf16x8* qr, int r32, int hi) {
  bf16x8 b0[4], b1[4];
#pragma unroll
  for (int d0 = 0; d0 < 4; ++d0) { const int cb = (d0 * 16 + hi * 8) * 2;
    b0[d0] = *reinterpret_cast<const bf16x8*>(Ks + KSWZ64(r32, cb)); b1[d0] = *reinterpret_cast<const bf16x8*>(Ks + KSWZ64(32 + r32, cb)); }
  SBAR();
#pragma unroll
  for (int d0 = 0; d0 < 4; ++d0) {
    if (MODE == 0 && d0 == 0) { p0 = __builtin_amdgcn_mfma_f32_32x32x16_bf16(b0[0], qr[0], ct, 0, 0, 0); p1 = __builtin_amdgcn_mfma_f32_32x32x16_bf16(b1[0], qr[0], ct, 0, 0, 0); }
    else { p0 = __builtin_amdgcn_mfma_f32_32x32x16_bf16(b0[d0], qr[d0], p0, 0, 0, 0); p1 = __builtin_amdgcn_mfma_f32_32x32x16_bf16(b1[d0], qr[d0], p1, 0, 0, 0); } }
}
__device__ __forceinline__ void p_init(f32x16& p0, f32x16& p1, int j, int cq, int qoff, int hi, const float* lut, float m_reg) {
  if (j > cq) {
#pragma unroll
    for (int r = 0; r < 16; ++r) { p0[r] = -1e30f; p1[r] = -1e30f; }
  } else {
    const float* lp = lut + (64 * (j - cq) - qoff + 192 + 4 * hi);
#pragma unroll
    for (int r = 0; r < 16; ++r) { p0[r] = lp[(r & 3) + 8 * (r >> 2)] - m_reg; p1[r] = lp[32 + (r & 3) + 8 * (r >> 2)] - m_reg; }
  }
}
#define QK_TILE(p0, p1, j, Ks) do { if ((j) < cq - 2) qkt<0>(p0, p1, ct, Ks, qr, r32, hi); else { p_init(p0, p1, j, cq, qoff, hi, lut, m_reg); qkt<1>(p0, p1, ct, Ks, qr, r32, hi); } } while (0)
__device__ __forceinline__ int v_st(int k, int c) { const int kk = (k & ~0xC) | ((k & 4) << 1) | ((k & 8) >> 1); return ((kk >> 3) * 4 + (c >> 5)) * 512 + ((kk & 7) * 32 + (c & 31)) * 2; }
__device__ __forceinline__ int v_rd_base(int lane) { return ((lane & 3) << 3) | (((lane >> 2) & 3) << 6) | (((lane >> 4) & 1) << 5) | (((lane >> 5) & 1) << 11); }
constexpr int v_rd_off(int d0, int ks, int half) { return d0 * 512 + ks * 4096 + half * 256; }
template <int OFF> __device__ __forceinline__ s16x4 tr_read(int vb) {
  s16x4 r; asm volatile("ds_read_b64_tr_b16 %0, %1 offset:%2" : "=&v"(r) : "v"(vb), "i"(OFF) : "memory"); return r;
}
struct VFrag { s16x4 l0, h0, l1, h1, l2, h2, l3, h3; };
template <int D0, int SOFF = 0> __device__ __forceinline__ void pv_load(VFrag& f, int vb) {
  f.l0 = tr_read<SOFF + v_rd_off(D0, 0, 0)>(vb); f.h0 = tr_read<SOFF + v_rd_off(D0, 0, 1)>(vb); f.l1 = tr_read<SOFF + v_rd_off(D0, 1, 0)>(vb); f.h1 = tr_read<SOFF + v_rd_off(D0, 1, 1)>(vb);
  f.l2 = tr_read<SOFF + v_rd_off(D0, 2, 0)>(vb); f.h2 = tr_read<SOFF + v_rd_off(D0, 2, 1)>(vb); f.l3 = tr_read<SOFF + v_rd_off(D0, 3, 0)>(vb); f.h3 = tr_read<SOFF + v_rd_off(D0, 3, 1)>(vb);
}
__device__ __forceinline__ void pv_mma(f32x16& od, const VFrag& f, bf16x8 pa0, bf16x8 pa1, bf16x8 pa2, bf16x8 pa3) {
#define PK(L, H) (bf16x8){L[0], L[1], L[2], L[3], H[0], H[1], H[2], H[3]}
  od = __builtin_amdgcn_mfma_f32_32x32x16_bf16(pa0, PK(f.l0, f.h0), od, 0, 0, 0);
  od = __builtin_amdgcn_mfma_f32_32x32x16_bf16(pa1, PK(f.l1, f.h1), od, 0, 0, 0);
  od = __builtin_amdgcn_mfma_f32_32x32x16_bf16(pa2, PK(f.l2, f.h2), od, 0, 0, 0);
  od = __builtin_amdgcn_mfma_f32_32x32x16_bf16(pa3, PK(f.l3, f.h3), od, 0, 0, 0);
#undef PK
}
#define PV_LGK(n) do { asm volatile("s_waitcnt lgkmcnt(" #n ")" ::: "memory"); SBAR(); } while (0)
#define PV_PRE(vb) VFrag fA_, fB_; pv_load<0>(fA_, vb); pv_load<1>(fB_, vb)
#define PV_PRE_S(SO) VFrag fA_, fB_; pv_load<0, SO>(fA_, vb0); pv_load<1, SO>(fB_, vb0)
#define PV_WITH_SM_S(o, SO, pa0, pa1, pa2, pa3, q0, q1) do {   \
    PV_LGK(8); pv_mma(o[0], fA_, pa0, pa1, pa2, pa3); sm_expr<0, 4>(q0); asm volatile("" : "+v"(q0)); \
    pv_load<2, SO>(fA_, vb0); PV_LGK(8); pv_mma(o[1], fB_, pa0, pa1, pa2, pa3); sm_expr<4, 12>(q0); asm volatile("" : "+v"(q0)); \
    pv_load<3, SO>(fB_, vb0); PV_LGK(8); pv_mma(o[2], fA_, pa0, pa1, pa2, pa3); sm_expr<12, 16>(q0); sm_expr<0, 6>(q1); asm volatile("" : "+v"(q0), "+v"(q1)); \
    PV_LGK(0); pv_mma(o[3], fB_, pa0, pa1, pa2, pa3); sm_expr<6, 16>(q1); asm volatile("" : "+v"(q1)); } while (0)
#define PV_WITH_SM(o, vb, pa0, pa1, pa2, pa3, q0, q1) do { \
    PV_LGK(8); pv_mma(o[0], fA_, pa0, pa1, pa2, pa3); sm_exp8<0>(q0); asm volatile("" : "+v"(q0)); \
    pv_load<2>(fA_, vb); PV_LGK(8); pv_mma(o[1], fB_, pa0, pa1, pa2, pa3); sm_exp8<1>(q0); asm volatile("" : "+v"(q0)); \
    pv_load<3>(fB_, vb); PV_LGK(8); pv_mma(o[2], fA_, pa0, pa1, pa2, pa3); sm_exp8<0>(q1); asm volatile("" : "+v"(q1)); \
    PV_LGK(0); pv_mma(o[3], fB_, pa0, pa1, pa2, pa3); sm_exp8<1>(q1); asm volatile("" : "+v"(q1)); } while (0)
#define PV_ONLY(o, vb, pa0, pa1, pa2, pa3) do { \
    PV_LGK(8); pv_mma(o[0], fA_, pa0, pa1, pa2, pa3); pv_load<2>(fA_, vb); PV_LGK(8); pv_mma(o[1], fB_, pa0, pa1, pa2, pa3); \
    pv_load<3>(fB_, vb); PV_LGK(8); pv_mma(o[2], fA_, pa0, pa1, pa2, pa3); PV_LGK(0); pv_mma(o[3], fB_, pa0, pa1, pa2, pa3); } while (0)

__device__ __forceinline__ void attn_unit(const int FIN, const bf16_t* __restrict__ Qb, const bf16_t* __restrict__ Kh, const bf16_t* __restrict__ Vh, bf16_t* __restrict__ Ob, float* __restrict__ park,
                                                             float lam, const float* __restrict__ g_sub, float gscale, int qb, char* lds, int tid) {
  const int wid = __builtin_amdgcn_readfirstlane(tid >> 6), lane = tid & 63, r32 = lane & 31, hi = lane >> 5;
  char* V_lds = lds + OFF_V; char* K_lds = lds + OFF_K;
  float* ws = (float*)(lds + OFF_WS) + wid * 64; float* li_l = ws; float* al_l = ws + 32;
  const float* lut = (const float*)(lds + OFF_LUT);
  const float cfar = lut[0];
  const int cq = 4 * qb + (wid >> 1), qoff = 32 * (wid & 1) + r32;
  float m_reg = 0.f, l_reg = 0; f32x16 o[4] = {}; bf16x8 qr[4]; f32x16 ct;
  const bf16_t* Qw = Qb + (size_t)(wid * QBLK + r32) * LDQ + hi * 8;
#pragma unroll
  for (int d0 = 0; d0 < 4; ++d0) qr[d0] = *reinterpret_cast<const bf16x8*>(Qw + d0 * 16);
  const int kq = wid * 64 + lane, krow = kq >> 3, kcs = (kq & 7) ^ ((krow >> 1) & 7);
  const unsigned kgb = (unsigned)(krow * LDKV + kcs * 8) * 2u;
  unsigned vgb[2];
#pragma unroll
  for (int i = 0; i < 2; ++i) { const int P = ((i * 8 + wid) * 64 + lane) * 16, sub = P >> 9, rem = P & 511, kk = (sub >> 2) * 8 + (rem >> 6), c = (sub & 3) * 32 + ((rem & 63) >> 1);
    const int k = (kk & ~0xC) | ((kk & 4) << 1) | ((kk & 8) >> 1); vgb[i] = (unsigned)(k * LDKV + c) * 2u; }
  const __amdgpu_buffer_rsrc_t krs = __builtin_amdgcn_make_buffer_rsrc((void*)Kh, 0, 0x08000000, 0x00020000), vrs = __builtin_amdgcn_make_buffer_rsrc((void*)Vh, 0, 0x08000000, 0x00020000);
  const int vb0 = (int)(uintptr_t)V_lds + v_rd_base(lane);
  PG8_LAS unsigned char* const ldsl = (PG8_LAS unsigned char*)lds;
#define GLD(t) do { const unsigned so_ = (unsigned)(t) * (unsigned)(KVBLK * LDKV * 2); const int sl_ = (t) & 3; \
    __builtin_amdgcn_raw_ptr_buffer_load_lds(krs, (PG8_LAS void*)(ldsl + OFF_K + sl_ * SHM_K + wid * 1024), 16, kgb, so_, 0, 0); \
    __builtin_amdgcn_raw_ptr_buffer_load_lds(vrs, (PG8_LAS void*)(ldsl + OFF_V + sl_ * SHM_V + wid * 1024), 16, vgb[0], so_, 0, 0); \
    __builtin_amdgcn_raw_ptr_buffer_load_lds(vrs, (PG8_LAS void*)(ldsl + OFF_V + sl_ * SHM_V + (8 + wid) * 1024), 16, vgb[1], so_, 0, 0); } while (0)
#define TILE_BAR(n) do { asm volatile("s_waitcnt vmcnt(" #n ")" ::: "memory"); __builtin_amdgcn_s_barrier(); asm volatile("" ::: "memory"); } while (0)
#define RESC(a) do { if (__any((a) < 1.f)) { if (hi == 0) al_l[r32] = (a); asm volatile("s_waitcnt lgkmcnt(0)" ::: "memory"); \
    _Pragma("unroll") for (int d = 0; d < 4; ++d) _Pragma("unroll") for (int r = 0; r < 16; ++r) o[d][r] *= al_l[crow(r, hi)]; } } while (0)
  f32x16 pA0, pA1, pB0, pB1; float alA = 1.f, alB; bf16x8 pa0, pa1, pa2, pa3; const int NT = 4 * qb + 4;
  constexpr int SE = 0, SO = 1;
  GLD(0); GLD(1); TILE_BAR(3);
  if (0 < cq - 2) {
#pragma unroll
    for (int r = 0; r < 16; ++r) { pA0[r] = cfar; pA1[r] = cfar; }
  } else p_init(pA0, pA1, 0, cq, qoff, hi, lut, 0.f);
  qkt<1>(pA0, pA1, ct, K_lds, qr, r32, hi); sm_first(pA0, pA1, m_reg);
#pragma unroll
  for (int r = 0; r < 16; ++r) ct[r] = cfar - m_reg;
  GLD(2); TILE_BAR(3);
#define FIN_SM(pC0, pC1, pN0, pN1, HASN) do { float ps_ = sm_rowsum(pC0, pC1); \
    if (__builtin_expect(__any(ps_ > BIGSUM), 0)) { const float d_ = ps_ > BIGSUM ? __builtin_amdgcn_logf(ps_) : 0.f, a_ = __builtin_amdgcn_exp2f(-d_); \
      m_reg += d_; ps_ *= a_; l_reg *= a_; \
      _Pragma("unroll") for (int r = 0; r < 16; ++r) { pC0[r] *= a_; pC1[r] *= a_; ct[r] -= d_; if (HASN) { pN0[r] -= d_; pN1[r] -= d_; } } \
      RESC(a_); } \
    l_reg += ps_; sm_pack(pC0, pC1, pa0, pa1, pa2, pa3); } while (0)
  const float BIGSUM = __builtin_amdgcn_exp2f(ATT_BIGSUM_LOG2);
#define GLD_S(t, SL) do { const unsigned so_ = (unsigned)(t) * (unsigned)(KVBLK * LDKV * 2); \
    __builtin_amdgcn_raw_ptr_buffer_load_lds(krs, (PG8_LAS void*)(ldsl + OFF_K + (SL) * SHM_K + wid * 1024), 16, kgb, so_, 0, 0); \
    __builtin_amdgcn_raw_ptr_buffer_load_lds(vrs, (PG8_LAS void*)(ldsl + OFF_V + (SL) * SHM_V + wid * 1024), 16, vgb[0], so_, 0, 0); \
    __builtin_amdgcn_raw_ptr_buffer_load_lds(vrs, (PG8_LAS void*)(ldsl + OFF_V + (SL) * SHM_V + (8 + wid) * 1024), 16, vgb[1], so_, 0, 0); } while (0)
#define FAR_STEP(pN0, pN1, pC0, pC1, T_, SK, SV, CHK) do { { SBAR(); qkt_far<(SK) * SHM_K>(pN0, pN1, ct, kbl, qr); \
    asm volatile("s_waitcnt lgkmcnt(0)" ::: "memory"); SBAR(); PV_PRE_S((SV) * SHM_V); SBAR(); \
    FIN_SM(pC0, pC1, pN0, pN1, true); SBAR(); \
    GLD_S((T_) + 2, ((SK) + 2) & 3); SBAR(); \
    PV_WITH_SM_S(o, (SV) * SHM_V, pa0, pa1, pa2, pa3, pN0, pN1); } \
    TILE_BAR(3); } while (0)
  int kbl[4];
#pragma unroll
  for (int d0 = 0; d0 < 4; ++d0) { kbl[d0] = (int)(uintptr_t)K_lds + KSWZ64(r32, (d0 * 16 + hi * 8) * 2); asm volatile("" : "+v"(kbl[d0])); }
  const int nfar4 = qb > 0 ? qb - 1 : 0;
#pragma unroll 1
  for (int g4 = 0; g4 < nfar4; ++g4) { const int t0_ = 4 * g4 + 1;
    FAR_STEP(pB0, pB1, pA0, pA1, t0_, 1, 0, 0); FAR_STEP(pA0, pA1, pB0, pB1, t0_ + 1, 2, 1, 0); FAR_STEP(pB0, pB1, pA0, pA1, t0_ + 2, 3, 2, 0); FAR_STEP(pA0, pA1, pB0, pB1, t0_ + 3, 0, 3, 0); }
#undef FAR_STEP
#undef GLD_S
  for (int j = 4 * nfar4 + 1; j + 1 < NT; j += 2) {
    { SBAR(); QK_TILE(pB0, pB1, j, K_lds + (j & 3) * SHM_K);
    asm volatile("s_waitcnt lgkmcnt(0)" ::: "memory"); SBAR(); PV_PRE(vb0 + ((j - 1) & 3) * SHM_V); SBAR();
    FIN_SM(pA0, pA1, pB0, pB1, true); SBAR();
    GLD(j + 2); SBAR();
    PV_WITH_SM(o, vb0 + ((j - 1) & 3) * SHM_V, pa0, pa1, pa2, pa3, pB0, pB1); }
    TILE_BAR(3);
    { SBAR(); QK_TILE(pA0, pA1, j + 1, K_lds + ((j + 1) & 3) * SHM_K);
    asm volatile("s_waitcnt lgkmcnt(0)" ::: "memory"); SBAR(); PV_PRE(vb0 + (j & 3) * SHM_V); SBAR();
    FIN_SM(pB0, pB1, pA0, pA1, true); SBAR();
    if (j + 3 < NT) { GLD(j + 3); } SBAR();
    PV_WITH_SM(o, vb0 + (j & 3) * SHM_V, pa0, pa1, pa2, pa3, pA0, pA1); }
    if (j + 3 < NT) TILE_BAR(3); else TILE_BAR(0);
  }
  { SBAR(); QK_TILE(pB0, pB1, NT - 1, K_lds + ((NT - 1) & 3) * SHM_K);
  { asm volatile("s_waitcnt lgkmcnt(0)" ::: "memory"); SBAR(); PV_PRE(vb0 + ((NT - 2) & 3) * SHM_V); SBAR();
  FIN_SM(pA0, pA1, pB0, pB1, true); SBAR();
  PV_WITH_SM(o, vb0 + ((NT - 2) & 3) * SHM_V, pa0, pa1, pa2, pa3, pB0, pB1); }
  { asm volatile("s_waitcnt lgkmcnt(0)" ::: "memory"); SBAR(); PV_PRE(vb0 + ((NT - 1) & 3) * SHM_V); SBAR();
  FIN_SM(pB0, pB1, pB0, pB1, false); SBAR();
  PV_ONLY(o, vb0 + ((NT - 1) & 3) * SHM_V, pa0, pa1, pa2, pa3); } }
#undef FIN_SM
  if (hi == 0) li_l[r32] = l_reg; asm volatile("s_waitcnt lgkmcnt(0)" ::: "memory");
  float rli[16];
#pragma unroll
  for (int r = 0; r < 16; ++r) rli[r] = __builtin_amdgcn_rcpf(li_l[crow(r, hi)]);
  float* pk = park + (size_t)wid * 4096 + lane;
  if (FIN == 0) {
#pragma unroll
    for (int r = 0; r < 16; ++r)
#pragma unroll
      for (int d0 = 0; d0 < 4; ++d0) pk[(r * 4 + d0) * 64] = o[d0][r] * rli[r];
  } else {
    float ss[16];
#pragma unroll
    for (int r = 0; r < 16; ++r) { float q = 0.f;
#pragma unroll
      for (int d0 = 0; d0 < 4; ++d0) { const float x = pk[(r * 4 + d0) * 64] - lam * (o[d0][r] * rli[r]); o[d0][r] = x; q += x * x; }
      ss[r] = q; }
    halve_step<16, 16>(ss, lane); halve_step<8, 8>(ss, lane); halve_step<4, 4>(ss, lane); halve_step<2, 2>(ss, lane); ss[0] += __shfl_xor(ss[0], 1);
    if ((lane & 1) == 0) al_l[hi * 16 + ((lane >> 4) & 1) * 8 + ((lane >> 3) & 1) * 4 + ((lane >> 2) & 1) * 2 + ((lane >> 1) & 1)] = rsqrtf(ss[0] * (1.f / ADV) + LN_EPS) * gscale;
    asm volatile("s_waitcnt lgkmcnt(0)" ::: "memory");
    float gs[4];
#pragma unroll
    for (int d0 = 0; d0 < 4; ++d0) gs[d0] = g_sub[d0 * 32 + r32];
    bf16_t* Ow = Ob + (size_t)(wid * QBLK) * LDQ;
#pragma unroll
    for (int r = 0; r < 16; ++r) { const int orow = crow(r, hi); const float rs = al_l[hi * 16 + r];
#pragma unroll
      for (int d0 = 0; d0 < 4; ++d0) Ow[(size_t)orow * LDQ + d0 * 32 + r32] = f2bf(o[d0][r] * rs * gs[d0]); }
  }
  __syncthreads();
#undef GLD
#undef TILE_BAR
#undef RESC
}
__device__ __forceinline__ void attn_phase(const bf16_t* Q, const bf16_t* KV, float* park, bf16_t* OB, const float* rel_table, const float* lq1, const float* lk1, const float* lq2, const float* lk2, const float* g_sub,
                                           float lambda_init, char* lds, int tid) {
  const int bx = blockIdx.x, xcd = bx & 7, slot = bx >> 3, combo = xcd * 2 + (slot >> 4), wi = slot & 15;
  const int h = combo & 7, b = combo >> 3, lane = tid & 63;
  float* lut = (float*)(lds + OFF_LUT);
  if (tid < 256) lut[tid] = rel_table[rel_bucket_dev(tid - 192) * AH + h] * LOG2E;
  __syncthreads();
  const float lam = __uint_as_float(__builtin_amdgcn_readfirstlane(__float_as_uint(__expf(wave_sum(lq1[lane] * lk1[lane])) - __expf(wave_sum(lq2[lane] * lk2[lane])) + lambda_init)));
  const bf16_t* K1 = KV + (size_t)b * SEQ * LDKV + h * ADH;
  const bf16_t* Vh = KV + (size_t)b * SEQ * LDKV + 1024 + h * ADV;
  float* pk = park + (size_t)bx * (NW * 4096);
#pragma unroll 1
  for (int u = 0; u < 8; ++u) {
    const int i = u >> 1, m = u & 1, g = i >> 1, qb = (i & 1) ? (32 * g + 31 - wi) : (32 * g + wi);
    const size_t row0 = (size_t)b * SEQ + (size_t)qb * 256;
    int t2 = tid; asm volatile("" : "+v"(t2));
    attn_unit(m, Q + row0 * LDQ + m * 512 + h * ADH, K1 + m * 512, Vh, OB + row0 * LDQ + h * ADV, pk, lam, g_sub, 1.f - lambda_init, qb, lds, t2);
  }
}
#undef KSWZ64
#undef SBAR
#undef QK_TILE
#undef PV_LGK
#undef PV_PRE
#undef PV_WITH_SM
#undef PV_ONLY
}

namespace gla {
using s16x4  = __attribute__((ext_vector_type(4))) short;
using f32x16 = __attribute__((ext_vector_type(16))) float;
using u32x4  = __attribute__((ext_vector_type(4))) unsigned;
typedef __bf16 bf2_t __attribute__((ext_vector_type(2)));
typedef float f2_t __attribute__((ext_vector_type(2)));
constexpr int GRP = 8, NGRP = NCH / GRP, NUNIT = NB * GH * NGRP;
constexpr int KP = 320, VP = 576, QP = 272;
constexpr int OFF_KD = 0, OFF_V = OFF_KD + 64 * KP, OFF_Q = OFF_V + 64 * VP, OFF_DEC = OFF_Q + 64 * QP, OFF_SS = OFF_DEC + 512, OFF_RS = OFF_SS + 8 * 64 * 4, LDS_GLA = OFF_RS + 256;
constexpr size_t LS_UNIT = (size_t)GDK * GDV;
__device__ __forceinline__ int crow(int r, int hi) { return (r & 3) + 8 * (r >> 2) + 4 * hi; }
__device__ __forceinline__ unsigned cvtpk2(float lo, float hi) { const f2_t v = {lo, hi}; return __builtin_bit_cast(unsigned, __builtin_convertvector(v, bf2_t)); }
template <int OFF> __device__ __forceinline__ s16x4 tr_read(int a) { s16x4 r; asm volatile("ds_read_b64_tr_b16 %0, %1 offset:%2" : "=&v"(r) : "v"(a), "i"(OFF) : "memory"); return r; }
#define GLA_PK(L, H) (bf16x8){L[0], L[1], L[2], L[3], H[0], H[1], H[2], H[3]}

template <bool WITH_O>
__device__ __forceinline__ void scan_unit(bf16_t* __restrict__ qkvr, const float* __restrict__ dec, float* __restrict__ LS, float* __restrict__ GD, const float* __restrict__ g_norm, bf16_t* __restrict__ yout, int ystride, int u, char* lds, int tid) {
  const int wid = __builtin_amdgcn_readfirstlane(tid >> 6), lane = tid & 63, r32 = lane & 31, hi = lane >> 5;
  const int g = u & (NGRP - 1), h = (u >> 5) & 3, b = u >> 7;
  const size_t tokg = (size_t)b * SEQ + (size_t)g * GRP * CHUNK;
  const int ldsb = (int)(uintptr_t)lds;
  const int i16 = lane & 15, tq = i16 >> 2, tp = i16 & 3, blk = (lane >> 4) & 1;
  const int kbase = ldsb + OFF_KD + (8 * hi + tq) * KP + (16 * blk + 4 * tp) * 2;
  const int vbase = ldsb + OFF_V + (8 * hi + tq) * VP + (32 * wid + 16 * blk + 4 * tp) * 2;
  f32x16 st[4];
  float* Lu = LS + (size_t)u * LS_UNIT;
  if (WITH_O) {
#pragma unroll
    for (int kt = 0; kt < 4; ++kt)
#pragma unroll
      for (int r = 0; r < 16; ++r) st[kt][r] = Lu[(size_t)(32 * kt + crow(r, hi)) * GDV + 32 * wid + r32];
  } else {
#pragma unroll
    for (int kt = 0; kt < 4; ++kt)
#pragma unroll
      for (int r = 0; r < 16; ++r) st[kt][r] = 0.f;
  }
  float gdec = 1.f;
  uint4 kd0, kd1, v0, v1, v2, v3, q0, q1; f32x4 dc_r;
  const int pr = tid >> 4, pc = (tid & 15) * 8;
  const int vr = tid >> 5, vc = (tid & 31) * 8;
#define GLA_LOAD(c) do { const bf16_t* gp = qkvr + (tokg + (size_t)(c) * CHUNK) * GQKVR; \
    kd0 = *(const uint4*)(gp + (size_t)pr * GQKVR + GHK + h * GDK + pc); kd1 = *(const uint4*)(gp + (size_t)(pr + 32) * GQKVR + GHK + h * GDK + pc); \
    if (WITH_O) { q0 = *(const uint4*)(gp + (size_t)pr * GQKVR + h * GDK + pc); q1 = *(const uint4*)(gp + (size_t)(pr + 32) * GQKVR + h * GDK + pc); } \
    v0 = *(const uint4*)(gp + (size_t)vr * GQKVR + 1024 + h * GDV + vc); v1 = *(const uint4*)(gp + (size_t)(vr + 16) * GQKVR + 1024 + h * GDV + vc); \
    v2 = *(const uint4*)(gp + (size_t)(vr + 32) * GQKVR + 1024 + h * GDV + vc); v3 = *(const uint4*)(gp + (size_t)(vr + 48) * GQKVR + 1024 + h * GDV + vc); \
    if (tid < 32) dc_r = *(const f32x4*)(dec + ((size_t)b * NCH + (size_t)g * GRP + (c)) * GHK + h * GDK + tid * 4); } while (0)
#define GLA_STORE() do { \
    *(uint4*)(lds + OFF_KD + pr * KP + pc * 2) = kd0; *(uint4*)(lds + OFF_KD + (pr + 32) * KP + pc * 2) = kd1; \
    if (WITH_O) { *(uint4*)(lds + OFF_Q + pr * QP + pc * 2) = q0; *(uint4*)(lds + OFF_Q + (pr + 32) * QP + pc * 2) = q1; } \
    *(uint4*)(lds + OFF_V + vr * VP + vc * 2) = v0; *(uint4*)(lds + OFF_V + (vr + 16) * VP + vc * 2) = v1; \
    *(uint4*)(lds + OFF_V + (vr + 32) * VP + vc * 2) = v2; *(uint4*)(lds + OFF_V + (vr + 48) * VP + vc * 2) = v3; \
    if (tid < 32) *(f32x4*)(lds + OFF_DEC + tid * 16) = dc_r; } while (0)
  GLA_LOAD(0);
#pragma unroll 1
  for (int c = 0; c < GRP; ++c) {
    const size_t t0 = tokg + (size_t)c * CHUNK;
    GLA_STORE();
    __syncthreads();
    if (!WITH_O && tid < 128) gdec *= ((const float*)(lds + OFF_DEC))[tid];
    if (c + 1 < GRP) GLA_LOAD(c + 1);
#pragma unroll
    for (int kt = 0; kt < 4; ++kt)
#pragma unroll
      for (int g4 = 0; g4 < 4; ++g4) { const f32x4 d = *(const f32x4*)(lds + OFF_DEC + (32 * kt + 8 * g4 + 4 * hi) * 4);
#pragma unroll
        for (int i = 0; i < 4; ++i) st[kt][4 * g4 + i] *= d[i]; }
#define GLA_STEP(S) do { const s16x4 bl = tr_read<(16 * (S)) * VP>(vbase), bh_ = tr_read<(16 * (S) + 4) * VP>(vbase); \
      const s16x4 a0l = tr_read<(16 * (S)) * KP + 0>(kbase), a0h = tr_read<(16 * (S) + 4) * KP + 0>(kbase), a1l = tr_read<(16 * (S)) * KP + 64>(kbase), a1h = tr_read<(16 * (S) + 4) * KP + 64>(kbase); \
      const s16x4 a2l = tr_read<(16 * (S)) * KP + 128>(kbase), a2h = tr_read<(16 * (S) + 4) * KP + 128>(kbase), a3l = tr_read<(16 * (S)) * KP + 192>(kbase), a3h = tr_read<(16 * (S) + 4) * KP + 192>(kbase); \
      asm volatile("s_waitcnt lgkmcnt(0)" ::: "memory"); __builtin_amdgcn_sched_barrier(0); \
      const bf16x8 bv = GLA_PK(bl, bh_); \
      st[0] = __builtin_amdgcn_mfma_f32_32x32x16_bf16(GLA_PK(a0l, a0h), bv, st[0], 0, 0, 0); st[1] = __builtin_amdgcn_mfma_f32_32x32x16_bf16(GLA_PK(a1l, a1h), bv, st[1], 0, 0, 0); \
      st[2] = __builtin_amdgcn_mfma_f32_32x32x16_bf16(GLA_PK(a2l, a2h), bv, st[2], 0, 0, 0); st[3] = __builtin_amdgcn_mfma_f32_32x32x16_bf16(GLA_PK(a3l, a3h), bv, st[3], 0, 0, 0); } while (0)
    GLA_STEP(0); GLA_STEP(1); GLA_STEP(2); GLA_STEP(3);
#undef GLA_STEP
    if (WITH_O) {
      f32x16 oa[2];
#pragma unroll
      for (int rt = 0; rt < 2; ++rt)
#pragma unroll
        for (int r = 0; r < 16; ++r) oa[rt][r] = 0.f;
#pragma unroll
      for (int kt = 0; kt < 4; ++kt)
#pragma unroll
        for (int s = 0; s < 2; ++s) {
          u32x4 pw; pw.x = cvtpk2(st[kt][8 * s + 0], st[kt][8 * s + 1]); pw.y = cvtpk2(st[kt][8 * s + 2], st[kt][8 * s + 3]); pw.z = cvtpk2(st[kt][8 * s + 4], st[kt][8 * s + 5]); pw.w = cvtpk2(st[kt][8 * s + 6], st[kt][8 * s + 7]);
          const bf16x8 bs = __builtin_bit_cast(bf16x8, pw);
#pragma unroll
          for (int rt = 0; rt < 2; ++rt) {
            const char* qp = lds + OFF_Q + (32 * rt + r32) * QP + (32 * kt + 16 * s + 4 * hi) * 2;
            const s16x4 ql = *(const s16x4*)qp, qh = *(const s16x4*)(qp + 16);
            oa[rt] = __builtin_amdgcn_mfma_f32_32x32x16_bf16(GLA_PK(ql, qh), bs, oa[rt], 0, 0, 0);
          }
        }
      float* SS = (float*)(lds + OFF_SS); float* RS = (float*)(lds + OFF_RS);
      { float x[32];
#pragma unroll
        for (int rt = 0; rt < 2; ++rt)
#pragma unroll
          for (int r = 0; r < 16; ++r) x[rt * 16 + r] = oa[rt][r] * oa[rt][r];
        halve_step<32, 16>(x, lane); halve_step<16, 8>(x, lane); halve_step<8, 4>(x, lane); halve_step<4, 2>(x, lane); halve_step<2, 1>(x, lane);
        SS[wid * 64 + 32 * (r32 >> 4) + crow(r32 & 15, hi)] = x[0]; }
      __syncthreads();
      if (tid < 64) { float s = 0.f;
#pragma unroll
        for (int w = 0; w < 8; ++w) s += SS[w * 64 + tid];
        RS[tid] = rsqrtf(s * (1.f / GDV) + LN_EPS); }
      __syncthreads();
      constexpr int YP = 528;
#pragma unroll
      for (int rt = 0; rt < 2; ++rt)
#pragma unroll
        for (int g4 = 0; g4 < 4; ++g4) { const f32x4 rs = *(const f32x4*)(RS + 32 * rt + 8 * g4 + 4 * hi);
#pragma unroll
          for (int i = 0; i < 4; ++i) *(bf16_t*)(lds + OFF_V + (32 * rt + 8 * g4 + 4 * hi + i) * YP + (32 * wid + r32) * 2) = f2bf(oa[rt][4 * g4 + i] * rs[i]); }
      __syncthreads();
#pragma unroll
      for (int i = 0; i < 4; ++i) { const int p = tid + 512 * i, tt = p >> 5, c8 = (p & 31) * 8;
        const uint4 yv = *(const uint4*)(lds + OFF_V + tt * YP + c8 * 2);
        const size_t tok = t0 + tt;
        const uint4 rv = *(const uint4*)(qkvr + tok * GQKVR + 2048 + h * GDV + c8);
        const f32x4 ga = *(const f32x4*)(g_norm + h * GDV + c8), gb = *(const f32x4*)(g_norm + h * GDV + c8 + 4);
        const unsigned yw[4] = {yv.x, yv.y, yv.z, yv.w}, rw[4] = {rv.x, rv.y, rv.z, rv.w}; unsigned ow[4];
#pragma unroll
        for (int k = 0; k < 4; ++k) { const float y0 = __uint_as_float(yw[k] << 16), y1 = __uint_as_float(yw[k] & 0xffff0000u), r0 = __uint_as_float(rw[k] << 16), r1 = __uint_as_float(rw[k] & 0xffff0000u);
          const float g0 = k < 2 ? ga[2 * k] : gb[2 * k - 4], g1 = k < 2 ? ga[2 * k + 1] : gb[2 * k - 3];
          ow[k] = cvtpk2(y0 * g0 * silu_f(r0), y1 * g1 * silu_f(r1)); }
        uint4 o4; o4.x = ow[0]; o4.y = ow[1]; o4.z = ow[2]; o4.w = ow[3];
        *(uint4*)(yout + tok * (size_t)ystride + h * GDV + c8) = o4; }
    }
    __syncthreads();
  }
  if (!WITH_O) {
#pragma unroll
    for (int kt = 0; kt < 4; ++kt)
#pragma unroll
      for (int r = 0; r < 16; ++r) Lu[(size_t)(32 * kt + crow(r, hi)) * GDV + 32 * wid + r32] = st[kt][r];
    if (tid < 128) GD[(size_t)u * GDK + tid] = gdec;
  }
#undef GLA_LOAD
#undef GLA_STORE
}
__device__ __forceinline__ void scan_groups(float* __restrict__ LS, const float* __restrict__ GD, int gtid, int nthreads) {
  for (int i = gtid; i < NB * GH * (GDK * GDV / 2); i += nthreads) {
    const int bh = i >> 14, e2 = i & 16383, k = e2 >> 7, v2 = e2 & 127;
    float* p = LS + (size_t)bh * NGRP * LS_UNIT + (size_t)k * GDV + 2 * v2;
    const float* gd = GD + (size_t)bh * NGRP * GDK + k;
    f2_t s = {0.f, 0.f};
#pragma unroll 8
    for (int g = 0; g < NGRP; ++g) { const f2_t l = *(const f2_t*)(p + (size_t)g * LS_UNIT); const float d = gd[(size_t)g * GDK];
      *(f2_t*)(p + (size_t)g * LS_UNIT) = s; s = s * d + l; }
  }
}
#undef GLA_PK
}

#define LAS __attribute__((address_space(3)))
constexpr int NWAVES = 8, NTHREADS = NWAVES * 64;
constexpr int LDS_XB = 151552;
constexpr int LDS_BYTES = LDS_XB + 256;
constexpr int CW_BAR = 4096;
constexpr int N_PHASES = 48;

#define XB_TMO      128
#define XB_XCNT(j)  (256  + 64 * (j))
#define XB_XSUB(j)  (1280 + 64 * (j))
#define XB_XGEN(j)  (2304 + 64 * (j))
#define XB_TOP      3328
#define XB_TOPGEN   3392
#define XCD_BAR_WORDS 3456
#define XB_SPIN_CAP (1u << 18)
__device__ __forceinline__ unsigned xb_ld(unsigned* p)              { return __hip_atomic_load(p, __ATOMIC_RELAXED, __HIP_MEMORY_SCOPE_AGENT); }
__device__ __forceinline__ unsigned xb_add(unsigned* p, unsigned v) { return __hip_atomic_fetch_add(p, v, __ATOMIC_RELAXED, __HIP_MEMORY_SCOPE_AGENT); }
__device__ __forceinline__ unsigned xb_xcc_id() { return (unsigned)__builtin_amdgcn_s_getreg((3 << 11) | 20) & 0xFu; }
#define XB_SPIN(cond, bar) do { unsigned _sp = 0; while (cond) { __builtin_amdgcn_s_sleep(1); \
    if ((++_sp & 255u) == 0u) { if (xb_ld(&(bar)[XB_TMO])) break; if (_sp > XB_SPIN_CAP) { atomicAdd(&(bar)[XB_TMO], 1u); break; } } } } while (0)
struct XcdBarrier { unsigned* bar; unsigned x; volatile LAS unsigned* st; };
__device__ __forceinline__ XcdBarrier xcd_barrier_post(unsigned* bar, volatile LAS unsigned* st) {
    XcdBarrier b; b.bar = bar; b.x = xb_xcc_id(); b.st = st;
    if (threadIdx.x == 0) (void)xb_add(&bar[XB_XCNT(b.x)], 1u);
    return b;
}
__device__ __forceinline__ void xcd_barrier_complete(unsigned* bar, unsigned x, unsigned& nloc, unsigned& nx) {
    const unsigned G = gridDim.x * gridDim.y * gridDim.z;
    unsigned sum, cnt, mine, sp = 0u;
    for (;;) {
        sum = 0u; cnt = 0u; mine = 0u;
#pragma unroll
        for (unsigned j = 0; j < 16; ++j) { const unsigned c = xb_ld(&bar[XB_XCNT(j)]); sum += c; cnt += (c > 0u) ? 1u : 0u; mine = (j == x) ? c : mine; }
        if (sum == G) break;
        __builtin_amdgcn_s_sleep(1);
        if ((++sp & 255u) == 0u) { if (xb_ld(&bar[XB_TMO])) break; if (sp > XB_SPIN_CAP) { atomicAdd(&bar[XB_TMO], 1u); break; } }
    }
    nloc = mine > 0u ? mine : 1u; nx = cnt > 0u ? cnt : 1u;
}
__device__ __forceinline__ void xcd_barrier(const XcdBarrier& b, int tid) {
    asm volatile("s_waitcnt vmcnt(0)" ::: "memory");
    __syncthreads();
    if (tid == 0) {
        unsigned* bar = b.bar;
        __builtin_amdgcn_s_waitcnt(0);
        unsigned nloc = b.st[0], nx = b.st[1];
        if (nloc == 0u) { xcd_barrier_complete(bar, b.x, nloc, nx); b.st[0] = nloc; b.st[1] = nx; }
        const unsigned old = xb_add(&bar[XB_XSUB(b.x)], 1u);
        const unsigned gen = old / nloc;
        if (old + 1u == (gen + 1u) * nloc) {
            __builtin_amdgcn_fence(__ATOMIC_RELEASE, "agent");
            asm volatile("s_waitcnt vmcnt(0)" ::: "memory");
            const unsigned og = xb_add(&bar[XB_TOP], 1u);
            const unsigned tg = og / nx;
            if (og + 1u == (tg + 1u) * nx) xb_add(&bar[XB_TOPGEN], 1u);
            else XB_SPIN(xb_ld(&bar[XB_TOPGEN]) == tg, bar);
            __builtin_amdgcn_fence(__ATOMIC_ACQUIRE, "agent");
            xb_add(&bar[XB_XGEN(b.x)], 1u);
            asm volatile("s_waitcnt vmcnt(0)" ::: "memory");
        } else {
            XB_SPIN(xb_ld(&bar[XB_XGEN(b.x)]) == gen, bar);
            __builtin_amdgcn_fence(__ATOMIC_ACQUIRE, "agent");
            asm volatile("s_waitcnt vmcnt(0)" ::: "memory");
        }
    }
    __syncthreads();
}

struct MArgs { const float* in[24]; float* out; unsigned char* ws; int ph_lo, ph_hi, li, pad; };

__device__ __forceinline__ unsigned pk2(float lo, float hi) { return (unsigned)f2bf(lo) | ((unsigned)f2bf(hi) << 16); }
__device__ __forceinline__ void tr_item(const float* W, int ld, int K, int N, bf16_t* WT, int rs, int roff, float scale, int nscale, float* scr, int item, int lane) {
    const int nblk = N / 32, kb = item / nblk, nb = item % nblk, k0 = 64 * kb, n0 = 32 * nb;
    const float sc = (n0 + (lane & 31)) < nscale ? scale : 1.f;
#pragma unroll 8
    for (int i = 0; i < 32; ++i) { const int kk = 2 * i + (lane >> 5); scr[kk * 33 + (lane & 31)] = __builtin_nontemporal_load(W + (size_t)(k0 + kk) * ld + n0 + (lane & 31)) * sc; }
    asm volatile("s_waitcnt lgkmcnt(0)" ::: "memory");
    const int c = lane & 7;
#pragma unroll
    for (int j = 0; j < 4; ++j) { const int n = (lane >> 3) + 8 * j; const float* s = scr + (8 * c) * 33 + n;
        uint4 o; o.x = pk2(s[0 * 33], s[1 * 33]); o.y = pk2(s[2 * 33], s[3 * 33]); o.z = pk2(s[4 * 33], s[5 * 33]); o.w = pk2(s[6 * 33], s[7 * 33]);
        const int ng = n0 + n, drow = (ng >> 4) * rs + (ng & 15) + roff;
        *(uint4*)(WT + (size_t)drow * K + k0 + 8 * c) = o; }
    asm volatile("s_waitcnt lgkmcnt(0)" ::: "memory");
}
__device__ __forceinline__ const void* ldptr(volatile LAS unsigned long long* tab, int i) { const unsigned long long v = tab[i];
    const unsigned lo = __builtin_amdgcn_readfirstlane((unsigned)v), hi = __builtin_amdgcn_readfirstlane((unsigned)(v >> 32)); return (const void*)(const __attribute__((address_space(1))) char*)(((unsigned long long)hi << 32) | lo); }
#define INP(i) ((const float*)ldptr(ptab, (i)))
__device__ __forceinline__ void ph_convert(volatile LAS unsigned long long* ptab, unsigned char* ws, unsigned char* lds, int gw, int NGW, int wave, int lane) {
    float* scr = (float*)(lds + wave * 16384);
    constexpr int I0 = 2 * 16 * 96, I1 = 2 * 16 * 32, I2 = 16 * 64, I3 = 2 * 16 * 32, I4 = 2 * 16 * 32, I5 = 64 * 16 * 16, I6 = I5, I7 = 64 * 8 * 32;
    constexpr int NIT = I0 + I1 + I2 + I3 + I4 + I5 + I6 + I7;
    for (int it = gw; it < NIT; it += NGW) {
        int r = it; const float* src; bf16_t* dst; int ld, K = D, N, rs = 16, roff = 0, nscale = 0, item; float scale = 1.f;
        if (r < I0) { const int z = r / (16 * 96); item = r % (16 * 96); src = INP(1) + (size_t)z * D * GIN; ld = GIN; N = GQKVR; dst = (bf16_t*)(ws + WS_WIN) + (size_t)z * GQKVR * D; scale = 0.08838834764831845f; nscale = 512; }
        else if ((r -= I0) < I1) { const int z = r / 512; item = r % 512; src = INP(5) + (size_t)z * D * D; ld = D; N = D; dst = (bf16_t*)(ws + WS_WOA) + (size_t)z * D * D; }
        else if ((r -= I1) < I2) { item = r; src = INP(6); ld = 2048; N = 2048; dst = (bf16_t*)(ws + WS_WKV); }
        else if ((r -= I2) < I3) { const int z = r / 512; item = r % 512; src = INP(7) + (size_t)z * D * D; ld = D; N = D; dst = (bf16_t*)(ws + WS_WQ) + (size_t)z * D * D; scale = 0.125f * 1.4426950408889634f; nscale = 1024; }
        else if ((r -= I3) < I4) { const int z = r / 512; item = r % 512; src = INP(13) + (size_t)z * D * D; ld = D; N = D; dst = (bf16_t*)(ws + WS_WOB) + (size_t)z * D * D; }
        else if ((r -= I4) < I5) { const int z = r / 256; item = r % 256; src = INP(19) + (size_t)z * D * FF; ld = FF; N = FF; dst = (bf16_t*)(ws + WS_WGU) + (size_t)z * 1024 * D; rs = 32; }
        else if ((r -= I5) < I6) { const int z = r / 256; item = r % 256; src = INP(20) + (size_t)z * D * FF; ld = FF; N = FF; dst = (bf16_t*)(ws + WS_WGU) + (size_t)z * 1024 * D; rs = 32; roff = 16; }
        else { r -= I6; const int z = r / 256; item = r % 256; src = INP(21) + (size_t)z * FF * D; ld = D; K = FF; N = D; dst = (bf16_t*)(ws + WS_WD) + (size_t)z * D * FF; }
        tr_item(src, ld, K, N, dst, rs, roff, scale, nscale, scr, item, lane);
    }
}

__device__ __forceinline__ void kdec_ref_phase(bf16_t* qkvr, const float* lr, const float* w_gate2, const float* b_gate, float* dec, unsigned char* lds, int tid) {
    float (*slr)[16] = (float (*)[16])lds;
    const int ch = tid;
    for (int bc = blockIdx.x; bc < NB * NCH; bc += gridDim.x) {
        const size_t tok0 = (size_t)bc * CHUNK;
        __syncthreads();
        for (int i = tid; i < 64 * 16; i += NTHREADS) slr[i >> 4][i & 15] = lr[tok0 * 16 + i];
        float wg[16];
#pragma unroll
        for (int j = 0; j < 16; ++j) wg[j] = w_gate2[j * GHK + ch];
        const float bg = b_gate[ch];
        __syncthreads();
        float cum[64]; float run = 0.f;
#pragma unroll
        for (int t = 0; t < 64; ++t) {
            float z = bg;
#pragma unroll
            for (int j = 0; j < 16; ++j) z += slr[t][j] * wg[j];
            const float ls = fminf(z, 0.f) - __logf(1.f + __expf(-fabsf(z)));
            run += ls * (1.f / 16.f); cum[t] = run;
        }
#pragma unroll
        for (int t = 0; t < 64; ++t) { bf16_t* kp = qkvr + (tok0 + t) * GQKVR + GHK + ch; *kp = f2bf(bf2f(*kp) * __expf(run - cum[t])); }
        dec[(size_t)bc * GHK + ch] = __expf(run);
    }
    __syncthreads();
}
constexpr size_t WS_O1 = WS_R1 + (size_t)T * D * 2, WS_O2 = WS_R1 + (size_t)2 * T * D * 2;
#define PTRS unsigned char* const ws = (unsigned char*)ldptr(ptab, 25); float* const outp = (float*)ldptr(ptab, 24); int* const CTL = (int*)(ws + WS_CTL); \
    bf16_t *WIN = (bf16_t*)(ws + WS_WIN), *WOA = (bf16_t*)(ws + WS_WOA), *WKV = (bf16_t*)(ws + WS_WKV), *WQ = (bf16_t*)(ws + WS_WQ), *WOB = (bf16_t*)(ws + WS_WOB), *WGU = (bf16_t*)(ws + WS_WGU), *WD = (bf16_t*)(ws + WS_WD); \
    bf16_t *HB = (bf16_t*)(ws + WS_HB), *R1 = (bf16_t*)(ws + WS_R1), *MIX = (bf16_t*)(ws + WS_MIX), *HBUF = (bf16_t*)(ws + WS_HBUF), *YSLOT = (bf16_t*)(ws + WS_YSLOT), *QB = (bf16_t*)(ws + WS_QB); \
    bf16_t *O1 = (bf16_t*)(ws + WS_O1), *O2 = (bf16_t*)(ws + WS_O2); float *LR = (float*)(ws + WS_LR), *DEC = (float*)(ws + WS_DEC), *TOKW = (float*)(ws + WS_TOKW); \
    int *LIST = (int*)(ws + WS_LIST), *TOKE = (int*)(ws + WS_TOKE), *TOKP = (int*)(ws + WS_TOKP); bf16_t* KV = (bf16_t*)outp; float* OBUF = outp; int* cnt = CTL + CW_CNT + 64 * l; \
    (void)WIN; (void)WOA; (void)WKV; (void)WQ; (void)WOB; (void)WGU; (void)WD; (void)HB; (void)R1; (void)MIX; (void)HBUF; (void)YSLOT; (void)QB; (void)O1; (void)O2; (void)LR; (void)DEC; (void)TOKW; (void)LIST; (void)TOKE; (void)TOKP; (void)KV; (void)OBUF; (void)cnt;
#define PHASE(id, ...) do { if ((id) >= lo && (id) < hi) { int lane; asm volatile("v_mbcnt_lo_u32_b32 %0, -1, 0\n\tv_mbcnt_hi_u32_b32 %0, -1, %0" : "=v"(lane)); const int wave = wave0, tid = wave0 * 64 + lane, gw = blockIdx.x * NWAVES + wave; (void)lane; (void)gw; PTRS \
        __VA_ARGS__; if ((id) + 1 < hi) { XcdBarrier bl = bar; asm volatile("" : "+s"(bl.bar), "+s"(bl.x)); xcd_barrier(bl, tid); } } } while (0)

template <int l> __device__ __forceinline__ void layer_phases(volatile LAS unsigned long long* const ptab, unsigned char* const lds, LAS unsigned char* const ldsl, const XcdBarrier& bar,
                                                            const int lo, const int hi, const int wave0, const int G, const int NGW) {
        const int pb = 1 + 12 * l;
        if (l < 2) {
            PHASE(pb + 0, { const pg8::Gemm g{HB, WIN + (size_t)l * GQKVR * D, D, D, D, 0}; pg8::DenseOrder S; S.init(T, GQKVR, G, (int)blockIdx.x); const pg8::EpiBf16 E{R1, GQKVR}; pg8::gemm_phase(ldsl, g, S, E, tid); });
            PHASE(pb + 1, kdec_ref_phase(R1, LR, INP(2) + (size_t)l * 16 * GHK, INP(3) + (size_t)l * GHK, DEC, lds, tid));
            PHASE(pb + 2, gla::scan_unit<false>(R1, DEC, (float*)MIX, (float*)MIX + (size_t)gla::NUNIT * gla::LS_UNIT, nullptr, nullptr, 0, (int)blockIdx.x, (char*)lds, tid));
            PHASE(pb + 3, gla::scan_groups((float*)MIX, (const float*)MIX + (size_t)gla::NUNIT * gla::LS_UNIT, (int)blockIdx.x * NTHREADS + tid, G * NTHREADS));
            PHASE(pb + 4, gla::scan_unit<true>(R1, DEC, (float*)MIX, nullptr, INP(4) + (size_t)l * GHV, R1 + 1024, GQKVR, (int)blockIdx.x, (char*)lds, tid));
            PHASE(pb + 5, { const pg8::Gemm g{R1 + 1024, WOA + (size_t)l * D * D, GQKVR, D, D, 0}; pg8::DenseOrder S; S.init(T, D, G, (int)blockIdx.x); const pg8::EpiBf16 E{MIX, D}; pg8::gemm_phase(ldsl, g, S, E, tid); });
        } else {
            const int j = l - 2; const float lambda_init = l == 2 ? 0.47071302f : 0.55605820f;
            PHASE(pb + 0, { { const pg8::Gemm g{HB, WQ + (size_t)j * D * D, D, D, D, 0}; pg8::DenseOrder S; S.init(T, D, G, (int)blockIdx.x); const pg8::EpiBf16 E{QB, D}; pg8::gemm_phase(ldsl, g, S, E, tid); }
                            if (l == 2) { const pg8::Gemm g{HB, WKV, D, D, D, 0}; pg8::DenseOrder S; S.init(T, 2048, G, (int)blockIdx.x); const pg8::EpiBf16 E{KV, 2048}; pg8::gemm_phase(ldsl, g, S, E, tid); } });
            PHASE(pb + 1, att::attn_phase(QB, KV, (float*)O1, O2, INP(14), INP(8) + j * 64, INP(9) + j * 64, INP(10) + j * 64, INP(11) + j * 64, INP(12) + j * ADV, lambda_init, (char*)lds, tid));
            PHASE(pb + 5, { const pg8::Gemm g{O2, WOB + (size_t)j * D * D, D, D, D, 0}; pg8::DenseOrder S; S.init(T, D, G, (int)blockIdx.x); const pg8::EpiBf16 E{MIX, D}; pg8::gemm_phase(ldsl, g, S, E, tid); });
        }
        PHASE(pb + 6, { RowArgs r{}; r.mode = 1; r.hb = HB; r.mix = MIX; r.ln_g = INP(22) + (size_t)(l * 2) * D; r.ln_b = INP(23) + (size_t)(l * 2) * D;
                        r.w_group = INP(15) + (size_t)l * D * 4; r.b_group = INP(16) + l * 4; r.w_router = INP(17) + (size_t)l * D * 16; r.b_router = INP(18) + l * 16;
                        r.cnt = cnt; r.list = LIST; r.tok_e = TOKE; r.tok_pos = TOKP; r.tok_w = TOKW;
                        row_phase<NTHREADS, 20>(r, lds, G, blockIdx.x, tid); });
        PHASE(pb + 7, { const pg8::Gemm g{HB, WGU + (size_t)l * NE * 1024 * D, D, D, D, (size_t)1024 * D}; const pg8::MoeOrder<true> S{cnt, LIST, 4, G, (int)blockIdx.x}; const pg8::EpiSwiglu E{HBUF, FF}; pg8::gemm_phase(ldsl, g, S, E, tid); });
        PHASE(pb + 8, { const pg8::Gemm g{HBUF, WD + (size_t)l * NE * D * FF, FF, FF, FF, (size_t)D * FF}; const pg8::MoeOrder<false> S{cnt, LIST, 4, G, (int)blockIdx.x}; const pg8::EpiBf16 E{YSLOT, D}; pg8::gemm_phase(ldsl, g, S, E, tid); });
        PHASE(pb + 9, { RowArgs r{}; r.mode = 2; r.hb = HB; r.Y = YSLOT; r.ln_g = INP(22) + (size_t)(l * 2 + 1) * D; r.ln_b = INP(23) + (size_t)(l * 2 + 1) * D;
                        r.cnt = cnt; r.tok_e = TOKE; r.tok_pos = TOKP; r.tok_w = TOKW;
                        if (l == 0) { r.lr_w = INP(1) + (size_t)D * GIN + 3072; r.lr_out = LR; }
                        if (l == 3) r.out = outp;
                        row_phase<NTHREADS, (l == 0 ? 16 : 0)>(r, lds, G, blockIdx.x, tid); });
}

__global__ void __launch_bounds__(NTHREADS, 2) fwd(MArgs a) {
    extern __shared__ __attribute__((aligned(16))) unsigned char lds[];
    const int tid0 = threadIdx.x, wave0 = __builtin_amdgcn_readfirstlane(tid0 >> 6);
    const int G = gridDim.x, NGW = G * NWAVES;
    volatile LAS unsigned long long* const ptab = (volatile LAS unsigned long long*)(lds + LDS_XB + 16);
    if (tid0 < 4) ((volatile LAS unsigned*)(lds + LDS_XB))[tid0] = 0u;
    if (tid0 < 24) ptab[tid0] = (unsigned long long)a.in[tid0];
    if (tid0 == 24) ptab[24] = (unsigned long long)a.out;
    if (tid0 == 25) ptab[25] = (unsigned long long)a.ws;
    __syncthreads();
    XcdBarrier bar = xcd_barrier_post((unsigned*)(a.ws + WS_CTL) + CW_BAR + a.li * XCD_BAR_WORDS, (volatile LAS unsigned*)(lds + LDS_XB));
    const int lo = a.ph_lo, hi = a.ph_hi;
    PG8_LAS unsigned char* const ldsl = (PG8_LAS unsigned char*)lds;
    { const int l = 0;
    PHASE(0, { ph_convert(ptab, ws, lds, gw, NGW, wave, lane); __syncthreads();
               RowArgs r{}; r.mode = 0; r.x = INP(0); r.hb = HB; r.lr_w = INP(1) + 3072; r.lr_out = LR; row_phase<NTHREADS, 16>(r, lds, G, blockIdx.x, tid); }); }
    layer_phases<0>(ptab, lds, ldsl, bar, lo, hi, wave0, G, NGW);
    layer_phases<1>(ptab, lds, ldsl, bar, lo, hi, wave0, G, NGW);
    layer_phases<2>(ptab, lds, ldsl, bar, lo, hi, wave0, G, NGW);
    layer_phases<3>(ptab, lds, ldsl, bar, lo, hi, wave0, G, NGW);
}
#undef PHASE

#ifndef RUN_MODE
#define RUN_MODE 1
#endif
extern "C" void kernel_launch(void* const* d_in, const int* in_sizes, int n_in, void* d_out, int out_size, void* d_ws, size_t ws_size, hipStream_t stream) {
    static int grid = 0;
    if (grid == 0) {
        if (n_in != 24 || out_size != T * D || ws_size < WS_END) { fprintf(stderr, "kernel_launch: unexpected sizes n_in %d out %d ws %zu (need %zu)\n", n_in, out_size, ws_size, (size_t)WS_END); grid = -1; return; }
        int dev = 0, cus = 0, per_cu = 0;
        if (hipGetDevice(&dev) != hipSuccess || hipDeviceGetAttribute(&cus, hipDeviceAttributeMultiprocessorCount, dev) != hipSuccess) { grid = -1; return; }
        if (hipFuncSetAttribute((const void*)fwd, hipFuncAttributeMaxDynamicSharedMemorySize, LDS_BYTES) != hipSuccess) { fprintf(stderr, "hipFuncSetAttribute failed\n"); grid = -1; return; }
        if (hipOccupancyMaxActiveBlocksPerMultiprocessor(&per_cu, (const void*)fwd, NTHREADS, LDS_BYTES) != hipSuccess || per_cu < 1) { fprintf(stderr, "occupancy query: %d blocks per CU\n", per_cu); grid = -1; return; }
        (void)hipGetLastError();
        grid = cus;
        if (grid != 256 || T % (grid * NWAVES * 4) != 0) { fprintf(stderr, "unsupported CU count %d\n", cus); grid = -1; return; }
    }
    if (grid < 0) return;
    (void)hipMemsetAsync((unsigned char*)d_ws + WS_CTL, 0, CTL_BYTES, stream);
    MArgs a{};
    for (int i = 0; i < 24; ++i) a.in[i] = (const float*)d_in[i];
    a.out = (float*)d_out; a.ws = (unsigned char*)d_ws;
#if RUN_MODE == 1
    a.ph_lo = 0; a.ph_hi = N_PHASES - 1; a.li = 0;
    hipLaunchKernelGGL(fwd, dim3(grid), dim3(NTHREADS), LDS_BYTES, stream, a);
#else
    int li = 0;
    for (int p = 0; p < N_PHASES - 1; ++p) {
        const int k = (p - 1) % 12, l = (p - 1) / 12;
        if (p > 0) { if (k >= 10) continue; if (l >= 2 && (k == 2 || k == 3 || k == 4)) continue; }
        a.ph_lo = p; a.ph_hi = p + 1; a.li = li++;
        hipLaunchKernelGGL(fwd, dim3(grid), dim3(NTHREADS), LDS_BYTES, stream, a);
    }
#endif
}
```

```cpp
#include <hip/hip_runtime.h>
#include <cstdio>
#include <cstdint>
#include <cmath>

typedef unsigned short bf16_t;
typedef short bf16x8 __attribute__((ext_vector_type(8)));
typedef float f32x4 __attribute__((ext_vector_type(4)));
typedef float f32x2 __attribute__((ext_vector_type(2)));

constexpr int NB = 2, SEQ = 16384, T = NB * SEQ, D = 1024;
constexpr int CHUNK = 64, NCH = SEQ / CHUNK;
constexpr int GH = 4, GDK = 128, GDV = 256, GHK = 512, GHV = 1024, GIN = 3088, GQKVR = 3072;
constexpr int AH = 8, ADH = 64, ADV = 128;
constexpr int NE = 16, FF = 512;
constexpr int NSLOT = 2 * T + NE * 256;
constexpr float ALPHA = 1.6817928305074290f;
constexpr float LN_EPS = 1e-5f;

constexpr size_t al256(size_t x) { return (x + 255) & ~(size_t)255; }
constexpr size_t WS_CTL = 0;
constexpr size_t CTL_BYTES = 1u << 20;
constexpr size_t WS_WIN = WS_CTL + CTL_BYTES;
constexpr size_t WS_WOA = WS_WIN + (size_t)2 * GQKVR * D * 2;
constexpr size_t WS_WKV = WS_WOA + (size_t)2 * D * D * 2;
constexpr size_t WS_WQ = WS_WKV + (size_t)2048 * D * 2;
constexpr size_t WS_WOB = WS_WQ + (size_t)2 * D * D * 2;
constexpr size_t WS_WGU = WS_WOB + (size_t)2 * D * D * 2;
constexpr size_t WS_WD = WS_WGU + (size_t)4 * NE * 1024 * D * 2;
constexpr size_t WS_HB = WS_WD + (size_t)4 * NE * D * FF * 2;
constexpr size_t WS_R1 = WS_HB + (size_t)T * D * 2;
constexpr size_t WS_MIX = WS_R1 + (size_t)T * GQKVR * 2;
constexpr size_t WS_LR = WS_MIX + (size_t)T * D * 2;
constexpr size_t WS_DEC = WS_LR + (size_t)T * 16 * 4;
constexpr size_t WS_LIST = WS_DEC + (size_t)NB * NCH * GHK * 4;
constexpr size_t WS_TOKE = WS_LIST + (size_t)NE * T * 4;
constexpr size_t WS_TOKP = WS_TOKE + (size_t)T * 2 * 4;
constexpr size_t WS_TOKW = WS_TOKP + (size_t)T * 2 * 4;
constexpr size_t WS_END = WS_TOKW + (size_t)T * 2 * 4;
static_assert(WS_TOKP == WS_TOKE + (size_t)T * 2 * 4 && WS_TOKW == WS_TOKP + (size_t)T * 2 * 4, "the row phase reads tok_e | tok_pos | tok_w as one array");
constexpr size_t WS_HBUF = WS_R1;
constexpr size_t WS_YSLOT = WS_R1 + al256((size_t)NSLOT * FF * 2);
static_assert(WS_YSLOT + (size_t)NSLOT * D * 2 <= WS_LR, "MoE overlay fits R1|MIX");
constexpr size_t WS_QB = WS_R1;
constexpr size_t WS_OB = WS_R1 + (size_t)T * D * 2;
constexpr int CW_CNT = 64;

__device__ __forceinline__ float bf2f(bf16_t v) { return __uint_as_float(((unsigned)v) << 16); }
__device__ __forceinline__ bf16_t f2bf(float f) { return __builtin_bit_cast(bf16_t, (__bf16)f); }
__device__ __forceinline__ float wave_sum(float v) {
#pragma unroll
    for (int o = 1; o < 64; o <<= 1) v += __shfl_xor(v, o);
    return v;
}
__device__ __forceinline__ float silu_f(float x) { return x * __builtin_amdgcn_rcpf(1.f + __expf(-x)); }

struct RowArgs {
    int mode;
    int pad0;
    const float* x; bf16_t* hb; bf16_t* hb_out; const bf16_t* mix; const bf16_t* Y;
    const float* ln_g; const float* ln_b;
    const float* w_group; const float* b_group; const float* w_router; const float* b_router;
    int* cnt; int* list; int* tok_e; int* tok_pos; float* tok_w;
    const float* lr_w; float* lr_out;
    float* out;
};

constexpr int ROW_LDS_W = 36 * 1024 * 4;
constexpr int ROW_LDS_BYTES = ROW_LDS_W + 4096;

template <int O> __device__ __forceinline__ float xor_get(float v, int lane) {
    if constexpr (O == 32) { const auto rr = __builtin_amdgcn_permlane32_swap(__float_as_uint(v), __float_as_uint(v), false, false); return __uint_as_float(lane < 32 ? rr[1] : rr[0]); }
    else return __int_as_float(__builtin_amdgcn_ds_swizzle(__float_as_int(v), (O << 10) | 0x1f));
}
template <int O> __device__ __forceinline__ float xor_add(float v) {
    if constexpr (O == 32) { const auto rr = __builtin_amdgcn_permlane32_swap(__float_as_uint(v), __float_as_uint(v), false, false); return __uint_as_float(rr[0]) + __uint_as_float(rr[1]); }
    else return v + __int_as_float(__builtin_amdgcn_ds_swizzle(__float_as_int(v), (O << 10) | 0x1f));
}
template <int N, int MASK> __device__ __forceinline__ void halve_step(float* a, int lane) {
    const bool up = (lane & MASK) != 0;
#pragma unroll
    for (int i = 0; i < N / 2; ++i) { const float send = up ? a[i] : a[N / 2 + i], keep = up ? a[N / 2 + i] : a[i]; a[i] = keep + xor_get<MASK>(send, lane); }
}
#define ROW_SUM4(x) do { _Pragma("unroll") for (int rr = 0; rr < 4; ++rr) x[rr] = xor_add<1>(x[rr]); _Pragma("unroll") for (int rr = 0; rr < 4; ++rr) x[rr] = xor_add<2>(x[rr]); \
    _Pragma("unroll") for (int rr = 0; rr < 4; ++rr) x[rr] = xor_add<4>(x[rr]); _Pragma("unroll") for (int rr = 0; rr < 4; ++rr) x[rr] = xor_add<8>(x[rr]); \
    _Pragma("unroll") for (int rr = 0; rr < 4; ++rr) x[rr] = xor_add<16>(x[rr]); _Pragma("unroll") for (int rr = 0; rr < 4; ++rr) x[rr] = xor_add<32>(x[rr]); } while (0)
typedef unsigned u32x2_nt __attribute__((ext_vector_type(2)));
__device__ __forceinline__ ushort4 ld_nt8(const bf16_t* p) { const u32x2_nt v = __builtin_nontemporal_load((const u32x2_nt*)p); ushort4 r; r.x = (unsigned short)v[0]; r.y = (unsigned short)(v[0] >> 16); r.z = (unsigned short)v[1]; r.w = (unsigned short)(v[1] >> 16); return r; }
__device__ __forceinline__ int wt_idx(int jj, int c) { return ((((jj >> 1) * 4 + (c >> 8)) * 2 + ((c >> 1) & 1)) * 256) + 4 * ((c >> 2) & 63) + (c & 1) * 2 + (jj & 1); }
template <int NTHR, int NDOT> __device__ __forceinline__ void row_phase(const RowArgs& a, unsigned char* lds_raw, int nblocks, int bid, int tid) {
    float* Wt = (float*)lds_raw;
    float* GB = Wt + 24 * 1024;
    int* lcnt = (int*)(lds_raw + ROW_LDS_W);
    int* lbase = lcnt + 16;
    int* offs = lbase + 16;
    int* ent = offs + 16;
    constexpr int nthr = NTHR, nw = NTHR / 64; const int lane = tid & 63, wave = tid >> 6;
    bf16_t* const hbo = a.hb_out ? a.hb_out : a.hb;
    const int rows_per_block = T / nblocks;
    if (a.mode == 1) {
        for (int i = tid; i < 1024 * 4; i += nthr) { const int c = i >> 2, j = i & 3; Wt[wt_idx(j, c)] = a.w_group[i]; }
        for (int i = tid; i < 1024 * 16; i += nthr) { const int c = i >> 4, j = i & 15; Wt[wt_idx(4 + j, c)] = a.w_router[i]; }
        if (tid < 16) lcnt[tid] = 0;
    } else if (a.lr_w) {
        for (int i = tid; i < 1024 * 16; i += nthr) { const int c = i >> 4, j = i & 15; Wt[wt_idx(j, c)] = a.lr_w[(size_t)c * GIN + j]; }
    }
    if (a.mode != 0) for (int i = tid; i < 2048; i += nthr) GB[i] = i < 1024 ? a.ln_g[i] : a.ln_b[i - 1024];
    int offv = 0;
    if (a.mode == 2) { const int myc = a.cnt[lane & (NE - 1)]; int o = 0;
#pragma unroll
        for (int e = 0; e < NE; ++e) { if (lane == e) offv = o; o += (__builtin_amdgcn_readlane(myc, e) + 255) & ~255; } }
    __syncthreads();
    const int iters = rows_per_block / (nw * 4);
    for (int it = 0; it < iters; ++it) {
        const int lr0 = (it * nw + wave) * 4;
        const size_t rowb = ((size_t)it * nblocks + bid) * (nw * 4) + wave * 4;
        float v[4][16];
        if (a.mode == 0) {
            f32x4 xr[4][4];
#pragma unroll
            for (int rr = 0; rr < 4; ++rr)
#pragma unroll
                for (int i = 0; i < 4; ++i) xr[rr][i] = __builtin_nontemporal_load((const f32x4*)(a.x + (rowb + rr) * D + 256 * i + 4 * lane));
#pragma unroll
            for (int rr = 0; rr < 4; ++rr)
#pragma unroll
                for (int i = 0; i < 4; ++i) { v[rr][4 * i] = xr[rr][i][0]; v[rr][4 * i + 1] = xr[rr][i][1]; v[rr][4 * i + 2] = xr[rr][i][2]; v[rr][4 * i + 3] = xr[rr][i][3]; }
        } else {
            ushort4 hr[4][4], ar[4][4], br[4][4]; float w0[4], w1[4];
            const bf16_t* pa[4]; const bf16_t* pb[4];
            if (a.mode == 1) {
#pragma unroll
                for (int rr = 0; rr < 4; ++rr) { pa[rr] = a.mix + (rowb + rr) * D; pb[rr] = pa[rr]; w0[rr] = 1.f; w1[rr] = 0.f; }
            } else {
                const int k_ = (lane >> 3) > 2 ? 2 : (lane >> 3); const int m = a.tok_e[(size_t)k_ * (2 * T) + rowb * 2 + (lane & 7)];
#pragma unroll
                for (int rr = 0; rr < 4; ++rr) { const int e0 = __builtin_amdgcn_readlane(m, 2 * rr), e1 = __builtin_amdgcn_readlane(m, 2 * rr + 1), p0 = __builtin_amdgcn_readlane(m, 8 + 2 * rr), p1 = __builtin_amdgcn_readlane(m, 9 + 2 * rr);
                    w0[rr] = __int_as_float(__builtin_amdgcn_readlane(m, 16 + 2 * rr)); w1[rr] = __int_as_float(__builtin_amdgcn_readlane(m, 17 + 2 * rr));
                    pa[rr] = a.Y + (size_t)(__builtin_amdgcn_readlane(offv, e0) + p0) * D; pb[rr] = a.Y + (size_t)(__builtin_amdgcn_readlane(offv, e1) + p1) * D; }
            }
#pragma unroll
            for (int rr = 0; rr < 4; ++rr)
#pragma unroll
                for (int i = 0; i < 4; ++i) { hr[rr][i] = *(const ushort4*)(a.hb + (rowb + rr) * D + 256 * i + 4 * lane); ar[rr][i] = ld_nt8(pa[rr] + 256 * i + 4 * lane);
                    if (a.mode == 2) br[rr][i] = ld_nt8(pb[rr] + 256 * i + 4 * lane); }
#pragma unroll
            for (int rr = 0; rr < 4; ++rr) { __builtin_amdgcn_sched_barrier(0);
#pragma unroll
                for (int i = 0; i < 4; ++i) {
                    v[rr][4 * i] = ALPHA * bf2f(hr[rr][i].x) + w0[rr] * bf2f(ar[rr][i].x); v[rr][4 * i + 1] = ALPHA * bf2f(hr[rr][i].y) + w0[rr] * bf2f(ar[rr][i].y);
                    v[rr][4 * i + 2] = ALPHA * bf2f(hr[rr][i].z) + w0[rr] * bf2f(ar[rr][i].z); v[rr][4 * i + 3] = ALPHA * bf2f(hr[rr][i].w) + w0[rr] * bf2f(ar[rr][i].w);
                    if (a.mode == 2) { v[rr][4 * i] += w1[rr] * bf2f(br[rr][i].x); v[rr][4 * i + 1] += w1[rr] * bf2f(br[rr][i].y); v[rr][4 * i + 2] += w1[rr] * bf2f(br[rr][i].z); v[rr][4 * i + 3] += w1[rr] * bf2f(br[rr][i].w); } } }
            __builtin_amdgcn_sched_barrier(0);
            float mu[4], rstd[4];
#pragma unroll
            for (int rr = 0; rr < 4; ++rr) { float s = 0.f;
#pragma unroll
                for (int i = 0; i < 16; ++i) s += v[rr][i];
                mu[rr] = s; }
            ROW_SUM4(mu);
#pragma unroll
            for (int rr = 0; rr < 4; ++rr) { mu[rr] *= (1.f / D); float q = 0.f;
#pragma unroll
                for (int i = 0; i < 16; ++i) { v[rr][i] -= mu[rr]; q += v[rr][i] * v[rr][i]; }
                rstd[rr] = q; }
            ROW_SUM4(rstd);
#pragma unroll
            for (int rr = 0; rr < 4; ++rr) rstd[rr] = rsqrtf(rstd[rr] * (1.f / D) + LN_EPS);
#pragma unroll
            for (int i = 0; i < 4; ++i) { int gl = 4 * lane; asm volatile("" : "+v"(gl));
                const f32x4 gg = *(const f32x4*)(GB + 256 * i + gl), bb = *(const f32x4*)(GB + 1024 + 256 * i + gl);
#pragma unroll
                for (int rr = 0; rr < 4; ++rr)
#pragma unroll
                    for (int qd = 0; qd < 4; ++qd) v[rr][4 * i + qd] = v[rr][4 * i + qd] * rstd[rr] * gg[qd] + bb[qd]; }
        }
#pragma unroll
        for (int rr = 0; rr < 4; ++rr)
#pragma unroll
            for (int i = 0; i < 4; ++i) { ushort4 t; t.x = f2bf(v[rr][4 * i]); t.y = f2bf(v[rr][4 * i + 1]); t.z = f2bf(v[rr][4 * i + 2]); t.w = f2bf(v[rr][4 * i + 3]);
                if (!a.out) *(ushort4*)(hbo + (rowb + rr) * D + 256 * i + 4 * lane) = t;
                if (a.out) { f32x4 o; o[0] = v[rr][4 * i]; o[1] = v[rr][4 * i + 1]; o[2] = v[rr][4 * i + 2]; o[3] = v[rr][4 * i + 3]; __builtin_nontemporal_store(o, (f32x4*)(a.out + (rowb + rr) * D + 256 * i + 4 * lane)); } }
        if constexpr (NDOT == 20) {
            float* res = Wt + 32 * 1024 + wave * 80;
            const int nb = ((lane >> 5) & 1) * 8 + ((lane >> 4) & 1) * 4 + ((lane >> 3) & 1) * 2 + ((lane >> 2) & 1);
#define ROW_FMA4(T_, RR, I, WA, WB) do { T_ = __builtin_elementwise_fma((f32x2){v[RR][4 * (I)], v[RR][4 * (I)]}, (f32x2){WA[0], WA[1]}, T_); T_ = __builtin_elementwise_fma((f32x2){v[RR][4 * (I) + 1], v[RR][4 * (I) + 1]}, (f32x2){WA[2], WA[3]}, T_); \
                T_ = __builtin_elementwise_fma((f32x2){v[RR][4 * (I) + 2], v[RR][4 * (I) + 2]}, (f32x2){WB[0], WB[1]}, T_); T_ = __builtin_elementwise_fma((f32x2){v[RR][4 * (I) + 3], v[RR][4 * (I) + 3]}, (f32x2){WB[2], WB[3]}, T_); } while (0)
#define ROW_RED16(X, SLOT) do { halve_step<16, 32>(X, lane); halve_step<8, 16>(X, lane); halve_step<4, 8>(X, lane); halve_step<2, 4>(X, lane); X[0] = xor_add<2>(X[0]); X[0] = xor_add<1>(X[0]); \
                if ((lane & 3) == 0) res[(SLOT) + nb] = X[0]; asm volatile("s_waitcnt lgkmcnt(0)" ::: "memory"); } while (0)
            f32x2 g2[8];
#pragma unroll
            for (int n = 0; n < 8; ++n) g2[n] = (f32x2){0.f, 0.f};
#pragma unroll
            for (int i = 0; i < 4; ++i)
#pragma unroll
                for (int jp = 0; jp < 2; ++jp) { const f32x4 wa = *(const f32x4*)(Wt + ((jp * 4 + i) * 2) * 256 + 4 * lane), wb = *(const f32x4*)(Wt + ((jp * 4 + i) * 2 + 1) * 256 + 4 * lane);
#pragma unroll
                    for (int rr = 0; rr < 4; ++rr) ROW_FMA4(g2[rr * 2 + jp], rr, i, wa, wb); }
            float ga[16];
#pragma unroll
            for (int n = 0; n < 8; ++n) { ga[2 * n] = g2[n][0]; ga[2 * n + 1] = g2[n][1]; }
            ROW_RED16(ga, 0);
            int gi[4];
            const float bg0 = a.b_group[0], bg1 = a.b_group[1], bg2 = a.b_group[2], bg3 = a.b_group[3];
#pragma unroll
            for (int rr = 0; rr < 4; ++rr) { const f32x4 t = *(const f32x4*)(res + 4 * rr); const float gl[4] = {t[0] + bg0, t[1] + bg1, t[2] + bg2, t[3] + bg3};
                int g_ = 0; float gm = gl[0];
#pragma unroll
                for (int j = 1; j < 4; ++j) if (gl[j] > gm) { gm = gl[j]; g_ = j; }
                gi[rr] = g_; }
            f32x2 e2[8];
#pragma unroll
            for (int n = 0; n < 8; ++n) e2[n] = (f32x2){0.f, 0.f};
#pragma unroll
            for (int rr = 0; rr < 4; ++rr) { const float* wr_ = Wt + (2 + 2 * gi[rr]) * 2048 + 4 * lane;
#pragma unroll
                for (int i = 0; i < 4; ++i)
#pragma unroll
                    for (int q = 0; q < 2; ++q) { const f32x4 wa = *(const f32x4*)(wr_ + q * 2048 + (i * 2) * 256), wb = *(const f32x4*)(wr_ + q * 2048 + (i * 2 + 1) * 256);
                        ROW_FMA4(e2[rr * 2 + q], rr, i, wa, wb); } }
            float ea[16];
#pragma unroll
            for (int n = 0; n < 8; ++n) { ea[2 * n] = e2[n][0]; ea[2 * n + 1] = e2[n][1]; }
            ROW_RED16(ea, 16);
#undef ROW_FMA4
#undef ROW_RED16
            if (lane < 4) {
                const f32x4 tg = *(const f32x4*)(res + 4 * lane), te = *(const f32x4*)(res + 16 + 4 * lane);
                const float gl[4] = {tg[0] + bg0, tg[1] + bg1, tg[2] + bg2, tg[3] + bg3};
                int gq = 0; float gm = gl[0];
#pragma unroll
                for (int j = 1; j < 4; ++j) if (gl[j] > gm) { gm = gl[j]; gq = j; }
                float gs = 0.f;
#pragma unroll
                for (int j = 0; j < 4; ++j) gs += __expf(gl[j] - gm);
                const float gw = 1.f / gs;
                float l4[4];
#pragma unroll
                for (int j = 0; j < 4; ++j) l4[j] = te[j] + a.b_router[gq * 4 + j];
                int ia = 0; float la = l4[0];
#pragma unroll
                for (int j = 1; j < 4; ++j) if (l4[j] > la) { la = l4[j]; ia = j; }
                int ib = -1; float lb = -3.0e38f;
#pragma unroll
                for (int j = 0; j < 4; ++j) if (j != ia && l4[j] > lb) { lb = l4[j]; ib = j; }
                const float eb = __expf(lb - la), wa = 1.f / (1.f + eb), wb = eb / (1.f + eb);
                const int e1 = gq * 4 + ia, e2_ = gq * 4 + ib;
                const int p1 = atomicAdd(&lcnt[e1], 1), p2 = atomicAdd(&lcnt[e2_], 1);
                const int lrow = lr0 + lane; const size_t row = rowb + lane;
                ent[lrow * 4 + 0] = e1; ent[lrow * 4 + 1] = p1; ent[lrow * 4 + 2] = e2_; ent[lrow * 4 + 3] = p2;
                a.tok_e[row * 2] = e1; a.tok_e[row * 2 + 1] = e2_; a.tok_w[row * 2] = gw * wa; a.tok_w[row * 2 + 1] = gw * wb;
            }
        } else if constexpr (NDOT > 0) {
            constexpr int NV = 4 * NDOT, NP = NDOT / 2;
            f32x2 acc2[4 * NP];
#pragma unroll
            for (int n = 0; n < 4 * NP; ++n) acc2[n] = (f32x2){0.f, 0.f};
#pragma unroll
            for (int i = 0; i < 4; ++i) {
#pragma unroll
                for (int jp = 0; jp < NP; ++jp) { const f32x4 wa = *(const f32x4*)(Wt + ((jp * 4 + i) * 2) * 256 + 4 * lane), wb = *(const f32x4*)(Wt + ((jp * 4 + i) * 2 + 1) * 256 + 4 * lane);
#pragma unroll
                    for (int rr = 0; rr < 4; ++rr) { f32x2 t = acc2[rr * NP + jp];
                        t = __builtin_elementwise_fma((f32x2){v[rr][4 * i], v[rr][4 * i]}, (f32x2){wa[0], wa[1]}, t); t = __builtin_elementwise_fma((f32x2){v[rr][4 * i + 1], v[rr][4 * i + 1]}, (f32x2){wa[2], wa[3]}, t);
                        t = __builtin_elementwise_fma((f32x2){v[rr][4 * i + 2], v[rr][4 * i + 2]}, (f32x2){wb[0], wb[1]}, t); t = __builtin_elementwise_fma((f32x2){v[rr][4 * i + 3], v[rr][4 * i + 3]}, (f32x2){wb[2], wb[3]}, t);
                        acc2[rr * NP + jp] = t; }
                    asm volatile("" : "+v"(acc2[jp]), "+v"(acc2[NP + jp]), "+v"(acc2[2 * NP + jp]), "+v"(acc2[3 * NP + jp]) :: "memory"); }
            }
            float acc[NV];
#pragma unroll
            for (int n = 0; n < 4 * NP; ++n) { acc[2 * n] = acc2[n][0]; acc[2 * n + 1] = acc2[n][1]; }
            halve_step<NV, 32>(acc, lane); halve_step<NV / 2, 16>(acc, lane); halve_step<NV / 4, 8>(acc, lane); halve_step<NV / 8, 4>(acc, lane);
            constexpr int NR = NV / 16;
#pragma unroll
            for (int i = 0; i < NR; ++i) { acc[i] = xor_add<2>(acc[i]); acc[i] = xor_add<1>(acc[i]); }
            float* res = Wt + 32 * 1024 + wave * 80;
            if ((lane & 3) == 0) { const int nb = ((lane >> 5) & 1) * (NV / 2) + ((lane >> 4) & 1) * (NV / 4) + ((lane >> 3) & 1) * (NV / 8) + ((lane >> 2) & 1) * (NV / 16);
#pragma unroll
                for (int i = 0; i < NR; ++i) res[nb + i] = acc[i]; }
            asm volatile("s_waitcnt lgkmcnt(0)" ::: "memory");
            if (a.mode != 1) {
                if (lane < NV) a.lr_out[rowb * 16 + lane] = res[lane];
            } else if (lane < 4) {
                const float* rp = res + lane * NDOT;
                float gl[4], el[16];
#pragma unroll
                for (int j = 0; j < 4; ++j) gl[j] = rp[j] + a.b_group[j];
#pragma unroll
                for (int j = 0; j < 16; ++j) el[j] = rp[4 + j] + a.b_router[j];
                int gi = 0; float gm = gl[0];
#pragma unroll
                for (int j = 1; j < 4; ++j) if (gl[j] > gm) { gm = gl[j]; gi = j; }
                float gs = 0.f;
#pragma unroll
                for (int j = 0; j < 4; ++j) gs += __expf(gl[j] - gm);
                const float gw = 1.f / gs;
                float l4[4];
#pragma unroll
                for (int j = 0; j < 4; ++j) l4[j] = gi == 0 ? el[j] : gi == 1 ? el[4 + j] : gi == 2 ? el[8 + j] : el[12 + j];
                int ia = 0; float la = l4[0];
#pragma unroll
                for (int j = 1; j < 4; ++j) if (l4[j] > la) { la = l4[j]; ia = j; }
                int ib = -1; float lb = -3.0e38f;
#pragma unroll
                for (int j = 0; j < 4; ++j) if (j != ia && l4[j] > lb) { lb = l4[j]; ib = j; }
                const float eb = __expf(lb - la), wa = 1.f / (1.f + eb), wb = eb / (1.f + eb);
                const int e1 = gi * 4 + ia, e2 = gi * 4 + ib;
                const int p1 = atomicAdd(&lcnt[e1], 1), p2 = atomicAdd(&lcnt[e2], 1);
                const int lrow = lr0 + lane; const size_t row = rowb + lane;
                ent[lrow * 4 + 0] = e1; ent[lrow * 4 + 1] = p1; ent[lrow * 4 + 2] = e2; ent[lrow * 4 + 3] = p2;
                a.tok_e[row * 2] = e1; a.tok_e[row * 2 + 1] = e2; a.tok_w[row * 2] = gw * wa; a.tok_w[row * 2 + 1] = gw * wb;
            }
        }
    }
    if (a.mode == 1) {
        __syncthreads();
        if (tid < 16) lbase[tid] = atomicAdd(&a.cnt[tid], lcnt[tid]);
        __syncthreads();
        for (int r = tid; r < rows_per_block; r += nthr) {
            const int e1 = ent[r * 4], p1 = lbase[e1] + ent[r * 4 + 1], e2 = ent[r * 4 + 2], p2 = lbase[e2] + ent[r * 4 + 3];
            const int tok = ((r / (nw * 4)) * nblocks + bid) * (nw * 4) + (r % (nw * 4));
            a.list[(size_t)e1 * T + p1] = tok; a.list[(size_t)e2 * T + p2] = tok;
            a.tok_pos[tok * 2] = p1; a.tok_pos[tok * 2 + 1] = p2;
        }
    }
    __syncthreads();
}

__device__ __forceinline__ int rel_bucket_dev(int rel) {
    const int n = rel < 0 ? -rel : rel; int bk;
    if (n < 8) bk = n; else if (n >= 128) bk = 15; else { const int x = (n * n) >> 6; bk = 8 + (31 - __clz(x)); if (bk > 15) bk = 15; }
    return (rel > 0 ? 16 : 0) + bk;
}
namespace pg8 {
#define PG8_LAS __attribute__((address_space(3)))
typedef unsigned u32x4 __attribute__((ext_vector_type(4)));
typedef unsigned u32x2 __attribute__((ext_vector_type(2)));
constexpr int BM = 256, BK = 64, HALF = 128, HTB = HALF * BK * 2, STAGE_BYTES = 8 * HTB, NXCD = 8, WGM = 8;
__host__ __device__ __forceinline__ int lds_byte(int r, int c) { const int st = (r >> 4) * 2 + (c >> 5), rr = r & 15, cc = c & 31, ob = rr * 64 + cc * 2; return st * 1024 + (ob ^ (((ob >> 9) & 1) << 5)); }
__host__ __device__ __forceinline__ void stage_rc(int b, int& R, int& C) { const int st = b / 1024, sb = b % 1024, swz = sb ^ (((sb >> 9) & 1) << 5); R = (st >> 1) * 16 + swz / 64; C = (st & 1) * 32 + (swz % 64) / 2; }
__host__ __device__ __forceinline__ int perm32(int rho) { const int n = rho >> 4, i = rho & 15; return 8 * (i >> 2) + 4 * n + (i & 3); }

struct Unit { int pn, e, arow, orow, cnt; };
struct Gemm { const bf16_t* A; const bf16_t* Bt; int lda, ldb, K; size_t bt_estride; };

struct DenseOrder {
    int nM, nN, nwg, G, c;
    __device__ __forceinline__ void init(int M, int N, int G_, int c_) { nM = M / BM; nN = N / BM; nwg = nM * nN; G = G_; c = c_; }
    __device__ __forceinline__ bool next(int i, Unit& u) const {
        const long L = (long)i * G + c; if (L >= nwg) return false;
        int wgid = (int)L; { const int q = nwg / NXCD, r = nwg % NXCD, xcd = wgid % NXCD, off = wgid / NXCD; wgid = (xcd < r ? xcd * (q + 1) : r * (q + 1) + (xcd - r) * q) + off; }
        const int nig = WGM * nN, gid = wgid / nig, fm = gid * WGM, gsz = (nM - fm) < WGM ? (nM - fm) : WGM;
        const int pm = fm + ((wgid % nig) % gsz); u.pn = (wgid % nig) / gsz; u.e = 0; u.arow = pm * BM; u.orow = pm * BM; u.cnt = 0; return true;
    }
    __device__ __forceinline__ unsigned rowbyte(const Unit& u, int r, int lda) const { return (unsigned)(u.arow + r) * (unsigned)lda * 2u; }
};
template <bool GATHER> struct MoeOrder {
    const int* cnt; const int* list; int nN, G, c;
    __device__ __forceinline__ bool next(int i, Unit& u) const {
        const int lane = (int)__builtin_amdgcn_mbcnt_hi(~0u, __builtin_amdgcn_mbcnt_lo(~0u, 0u));
        const int myc = cnt[lane & (NE - 1)];
        const int x = c & 7, nwx = G >> 3; int L = __builtin_amdgcn_readfirstlane(i * nwx + (c >> 3)); bool found = false;
        u.pn = 0; u.e = 0; u.arow = 0; u.orow = 0; u.cnt = 0;
        int esel = -1, ce_sel = 0;
        { const int ce0 = __builtin_amdgcn_readlane(myc, x), nu0 = ((ce0 + 255) >> 8) * nN;
          if (L < nu0) { esel = x; ce_sel = ce0; }
          else { L -= nu0; const int ce1 = __builtin_amdgcn_readlane(myc, x + 8), nu1 = ((ce1 + 255) >> 8) * nN; if (L < nu1) { esel = x + 8; ce_sel = ce1; } } }
        if (esel >= 0) { int off = 0;
#pragma unroll
            for (int e = 0; e < NE; ++e) { const int nt = (__builtin_amdgcn_readlane(myc, e) + 255) >> 8; if (e < esel) off += nt * BM; }
            const int pm = L / nN; u.pn = L - pm * nN; u.e = esel; u.arow = pm * BM; u.orow = off + pm * BM; u.cnt = ce_sel; found = true; }
        return found;
    }
    __device__ __forceinline__ unsigned rowbyte(const Unit& u, int r, int lda) const {
        if (GATHER) { const int li = u.arow + r; const int tok = li < u.cnt ? list[(size_t)u.e * T + li] : 0; return (unsigned)tok * (unsigned)lda * 2u; }
        return (unsigned)(u.orow + r) * (unsigned)lda * 2u;
    }
};

__device__ __forceinline__ unsigned cvt_pk_bf16(float lo, float hi) { unsigned r; asm volatile("v_cvt_pk_bf16_f32 %0, %1, %2" : "=v"(r) : "v"(lo), "v"(hi)); return r; }
struct EpiBf16 {
    static constexpr bool PERM = true;
    bf16_t* O; int ldc;
    __device__ __forceinline__ void operator()(const f32x4 (&acc)[2][2][4][2], const Unit& u, int wr, int wc, int fr, int fq) const {
        const int row0 = u.orow + wr * 64 + fr, col0 = u.pn * BM + wc * 32 + 8 * fq;
#pragma unroll
        for (int ai = 0; ai < 2; ++ai)
#pragma unroll
            for (int m = 0; m < 4; ++m) { bf16_t* rowp = O + (size_t)(row0 + ai * HALF + m * 16) * ldc + col0;
#pragma unroll
                for (int bj = 0; bj < 2; ++bj) { const f32x4 v0 = acc[ai][bj][m][0], v1 = acc[ai][bj][m][1];
                    u32x4 w; w.x = cvt_pk_bf16(v0[0], v0[1]); w.y = cvt_pk_bf16(v0[2], v0[3]); w.z = cvt_pk_bf16(v1[0], v1[1]); w.w = cvt_pk_bf16(v1[2], v1[3]);
                    *(u32x4*)(rowp + bj * HALF) = w; } }
    }
};
struct EpiSwiglu {
    static constexpr bool PERM = false;
    bf16_t* O; int ldc;
    __device__ __forceinline__ void operator()(const f32x4 (&acc)[2][2][4][2], const Unit& u, int wr, int wc, int fr, int fq) const {
        const int row0 = u.orow + wr * 64 + fr, col0 = u.pn * (BM / 2) + wc * 16 + 4 * fq;
#pragma unroll
        for (int ai = 0; ai < 2; ++ai)
#pragma unroll
            for (int m = 0; m < 4; ++m) { bf16_t* rowp = O + (size_t)(row0 + ai * HALF + m * 16) * ldc + col0;
#pragma unroll
                for (int bj = 0; bj < 2; ++bj) { const f32x4 g = acc[ai][bj][m][0], v = acc[ai][bj][m][1];
                    u32x2 w; w.x = cvt_pk_bf16(silu_f(g[0]) * v[0], silu_f(g[1]) * v[1]); w.y = cvt_pk_bf16(silu_f(g[2]) * v[2], silu_f(g[3]) * v[3]);
                    *(u32x2*)(rowp + bj * (HALF / 2)) = w; } }
    }
};

template <class Epi, class Sched>
__device__ __forceinline__ void gemm_phase(PG8_LAS unsigned char* lds, const Gemm g, const Sched& S, const Epi& E, int tid) {
    const int wid = __builtin_amdgcn_readfirstlane(tid >> 6), lane = tid & 63, wr = wid >> 2, wc = wid & 3, fr = lane & 15, fq = lane >> 4;
    const int K = g.K, nt = K / BK;
    unsigned voffB[2];
#pragma unroll
    for (int i = 0; i < 2; ++i) { int R, C; stage_rc(tid * 16 + i * 8192, R, C); const int Rb = Epi::PERM ? ((R & ~31) + perm32(R & 31)) : R;
        voffB[i] = (unsigned)(Rb * g.ldb + C) * 2u; }
    const size_t kstep = (size_t)(BK * 2);
    const size_t hstepB = (size_t)HALF * g.ldb * 2, tstepB = 2 * hstepB;
    const unsigned ldsw = (unsigned)wid * 1024u;
    const int aoff = lds_byte(wr * 64 + fr, fq * 8), boff = lds_byte(wc * 32 + fr, fq * 8);
#define PG8_SA(b, h) (((b) * 2 + (h)) * HTB)
#define PG8_SB(b, h) ((4 + (b) * 2 + (h)) * HTB)
#define PG8_STAGE(bufoff, gbase, voff) do { _Pragma("unroll") for (int _i = 0; _i < 2; ++_i) \
        __builtin_amdgcn_global_load_lds((const unsigned*)((const char*)(gbase) + (voff)[_i]), (PG8_LAS unsigned*)(lds + (bufoff) + ldsw + _i * 8192), 16, 0, 0); } while (0)
#define PG8_LDA(dst, b, h) do { _Pragma("unroll") for (int m = 0; m < 4; ++m) _Pragma("unroll") for (int k = 0; k < 2; ++k) dst[m][k] = *(const PG8_LAS bf16x8*)(lds + PG8_SA(b, h) + aoff + m * 2048 + k * 1024); } while (0)
#define PG8_LDB(dst, b, h) do { _Pragma("unroll") for (int n = 0; n < 2; ++n) _Pragma("unroll") for (int k = 0; k < 2; ++k) dst[n][k] = *(const PG8_LAS bf16x8*)(lds + PG8_SB(b, h) + boff + n * 2048 + k * 1024); } while (0)
#define PG8_MMA(ai, bj, At, Bt) do { __builtin_amdgcn_s_setprio(1); _Pragma("unroll") for (int m = 0; m < 4; ++m) _Pragma("unroll") for (int n = 0; n < 2; ++n) _Pragma("unroll") for (int k = 0; k < 2; ++k) \
        acc[ai][bj][m][n] = __builtin_amdgcn_mfma_f32_16x16x32_bf16(Bt[n][k], At[m][k], acc[ai][bj][m][n], 0, 0, 0); __builtin_amdgcn_s_setprio(0); } while (0)
#define PG8_WAIT_V(n) asm volatile("s_waitcnt vmcnt(" #n ")" ::: "memory")
#define PG8_WAIT_L(n) asm volatile("s_waitcnt lgkmcnt(" #n ")" ::: "memory")
#define PG8_BAR __builtin_amdgcn_s_barrier()
#define PG8_SCHED __builtin_amdgcn_sched_barrier(0)
#define PG8_ROWS(dst, u) do { int _t = tid; asm volatile("" : "+v"(_t)); _Pragma("unroll") for (int _i = 0; _i < 2; ++_i) { int _R, _C; stage_rc(_t * 16 + _i * 8192, _R, _C); \
        _Pragma("unroll") for (int _h = 0; _h < 2; ++_h) dst[_h][_i] = S.rowbyte(u, _h * HALF + _R, g.lda) + (unsigned)(_C * 2); } } while (0)
    Unit cur, nxt; int ui = 0;
    if (!S.next(0, cur)) return;
    f32x4 acc[2][2][4][2];
#pragma unroll
    for (int a = 0; a < 2; ++a)
#pragma unroll
        for (int b = 0; b < 2; ++b)
#pragma unroll
            for (int m = 0; m < 4; ++m)
#pragma unroll
                for (int n = 0; n < 2; ++n) acc[a][b][m][n] = (f32x4){0.f, 0.f, 0.f, 0.f};
    bf16x8 At[4][2], B0[2][2], B1[2][2];
    unsigned cvA[2][2], nvA[2][2];
    PG8_ROWS(cvA, cur);
    const char* const gA = (const char*)g.A;
    const char* cB = (const char*)g.Bt + (size_t)cur.e * g.bt_estride * 2 + (size_t)cur.pn * tstepB;
    PG8_STAGE(PG8_SB(0, 0), cB, voffB); PG8_STAGE(PG8_SB(0, 1), cB + hstepB, voffB); PG8_STAGE(PG8_SA(0, 0), gA, cvA[0]); PG8_STAGE(PG8_SA(0, 1), gA, cvA[1]);
    if (wr == 1) PG8_BAR;
    PG8_WAIT_V(2); PG8_BAR;
    PG8_STAGE(PG8_SB(1, 0), cB + kstep, voffB); PG8_STAGE(PG8_SA(1, 0), gA + kstep, cvA[0]); PG8_STAGE(PG8_SB(1, 1), cB + hstepB + kstep, voffB);
    PG8_WAIT_V(6); PG8_BAR;
    for (;;) {
        const bool has_next = S.next(ui + 1, nxt);
        const char* nB = has_next ? (const char*)g.Bt + (size_t)nxt.e * g.bt_estride * 2 + (size_t)nxt.pn * tstepB : cB;
        if (has_next) { PG8_ROWS(nvA, nxt); }
        else {
#pragma unroll
            for (int _h = 0; _h < 2; ++_h)
#pragma unroll
                for (int _i = 0; _i < 2; ++_i) nvA[_h][_i] = cvA[_h][_i];
        }
        for (int t = 0; t < nt; t += 2) {
            const bool last = (t == nt - 2);
            const char* a1 = gA + (size_t)(t + 1) * kstep;
            const char* a2 = last ? gA : gA + (size_t)(t + 2) * kstep; const char* b2 = last ? nB : cB + (size_t)(t + 2) * kstep;
            const char* a3 = a2 + kstep; const char* b3 = b2 + kstep;
            PG8_LDB(B0, 0, 0); PG8_LDB(B1, 0, 1); PG8_SCHED; PG8_LDA(At, 0, 0); PG8_STAGE(PG8_SA(1, 1), a1, cvA[1]);
            PG8_WAIT_V(8); PG8_WAIT_L(0); PG8_BAR; PG8_MMA(0, 0, At, B0); PG8_MMA(0, 1, At, B1); PG8_BAR; PG8_SCHED;
            PG8_LDA(At, 0, 1); PG8_STAGE(PG8_SB(0, 0), b2, voffB); PG8_STAGE(PG8_SB(0, 1), b2 + hstepB, voffB); if (last) PG8_STAGE(PG8_SA(0, 0), a2, nvA[0]); else PG8_STAGE(PG8_SA(0, 0), a2, cvA[0]);
            PG8_WAIT_V(8); PG8_WAIT_L(0); PG8_BAR; PG8_MMA(1, 0, At, B0); PG8_MMA(1, 1, At, B1); PG8_BAR; PG8_SCHED;
            PG8_LDB(B0, 1, 0); PG8_LDB(B1, 1, 1); PG8_SCHED; PG8_LDA(At, 1, 0); if (last) PG8_STAGE(PG8_SA(0, 1), a2, nvA[1]); else PG8_STAGE(PG8_SA(0, 1), a2, cvA[1]);
            PG8_WAIT_V(8); PG8_WAIT_L(0); PG8_BAR; PG8_MMA(0, 0, At, B0); PG8_MMA(0, 1, At, B1); PG8_BAR; PG8_SCHED;
            PG8_LDA(At, 1, 1); PG8_STAGE(PG8_SB(1, 0), b3, voffB); PG8_STAGE(PG8_SB(1, 1), b3 + hstepB, voffB); if (last) PG8_STAGE(PG8_SA(1, 0), a3, nvA[0]); else PG8_STAGE(PG8_SA(1, 0), a3, cvA[0]);
            PG8_WAIT_V(8); PG8_WAIT_L(0); PG8_BAR; PG8_MMA(1, 0, At, B0); PG8_MMA(1, 1, At, B1); PG8_BAR; PG8_SCHED;
        }
        if (wr == 0) PG8_BAR;
        E(acc, cur, wr, wc, fr, fq);
        if (!has_next) break;
#pragma unroll
        for (int a = 0; a < 2; ++a)
#pragma unroll
            for (int b = 0; b < 2; ++b)
#pragma unroll
                for (int m = 0; m < 4; ++m)
#pragma unroll
                    for (int n = 0; n < 2; ++n) acc[a][b][m][n] = (f32x4){0.f, 0.f, 0.f, 0.f};
        cur = nxt; cB = nB; ++ui;
#pragma unroll
        for (int _h = 0; _h < 2; ++_h)
#pragma unroll
            for (int _i = 0; _i < 2; ++_i) cvA[_h][_i] = nvA[_h][_i];
        if (wr == 1) PG8_BAR;
    }
    PG8_WAIT_V(0);
    PG8_BAR;
#undef PG8_SA
#undef PG8_SB
#undef PG8_STAGE
#undef PG8_LDA
#undef PG8_LDB
#undef PG8_MMA
#undef PG8_WAIT_V
#undef PG8_WAIT_L
#undef PG8_BAR
#undef PG8_SCHED
#undef PG8_ROWS
}
}

namespace att {
using s16x4  = __attribute__((ext_vector_type(4))) short;
using f32x16 = __attribute__((ext_vector_type(16))) float;
using f32x2  = __attribute__((ext_vector_type(2))) float;
using u32x4  = __attribute__((ext_vector_type(4))) unsigned;
constexpr int NW = 8, QBLK = 32, KVBLK = 64, LDKV = 2048, LDQ = 1024;
constexpr int SHM_V = KVBLK * ADV * 2, SHM_K = KVBLK * ADH * 2;
constexpr int OFF_V = 0, OFF_K = 4 * SHM_V, OFF_WS = OFF_K + 4 * SHM_K, OFF_LUT = OFF_WS + NW * 64 * 4, LDS_ATT = OFF_LUT + 1024;
constexpr float LOG2E = 1.4426950408889634f, THR2 = 8.f * LOG2E;
#define KSWZ64(row, colB) ((row) * 128 + ((colB) ^ ((((row) >> 1) & 7) << 4)))
#define SBAR() __builtin_amdgcn_sched_barrier(0)
__device__ __forceinline__ int crow(int r, int hi) { return (r & 3) + 8 * (r >> 2) + 4 * hi; }
typedef __bf16 bf2_t __attribute__((ext_vector_type(2)));
__device__ __forceinline__ unsigned cvtpk(float lo, float hi) { const f32x2 v = {lo, hi}; return __builtin_bit_cast(unsigned, __builtin_convertvector(v, bf2_t)); }

__device__ __forceinline__ void sm_max0(const f32x16& p0, float& pmax) {
  pmax = p0[0];
#pragma unroll
  for (int r = 1; r < 16; ++r) pmax = fmaxf(pmax, p0[r]);
}
__device__ __forceinline__ void sm_decide(f32x16& p0, f32x16& p1, float& pmax, float& m_reg, float& alpha, f32x16& ct) {
#pragma unroll
  for (int r = 0; r < 16; ++r) pmax = fmaxf(pmax, p1[r]);
  { auto rr = __builtin_amdgcn_permlane32_swap(__float_as_uint(pmax), __float_as_uint(pmax), false, false);
    pmax = fmaxf(__uint_as_float(rr[0]), __uint_as_float(rr[1])); }
  if (__builtin_expect(__all(pmax <= THR2), 1)) { alpha = 1.f; }
  else { const float d = fmaxf(pmax, 0.f); alpha = __builtin_amdgcn_exp2f(-d); m_reg += d;
#pragma unroll
    for (int r = 0; r < 16; ++r) { p0[r] -= d; p1[r] -= d; ct[r] -= d; } }
}
__device__ __forceinline__ void sm_exp(f32x16& p) {
#pragma unroll
  for (int r = 0; r < 16; ++r) p[r] = __builtin_amdgcn_exp2f(p[r]);
}
__device__ __forceinline__ void sm_first(f32x16& p0, f32x16& p1, float& m_reg) {
  float pmax; sm_max0(p0, pmax);
#pragma unroll
  for (int r = 0; r < 16; ++r) pmax = fmaxf(pmax, p1[r]);
  { auto rr = __builtin_amdgcn_permlane32_swap(__float_as_uint(pmax), __float_as_uint(pmax), false, false);
    pmax = fmaxf(__uint_as_float(rr[0]), __uint_as_float(rr[1])); }
  m_reg = pmax;
#pragma unroll
  for (int r = 0; r < 16; ++r) { p0[r] = __builtin_amdgcn_exp2f(p0[r] - pmax); p1[r] = __builtin_amdgcn_exp2f(p1[r] - pmax); }
}
__device__ __forceinline__ void finishSM(const f32x16& p0, const f32x16& p1, float alpha, float& l_reg, bf16x8& pa0, bf16x8& pa1, bf16x8& pa2, bf16x8& pa3) {
  f32x2 a = {p0[0], p0[1]}, b = {p0[2], p0[3]};
#pragma unroll
  for (int r = 4; r < 16; r += 4) { a += (f32x2){p0[r], p0[r + 1]}; b += (f32x2){p0[r + 2], p0[r + 3]}; }
#pragma unroll
  for (int r = 0; r < 16; r += 4) { a += (f32x2){p1[r], p1[r + 1]}; b += (f32x2){p1[r + 2], p1[r + 3]}; }
  float ps = (a[0] + a[1]) + (b[0] + b[1]);
  { auto rr = __builtin_amdgcn_permlane32_swap(__float_as_uint(ps), __float_as_uint(ps), false, false);
    ps = __uint_as_float(rr[0]) + __uint_as_float(rr[1]); }
  l_reg = l_reg * alpha + ps;
#define PK4(P, BASE, OUT) do { u32x4 w = {cvtpk(P[BASE + 0], P[BASE + 1]), cvtpk(P[BASE + 2], P[BASE + 3]), cvtpk(P[BASE + 4], P[BASE + 5]), cvtpk(P[BASE + 6], P[BASE + 7])}; OUT = *reinterpret_cast<bf16x8*>(&w); } while (0)
  PK4(p0, 0, pa0); PK4(p0, 8, pa1); PK4(p1, 0, pa2); PK4(p1, 8, pa3);
#undef PK4
}
#ifndef ATT_BIGSUM_LOG2
#define ATT_BIGSUM_LOG2 17.5f
#endif
template <int H> __device__ __forceinline__ void sm_exp8(f32x16& p) {
#pragma unroll
  for (int r = 8 * H; r < 8 * H + 8; ++r) p[r] = __builtin_amdgcn_exp2f(p[r]);
}
__device__ __forceinline__ float sm_rowsum(const f32x16& p0, const f32x16& p1) {
  f32x2 a = {p0[0], p0[1]}, b = {p0[2], p0[3]};
#pragma unroll
  for (int r = 4; r < 16; r += 4) { a += (f32x2){p0[r], p0[r + 1]}; b += (f32x2){p0[r + 2], p0[r + 3]}; }
#pragma unroll
  for (int r = 0; r < 16; r += 4) { a += (f32x2){p1[r], p1[r + 1]}; b += (f32x2){p1[r + 2], p1[r + 3]}; }
  float ps = (a[0] + a[1]) + (b[0] + b[1]);
  { auto rr = __builtin_amdgcn_permlane32_swap(__float_as_uint(ps), __float_as_uint(ps), false, false);
    ps = __uint_as_float(rr[0]) + __uint_as_float(rr[1]); }
  return ps;
}
__device__ __forceinline__ void sm_pack(const f32x16& p0, const f32x16& p1, bf16x8& pa0, bf16x8& pa1, bf16x8& pa2, bf16x8& pa3) {
#define PK4(P, BASE, OUT) do { u32x4 w = {cvtpk(P[BASE + 0], P[BASE + 1]), cvtpk(P[BASE + 2], P[BASE + 3]), cvtpk(P[BASE + 4], P[BASE + 5]), cvtpk(P[BASE + 6], P[BASE + 7])}; OUT = *reinterpret_cast<bf16x8*>(&w); } while (0)
  PK4(p0, 0, pa0); PK4(p0, 8, pa1); PK4(p1, 0, pa2); PK4(p1, 8, pa3);
#undef PK4
}
template <int KOFF> __device__ __forceinline__ void qkt_far(f32x16& p0, f32x16& p1, const f32x16& ct, const int* kb, const bf16x8* qr) {
  bf16x8 b0[4], b1[4];
  __builtin_amdgcn_s_setprio(2);
#pragma unroll
  for (int d0 = 0; d0 < 4; ++d0) { b0[d0] = *(const PG8_LAS bf16x8*)(unsigned)(kb[d0] + KOFF); b1[d0] = *(const PG8_LAS bf16x8*)(unsigned)(kb[d0] + KOFF + 4096); }
  SBAR();
#pragma unroll
  for (int d0 = 0; d0 < 4; ++d0) {
    if (d0 == 0) { p0 = __builtin_amdgcn_mfma_f32_32x32x16_bf16(b0[0], qr[0], ct, 0, 0, 0); p1 = __builtin_amdgcn_mfma_f32_32x32x16_bf16(b1[0], qr[0], ct, 0, 0, 0); }
    else { p0 = __builtin_amdgcn_mfma_f32_32x32x16_bf16(b0[d0], qr[d0], p0, 0, 0, 0); p1 = __builtin_amdgcn_mfma_f32_32x32x16_bf16(b1[d0], qr[d0], p1, 0, 0, 0); } }
  __builtin_amdgcn_s_setprio(0);
}
template <int MODE> __device__ __forceinline__ void qkt(f32x16& p0, f32x16& p1, const f32x16& ct, const char* Ks, const bf16x8* qr, int r32, int hi) {
  bf16x8 b0[4], b1[4];
#pragma unroll
  for (int d0 = 0; d0 < 4; ++d0) { const int cb = (d0 * 16 + hi * 8) * 2;
    b0[d0] = *reinterpret_cast<const bf16x8*>(Ks + KSWZ64(r32, cb)); b1[d0] = *reinterpret_cast<const bf16x8*>(Ks + KSWZ64(32 + r32, cb)); }
  SBAR();
#pragma unroll
  for (int d0 = 0; d0 < 4; ++d0) {
    if (MODE == 0 && d0 == 0) { p0 = __builtin_amdgcn_mfma_f32_32x32x16_bf16(b0[0], qr[0], ct, 0, 0, 0); p1 = __builtin_amdgcn_mfma_f32_32x32x16_bf16(b1[0], qr[0], ct, 0, 0, 0); }
    else { p0 = __builtin_amdgcn_mfma_f32_32x32x16_bf16(b0[d0], qr[d0], p0, 0, 0, 0); p1 = __builtin_amdgcn_mfma_f32_32x32x16_bf16(b1[d0], qr[d0], p1, 0, 0, 0); } }
}
__device__ __forceinline__ void p_init(f32x16& p0, f32x16& p1, int j, int cq, int qoff, int hi, const float* lut, float m_reg) {
  if (j > cq) {
#pragma unroll
    for (int r = 0; r < 16; ++r) { p0[r] = -1e30f; p1[r] = -1e30f; }
  } else {
    const float* lp = lut + (64 * (j - cq) - qoff + 192 + 4 * hi);
#pragma unroll
    for (int r = 0; r < 16; ++r) { p0[r] = lp[(r & 3) + 8 * (r >> 2)] - m_reg; p1[r] = lp[32 + (r & 3) + 8 * (r >> 2)] - m_reg; }
  }
}
#define QK_TILE(p0, p1, j, Ks) do { if ((j) < cq - 2) qkt<0>(p0, p1, ct, Ks, qr, r32, hi); else { p_init(p0, p1, j, cq, qoff, hi, lut, m_reg); qkt<1>(p0, p1, ct, Ks, qr, r32, hi); } } while (0)
__device__ __forceinline__ int v_st(int k, int c) { const int kk = (k & ~0xC) | ((k & 4) << 1) | ((k & 8) >> 1); return ((kk >> 3) * 4 + (c >> 5)) * 512 + ((kk & 7) * 32 + (c & 31)) * 2; }
__device__ __forceinline__ int v_rd_base(int lane) { return ((lane & 3) << 3) | (((lane >> 2) & 3) << 6) | (((lane >> 4) & 1) << 5) | (((lane >> 5) & 1) << 11); }
constexpr int v_rd_off(int d0, int ks, int half) { return d0 * 512 + ks * 4096 + half * 256; }
template <int OFF> __device__ __forceinline__ s16x4 tr_read(int vb) {
  s16x4 r; asm volatile("ds_read_b64_tr_b16 %0, %1 offset:%2" : "=&v"(r) : "v"(vb), "i"(OFF) : "memory"); return r;
}
struct VFrag { s16x4 l0, h0, l1, h1, l2, h2, l3, h3; };
template <int D0, int SOFF = 0> __device__ __forceinline__ void pv_load(VFrag& f, int vb) {
  f.l0 = tr_read<SOFF + v_rd_off(D0, 0, 0)>(vb); f.h0 = tr_read<SOFF + v_rd_off(D0, 0, 1)>(vb); f.l1 = tr_read<SOFF + v_rd_off(D0, 1, 0)>(vb); f.h1 = tr_read<SOFF + v_rd_off(D0, 1, 1)>(vb);
  f.l2 = tr_read<SOFF + v_rd_off(D0, 2, 0)>(vb); f.h2 = tr_read<SOFF + v_rd_off(D0, 2, 1)>(vb); f.l3 = tr_read<SOFF + v_rd_off(D0, 3, 0)>(vb); f.h3 = tr_read<SOFF + v_rd_off(D0, 3, 1)>(vb);
}
__device__ __forceinline__ void pv_mma(f32x16& od, const VFrag& f, bf16x8 pa0, bf16x8 pa1, bf16x8 pa2, bf16x8 pa3) {
#define PK(L, H) (bf16x8){L[0], L[1], L[2], L[3], H[0], H[1], H[2], H[3]}
  od = __builtin_amdgcn_mfma_f32_32x32x16_bf16(pa0, PK(f.l0, f.h0), od, 0, 0, 0);
  od = __builtin_amdgcn_mfma_f32_32x32x16_bf16(pa1, PK(f.l1, f.h1), od, 0, 0, 0);
  od = __builtin_amdgcn_mfma_f32_32x32x16_bf16(pa2, PK(f.l2, f.h2), od, 0, 0, 0);
  od = __builtin_amdgcn_mfma_f32_32x32x16_bf16(pa3, PK(f.l3, f.h3), od, 0, 0, 0);
#undef PK
}
#define PV_LGK(n) do { asm volatile("s_waitcnt lgkmcnt(" #n ")" ::: "memory"); SBAR(); } while (0)
#define PV_PRE(vb) VFrag fA_, fB_; pv_load<0>(fA_, vb); pv_load<1>(fB_, vb)
#define PV_PRE_S(SO) VFrag fA_, fB_; pv_load<0, SO>(fA_, vb0); pv_load<1, SO>(fB_, vb0)
#define PV_WITH_SM_S(o, SO, pa0, pa1, pa2, pa3, q0, q1) do { \
    PV_LGK(8); pv_mma(o[0], fA_, pa0, pa1, pa2, pa3); sm_exp8<0>(q0); asm volatile("" : "+v"(q0)); \
    pv_load<2, SO>(fA_, vb0); PV_LGK(8); pv_mma(o[1], fB_, pa0, pa1, pa2, pa3); sm_exp8<1>(q0); asm volatile("" : "+v"(q0)); \
    pv_load<3, SO>(fB_, vb0); PV_LGK(8); pv_mma(o[2], fA_, pa0, pa1, pa2, pa3); sm_exp8<0>(q1); asm volatile("" : "+v"(q1)); \
    PV_LGK(0); pv_mma(o[3], fB_, pa0, pa1, pa2, pa3); sm_exp8<1>(q1); asm volatile("" : "+v"(q1)); } while (0)
#define PV_WITH_SM(o, vb, pa0, pa1, pa2, pa3, q0, q1) do { \
    PV_LGK(8); pv_mma(o[0], fA_, pa0, pa1, pa2, pa3); sm_exp8<0>(q0); asm volatile("" : "+v"(q0)); \
    pv_load<2>(fA_, vb); PV_LGK(8); pv_mma(o[1], fB_, pa0, pa1, pa2, pa3); sm_exp8<1>(q0); asm volatile("" : "+v"(q0)); \
    pv_load<3>(fB_, vb); PV_LGK(8); pv_mma(o[2], fA_, pa0, pa1, pa2, pa3); sm_exp8<0>(q1); asm volatile("" : "+v"(q1)); \
    PV_LGK(0); pv_mma(o[3], fB_, pa0, pa1, pa2, pa3); sm_exp8<1>(q1); asm volatile("" : "+v"(q1)); } while (0)
#define PV_ONLY(o, vb, pa0, pa1, pa2, pa3) do { \
    PV_LGK(8); pv_mma(o[0], fA_, pa0, pa1, pa2, pa3); pv_load<2>(fA_, vb); PV_LGK(8); pv_mma(o[1], fB_, pa0, pa1, pa2, pa3); \
    pv_load<3>(fB_, vb); PV_LGK(8); pv_mma(o[2], fA_, pa0, pa1, pa2, pa3); PV_LGK(0); pv_mma(o[3], fB_, pa0, pa1, pa2, pa3); } while (0)

__device__ __forceinline__ void attn_unit(const int FIN, const bf16_t* __restrict__ Qb, const bf16_t* __restrict__ Kh, const bf16_t* __restrict__ Vh, bf16_t* __restrict__ Ob, float* __restrict__ park,
                                                             float lam, const float* __restrict__ g_sub, float gscale, int qb, char* lds, int tid) {
  const int wid = __builtin_amdgcn_readfirstlane(tid >> 6), lane = tid & 63, r32 = lane & 31, hi = lane >> 5;
  char* V_lds = lds + OFF_V; char* K_lds = lds + OFF_K;
  float* ws = (float*)(lds + OFF_WS) + wid * 64; float* li_l = ws; float* al_l = ws + 32;
  const float* lut = (const float*)(lds + OFF_LUT);
  const float cfar = lut[0];
  const int cq = 4 * qb + (wid >> 1), qoff = 32 * (wid & 1) + r32;
  float m_reg = 0.f, l_reg = 0; f32x16 o[4] = {}; bf16x8 qr[4]; f32x16 ct;
  const bf16_t* Qw = Qb + (size_t)(wid * QBLK + r32) * LDQ + hi * 8;
#pragma unroll
  for (int d0 = 0; d0 < 4; ++d0) qr[d0] = *reinterpret_cast<const bf16x8*>(Qw + d0 * 16);
  const int kq = wid * 64 + lane, krow = kq >> 3, kcs = (kq & 7) ^ ((krow >> 1) & 7);
  const unsigned kgb = (unsigned)(krow * LDKV + kcs * 8) * 2u;
  unsigned vgb[2];
#pragma unroll
  for (int i = 0; i < 2; ++i) { const int P = ((i * 8 + wid) * 64 + lane) * 16, sub = P >> 9, rem = P & 511, kk = (sub >> 2) * 8 + (rem >> 6), c = (sub & 3) * 32 + ((rem & 63) >> 1);
    const int k = (kk & ~0xC) | ((kk & 4) << 1) | ((kk & 8) >> 1); vgb[i] = (unsigned)(k * LDKV + c) * 2u; }
  const __amdgpu_buffer_rsrc_t krs = __builtin_amdgcn_make_buffer_rsrc((void*)Kh, 0, 0x08000000, 0x00020000), vrs = __builtin_amdgcn_make_buffer_rsrc((void*)Vh, 0, 0x08000000, 0x00020000);
  const int vb0 = (int)(uintptr_t)V_lds + v_rd_base(lane);
  PG8_LAS unsigned char* const ldsl = (PG8_LAS unsigned char*)lds;
#define GLD(t) do { const unsigned so_ = (unsigned)(t) * (unsigned)(KVBLK * LDKV * 2); const int sl_ = (t) & 3; \
    __builtin_amdgcn_raw_ptr_buffer_load_lds(krs, (PG8_LAS void*)(ldsl + OFF_K + sl_ * SHM_K + wid * 1024), 16, kgb, so_, 0, 0); \
    __builtin_amdgcn_raw_ptr_buffer_load_lds(vrs, (PG8_LAS void*)(ldsl + OFF_V + sl_ * SHM_V + wid * 1024), 16, vgb[0], so_, 0, 0); \
    __builtin_amdgcn_raw_ptr_buffer_load_lds(vrs, (PG8_LAS void*)(ldsl + OFF_V + sl_ * SHM_V + (8 + wid) * 1024), 16, vgb[1], so_, 0, 0); } while (0)
#define TILE_BAR(n) do { asm volatile("s_waitcnt vmcnt(" #n ")" ::: "memory"); __builtin_amdgcn_s_barrier(); asm volatile("" ::: "memory"); } while (0)
#define RESC(a) do { if (__any((a) < 1.f)) { if (hi == 0) al_l[r32] = (a); asm volatile("s_waitcnt lgkmcnt(0)" ::: "memory"); \
    _Pragma("unroll") for (int d = 0; d < 4; ++d) _Pragma("unroll") for (int r = 0; r < 16; ++r) o[d][r] *= al_l[crow(r, hi)]; } } while (0)
  f32x16 pA0, pA1, pB0, pB1; float alA = 1.f, alB; bf16x8 pa0, pa1, pa2, pa3; const int NT = 4 * qb + 4;
  constexpr int SE = 0, SO = 1;
  GLD(0); GLD(1); TILE_BAR(3);
  if (0 < cq - 2) {
#pragma unroll
    for (int r = 0; r < 16; ++r) { pA0[r] = cfar; pA1[r] = cfar; }
  } else p_init(pA0, pA1, 0, cq, qoff, hi, lut, 0.f);
  qkt<1>(pA0, pA1, ct, K_lds, qr, r32, hi); sm_first(pA0, pA1, m_reg);
#pragma unroll
  for (int r = 0; r < 16; ++r) ct[r] = cfar - m_reg;
  GLD(2); TILE_BAR(3);
#define FIN_SM(pC0, pC1, pN0, pN1, HASN) do { float ps_ = sm_rowsum(pC0, pC1); \
    if (__builtin_expect(__any(ps_ > BIGSUM), 0)) { const float d_ = ps_ > BIGSUM ? __builtin_amdgcn_logf(ps_) : 0.f, a_ = __builtin_amdgcn_exp2f(-d_); \
      m_reg += d_; ps_ *= a_; l_reg *= a_; \
      _Pragma("unroll") for (int r = 0; r < 16; ++r) { pC0[r] *= a_; pC1[r] *= a_; ct[r] -= d_; if (HASN) { pN0[r] -= d_; pN1[r] -= d_; } } \
      RESC(a_); } \
    l_reg += ps_; sm_pack(pC0, pC1, pa0, pa1, pa2, pa3); } while (0)
  const float BIGSUM = __builtin_amdgcn_exp2f(ATT_BIGSUM_LOG2);
#define GLD_S(t, SL) do { const unsigned so_ = (unsigned)(t) * (unsigned)(KVBLK * LDKV * 2); \
    __builtin_amdgcn_raw_ptr_buffer_load_lds(krs, (PG8_LAS void*)(ldsl + OFF_K + (SL) * SHM_K + wid * 1024), 16, kgb, so_, 0, 0); \
    __builtin_amdgcn_raw_ptr_buffer_load_lds(vrs, (PG8_LAS void*)(ldsl + OFF_V + (SL) * SHM_V + wid * 1024), 16, vgb[0], so_, 0, 0); \
    __builtin_amdgcn_raw_ptr_buffer_load_lds(vrs, (PG8_LAS void*)(ldsl + OFF_V + (SL) * SHM_V + (8 + wid) * 1024), 16, vgb[1], so_, 0, 0); } while (0)
#define FAR_STEP(pN0, pN1, pC0, pC1, T_, SK, SV, CHK) do { { SBAR(); qkt_far<(SK) * SHM_K>(pN0, pN1, ct, kbl, qr); \
    asm volatile("s_waitcnt lgkmcnt(0)" ::: "memory"); SBAR(); PV_PRE_S((SV) * SHM_V); SBAR(); \
    FIN_SM(pC0, pC1, pN0, pN1, true); SBAR(); \
    GLD_S((T_) + 2, ((SK) + 2) & 3); SBAR(); \
    PV_WITH_SM_S(o, (SV) * SHM_V, pa0, pa1, pa2, pa3, pN0, pN1); } \
    TILE_BAR(3); } while (0)
  int kbl[4];
#pragma unroll
  for (int d0 = 0; d0 < 4; ++d0) { kbl[d0] = (int)(uintptr_t)K_lds + KSWZ64(r32, (d0 * 16 + hi * 8) * 2); asm volatile("" : "+v"(kbl[d0])); }
  const int nfar4 = qb > 0 ? qb - 1 : 0;
#pragma unroll 1
  for (int g4 = 0; g4 < nfar4; ++g4) { const int t0_ = 4 * g4 + 1;
    FAR_STEP(pB0, pB1, pA0, pA1, t0_, 1, 0, 0); FAR_STEP(pA0, pA1, pB0, pB1, t0_ + 1, 2, 1, 0); FAR_STEP(pB0, pB1, pA0, pA1, t0_ + 2, 3, 2, 0); FAR_STEP(pA0, pA1, pB0, pB1, t0_ + 3, 0, 3, 0); }
#undef FAR_STEP
#undef GLD_S
  for (int j = 4 * nfar4 + 1; j + 1 < NT; j += 2) {
    { SBAR(); QK_TILE(pB0, pB1, j, K_lds + (j & 3) * SHM_K);
    asm volatile("s_waitcnt lgkmcnt(0)" ::: "memory"); SBAR(); PV_PRE(vb0 + ((j - 1) & 3) * SHM_V); SBAR();
    FIN_SM(pA0, pA1, pB0, pB1, true); SBAR();
    GLD(j + 2); SBAR();
    PV_WITH_SM(o, vb0 + ((j - 1) & 3) * SHM_V, pa0, pa1, pa2, pa3, pB0, pB1); }
    TILE_BAR(3);
    { SBAR(); QK_TILE(pA0, pA1, j + 1, K_lds + ((j + 1) & 3) * SHM_K);
    asm volatile("s_waitcnt lgkmcnt(0)" ::: "memory"); SBAR(); PV_PRE(vb0 + (j & 3) * SHM_V); SBAR();
    FIN_SM(pB0, pB1, pA0, pA1, true); SBAR();
    if (j + 3 < NT) { GLD(j + 3); } SBAR();
    PV_WITH_SM(o, vb0 + (j & 3) * SHM_V, pa0, pa1, pa2, pa3, pA0, pA1); }
    if (j + 3 < NT) TILE_BAR(3); else TILE_BAR(0);
  }
  { SBAR(); QK_TILE(pB0, pB1, NT - 1, K_lds + ((NT - 1) & 3) * SHM_K);
  { asm volatile("s_waitcnt lgkmcnt(0)" ::: "memory"); SBAR(); PV_PRE(vb0 + ((NT - 2) & 3) * SHM_V); SBAR();
  FIN_SM(pA0, pA1, pB0, pB1, true); SBAR();
  PV_WITH_SM(o, vb0 + ((NT - 2) & 3) * SHM_V, pa0, pa1, pa2, pa3, pB0, pB1); }
  { asm volatile("s_waitcnt lgkmcnt(0)" ::: "memory"); SBAR(); PV_PRE(vb0 + ((NT - 1) & 3) * SHM_V); SBAR();
  FIN_SM(pB0, pB1, pB0, pB1, false); SBAR();
  PV_ONLY(o, vb0 + ((NT - 1) & 3) * SHM_V, pa0, pa1, pa2, pa3); } }
#undef FIN_SM
  if (hi == 0) li_l[r32] = l_reg; asm volatile("s_waitcnt lgkmcnt(0)" ::: "memory");
  float rli[16];
#pragma unroll
  for (int r = 0; r < 16; ++r) rli[r] = __builtin_amdgcn_rcpf(li_l[crow(r, hi)]);
  float* pk = park + (size_t)wid * 4096 + lane;
  if (FIN == 0) {
#pragma unroll
    for (int r = 0; r < 16; ++r)
#pragma unroll
      for (int d0 = 0; d0 < 4; ++d0) pk[(r * 4 + d0) * 64] = o[d0][r] * rli[r];
  } else {
    float ss[16];
#pragma unroll
    for (int r = 0; r < 16; ++r) { float q = 0.f;
#pragma unroll
      for (int d0 = 0; d0 < 4; ++d0) { const float x = pk[(r * 4 + d0) * 64] - lam * (o[d0][r] * rli[r]); o[d0][r] = x; q += x * x; }
      ss[r] = q; }
    halve_step<16, 16>(ss, lane); halve_step<8, 8>(ss, lane); halve_step<4, 4>(ss, lane); halve_step<2, 2>(ss, lane); ss[0] += __shfl_xor(ss[0], 1);
    if ((lane & 1) == 0) al_l[hi * 16 + ((lane >> 4) & 1) * 8 + ((lane >> 3) & 1) * 4 + ((lane >> 2) & 1) * 2 + ((lane >> 1) & 1)] = rsqrtf(ss[0] * (1.f / ADV) + LN_EPS) * gscale;
    asm volatile("s_waitcnt lgkmcnt(0)" ::: "memory");
    float gs[4];
#pragma unroll
    for (int d0 = 0; d0 < 4; ++d0) gs[d0] = g_sub[d0 * 32 + r32];
    bf16_t* Ow = Ob + (size_t)(wid * QBLK) * LDQ;
#pragma unroll
    for (int r = 0; r < 16; ++r) { const int orow = crow(r, hi); const float rs = al_l[hi * 16 + r];
#pragma unroll
      for (int d0 = 0; d0 < 4; ++d0) Ow[(size_t)orow * LDQ + d0 * 32 + r32] = f2bf(o[d0][r] * rs * gs[d0]); }
  }
  __syncthreads();
#undef GLD
#undef TILE_BAR
#undef RESC
}
__device__ __forceinline__ void attn_phase(const bf16_t* Q, const bf16_t* KV, float* park, bf16_t* OB, const float* rel_table, const float* lq1, const float* lk1, const float* lq2, const float* lk2, const float* g_sub,
                                           float lambda_init, char* lds, int tid) {
  const int bx = blockIdx.x, xcd = bx & 7, slot = bx >> 3, combo = xcd * 2 + (slot >> 4), wi = slot & 15;
  const int h = combo & 7, b = combo >> 3, lane = tid & 63;
  float* lut = (float*)(lds + OFF_LUT);
  if (tid < 256) lut[tid] = rel_table[rel_bucket_dev(tid - 192) * AH + h] * LOG2E;
  __syncthreads();
  const float lam = __uint_as_float(__builtin_amdgcn_readfirstlane(__float_as_uint(__expf(wave_sum(lq1[lane] * lk1[lane])) - __expf(wave_sum(lq2[lane] * lk2[lane])) + lambda_init)));
  const bf16_t* K1 = KV + (size_t)b * SEQ * LDKV + h * ADH;
  const bf16_t* Vh = KV + (size_t)b * SEQ * LDKV + 1024 + h * ADV;
  float* pk = park + (size_t)bx * (NW * 4096);
#pragma unroll 1
  for (int u = 0; u < 8; ++u) {
    const int i = u >> 1, m = u & 1, g = i >> 1, qb = (i & 1) ? (32 * g + 31 - wi) : (32 * g + wi);
    const size_t row0 = (size_t)b * SEQ + (size_t)qb * 256;
    int t2 = tid; asm volatile("" : "+v"(t2));
    attn_unit(m, Q + row0 * LDQ + m * 512 + h * ADH, K1 + m * 512, Vh, OB + row0 * LDQ + h * ADV, pk, lam, g_sub, 1.f - lambda_init, qb, lds, t2);
  }
}
#undef KSWZ64
#undef SBAR
#undef QK_TILE
#undef PV_LGK
#undef PV_PRE
#undef PV_WITH_SM
#undef PV_ONLY
}

namespace gla {
using s16x4  = __attribute__((ext_vector_type(4))) short;
using f32x16 = __attribute__((ext_vector_type(16))) float;
using u32x4  = __attribute__((ext_vector_type(4))) unsigned;
typedef __bf16 bf2_t __attribute__((ext_vector_type(2)));
typedef float f2_t __attribute__((ext_vector_type(2)));
constexpr int GRP = 8, NGRP = NCH / GRP, NUNIT = NB * GH * NGRP;
constexpr int KP = 320, VP = 576, QP = 272;
constexpr int OFF_KD = 0, OFF_V = OFF_KD + 64 * KP, OFF_Q = OFF_V + 64 * VP, OFF_DEC = OFF_Q + 64 * QP, OFF_SS = OFF_DEC + 512, OFF_RS = OFF_SS + 8 * 64 * 4, LDS_GLA = OFF_RS + 256;
constexpr size_t LS_UNIT = (size_t)GDK * GDV;
__device__ __forceinline__ int crow(int r, int hi) { return (r & 3) + 8 * (r >> 2) + 4 * hi; }
__device__ __forceinline__ unsigned cvtpk2(float lo, float hi) { const f2_t v = {lo, hi}; return __builtin_bit_cast(unsigned, __builtin_convertvector(v, bf2_t)); }
template <int OFF> __device__ __forceinline__ s16x4 tr_read(int a) { s16x4 r; asm volatile("ds_read_b64_tr_b16 %0, %1 offset:%2" : "=&v"(r) : "v"(a), "i"(OFF) : "memory"); return r; }
#define GLA_PK(L, H) (bf16x8){L[0], L[1], L[2], L[3], H[0], H[1], H[2], H[3]}

template <bool WITH_O>
__device__ __forceinline__ void scan_unit(bf16_t* __restrict__ qkvr, const float* __restrict__ dec, float* __restrict__ LS, float* __restrict__ GD, const float* __restrict__ g_norm, bf16_t* __restrict__ yout, int ystride, int u, char* lds, int tid) {
  const int wid = __builtin_amdgcn_readfirstlane(tid >> 6), lane = tid & 63, r32 = lane & 31, hi = lane >> 5;
  const int g = u & (NGRP - 1), h = (u >> 5) & 3, b = u >> 7;
  const size_t tokg = (size_t)b * SEQ + (size_t)g * GRP * CHUNK;
  const int ldsb = (int)(uintptr_t)lds;
  const int i16 = lane & 15, tq = i16 >> 2, tp = i16 & 3, blk = (lane >> 4) & 1;
  const int kbase = ldsb + OFF_KD + (8 * hi + tq) * KP + (16 * blk + 4 * tp) * 2;
  const int vbase = ldsb + OFF_V + (8 * hi + tq) * VP + (32 * wid + 16 * blk + 4 * tp) * 2;
  f32x16 st[4];
  float* Lu = LS + (size_t)u * LS_UNIT;
  if (WITH_O) {
#pragma unroll
    for (int kt = 0; kt < 4; ++kt)
#pragma unroll
      for (int r = 0; r < 16; ++r) st[kt][r] = Lu[(size_t)(32 * kt + crow(r, hi)) * GDV + 32 * wid + r32];
  } else {
#pragma unroll
    for (int kt = 0; kt < 4; ++kt)
#pragma unroll
      for (int r = 0; r < 16; ++r) st[kt][r] = 0.f;
  }
  float gdec = 1.f;
  uint4 kd0, kd1, v0, v1, v2, v3, q0, q1; f32x4 dc_r;
  const int pr = tid >> 4, pc = (tid & 15) * 8;
  const int vr = tid >> 5, vc = (tid & 31) * 8;
#define GLA_LOAD(c) do { const bf16_t* gp = qkvr + (tokg + (size_t)(c) * CHUNK) * GQKVR; \
    kd0 = *(const uint4*)(gp + (size_t)pr * GQKVR + GHK + h * GDK + pc); kd1 = *(const uint4*)(gp + (size_t)(pr + 32) * GQKVR + GHK + h * GDK + pc); \
    if (WITH_O) { q0 = *(const uint4*)(gp + (size_t)pr * GQKVR + h * GDK + pc); q1 = *(const uint4*)(gp + (size_t)(pr + 32) * GQKVR + h * GDK + pc); } \
    v0 = *(const uint4*)(gp + (size_t)vr * GQKVR + 1024 + h * GDV + vc); v1 = *(const uint4*)(gp + (size_t)(vr + 16) * GQKVR + 1024 + h * GDV + vc); \
    v2 = *(const uint4*)(gp + (size_t)(vr + 32) * GQKVR + 1024 + h * GDV + vc); v3 = *(const uint4*)(gp + (size_t)(vr + 48) * GQKVR + 1024 + h * GDV + vc); \
    if (tid < 32) dc_r = *(const f32x4*)(dec + ((size_t)b * NCH + (size_t)g * GRP + (c)) * GHK + h * GDK + tid * 4); } while (0)
#define GLA_STORE() do { \
    *(uint4*)(lds + OFF_KD + pr * KP + pc * 2) = kd0; *(uint4*)(lds + OFF_KD + (pr + 32) * KP + pc * 2) = kd1; \
    if (WITH_O) { *(uint4*)(lds + OFF_Q + pr * QP + pc * 2) = q0; *(uint4*)(lds + OFF_Q + (pr + 32) * QP + pc * 2) = q1; } \
    *(uint4*)(lds + OFF_V + vr * VP + vc * 2) = v0; *(uint4*)(lds + OFF_V + (vr + 16) * VP + vc * 2) = v1; \
    *(uint4*)(lds + OFF_V + (vr + 32) * VP + vc * 2) = v2; *(uint4*)(lds + OFF_V + (vr + 48) * VP + vc * 2) = v3; \
    if (tid < 32) *(f32x4*)(lds + OFF_DEC + tid * 16) = dc_r; } while (0)
  GLA_LOAD(0);
#pragma unroll 1
  for (int c = 0; c < GRP; ++c) {
    const size_t t0 = tokg + (size_t)c * CHUNK;
    GLA_STORE();
    __syncthreads();
    if (!WITH_O && tid < 128) gdec *= ((const float*)(lds + OFF_DEC))[tid];
    if (c + 1 < GRP) GLA_LOAD(c + 1);
#pragma unroll
    for (int kt = 0; kt < 4; ++kt)
#pragma unroll
      for (int g4 = 0; g4 < 4; ++g4) { const f32x4 d = *(const f32x4*)(lds + OFF_DEC + (32 * kt + 8 * g4 + 4 * hi) * 4);
#pragma unroll
        for (int i = 0; i < 4; ++i) st[kt][4 * g4 + i] *= d[i]; }
#define GLA_STEP(S) do { const s16x4 bl = tr_read<(16 * (S)) * VP>(vbase), bh_ = tr_read<(16 * (S) + 4) * VP>(vbase); \
      const s16x4 a0l = tr_read<(16 * (S)) * KP + 0>(kbase), a0h = tr_read<(16 * (S) + 4) * KP + 0>(kbase), a1l = tr_read<(16 * (S)) * KP + 64>(kbase), a1h = tr_read<(16 * (S) + 4) * KP + 64>(kbase); \
      const s16x4 a2l = tr_read<(16 * (S)) * KP + 128>(kbase), a2h = tr_read<(16 * (S) + 4) * KP + 128>(kbase), a3l = tr_read<(16 * (S)) * KP + 192>(kbase), a3h = tr_read<(16 * (S) + 4) * KP + 192>(kbase); \
      asm volatile("s_waitcnt lgkmcnt(0)" ::: "memory"); __builtin_amdgcn_sched_barrier(0); \
      const bf16x8 bv = GLA_PK(bl, bh_); \
      st[0] = __builtin_amdgcn_mfma_f32_32x32x16_bf16(GLA_PK(a0l, a0h), bv, st[0], 0, 0, 0); st[1] = __builtin_amdgcn_mfma_f32_32x32x16_bf16(GLA_PK(a1l, a1h), bv, st[1], 0, 0, 0); \
      st[2] = __builtin_amdgcn_mfma_f32_32x32x16_bf16(GLA_PK(a2l, a2h), bv, st[2], 0, 0, 0); st[3] = __builtin_amdgcn_mfma_f32_32x32x16_bf16(GLA_PK(a3l, a3h), bv, st[3], 0, 0, 0); } while (0)
    GLA_STEP(0); GLA_STEP(1); GLA_STEP(2); GLA_STEP(3);
#undef GLA_STEP
    if (WITH_O) {
      f32x16 oa[2];
#pragma unroll
      for (int rt = 0; rt < 2; ++rt)
#pragma unroll
        for (int r = 0; r < 16; ++r) oa[rt][r] = 0.f;
#pragma unroll
      for (int kt = 0; kt < 4; ++kt)
#pragma unroll
        for (int s = 0; s < 2; ++s) {
          u32x4 pw; pw.x = cvtpk2(st[kt][8 * s + 0], st[kt][8 * s + 1]); pw.y = cvtpk2(st[kt][8 * s + 2], st[kt][8 * s + 3]); pw.z = cvtpk2(st[kt][8 * s + 4], st[kt][8 * s + 5]); pw.w = cvtpk2(st[kt][8 * s + 6], st[kt][8 * s + 7]);
          const bf16x8 bs = __builtin_bit_cast(bf16x8, pw);
#pragma unroll
          for (int rt = 0; rt < 2; ++rt) {
            const char* qp = lds + OFF_Q + (32 * rt + r32) * QP + (32 * kt + 16 * s + 4 * hi) * 2;
            const s16x4 ql = *(const s16x4*)qp, qh = *(const s16x4*)(qp + 16);
            oa[rt] = __builtin_amdgcn_mfma_f32_32x32x16_bf16(GLA_PK(ql, qh), bs, oa[rt], 0, 0, 0);
          }
        }
      float* SS = (float*)(lds + OFF_SS); float* RS = (float*)(lds + OFF_RS);
      { float x[32];
#pragma unroll
        for (int rt = 0; rt < 2; ++rt)
#pragma unroll
          for (int r = 0; r < 16; ++r) x[rt * 16 + r] = oa[rt][r] * oa[rt][r];
        halve_step<32, 16>(x, lane); halve_step<16, 8>(x, lane); halve_step<8, 4>(x, lane); halve_step<4, 2>(x, lane); halve_step<2, 1>(x, lane);
        SS[wid * 64 + 32 * (r32 >> 4) + crow(r32 & 15, hi)] = x[0]; }
      __syncthreads();
      if (tid < 64) { float s = 0.f;
#pragma unroll
        for (int w = 0; w < 8; ++w) s += SS[w * 64 + tid];
        RS[tid] = rsqrtf(s * (1.f / GDV) + LN_EPS); }
      __syncthreads();
      constexpr int YP = 528;
#pragma unroll
      for (int rt = 0; rt < 2; ++rt)
#pragma unroll
        for (int g4 = 0; g4 < 4; ++g4) { const f32x4 rs = *(const f32x4*)(RS + 32 * rt + 8 * g4 + 4 * hi);
#pragma unroll
          for (int i = 0; i < 4; ++i) *(bf16_t*)(lds + OFF_V + (32 * rt + 8 * g4 + 4 * hi + i) * YP + (32 * wid + r32) * 2) = f2bf(oa[rt][4 * g4 + i] * rs[i]); }
      __syncthreads();
#pragma unroll
      for (int i = 0; i < 4; ++i) { const int p = tid + 512 * i, tt = p >> 5, c8 = (p & 31) * 8;
        const uint4 yv = *(const uint4*)(lds + OFF_V + tt * YP + c8 * 2);
        const size_t tok = t0 + tt;
        const uint4 rv = *(const uint4*)(qkvr + tok * GQKVR + 2048 + h * GDV + c8);
        const f32x4 ga = *(const f32x4*)(g_norm + h * GDV + c8), gb = *(const f32x4*)(g_norm + h * GDV + c8 + 4);
        const unsigned yw[4] = {yv.x, yv.y, yv.z, yv.w}, rw[4] = {rv.x, rv.y, rv.z, rv.w}; unsigned ow[4];
#pragma unroll
        for (int k = 0; k < 4; ++k) { const float y0 = __uint_as_float(yw[k] << 16), y1 = __uint_as_float(yw[k] & 0xffff0000u), r0 = __uint_as_float(rw[k] << 16), r1 = __uint_as_float(rw[k] & 0xffff0000u);
          const float g0 = k < 2 ? ga[2 * k] : gb[2 * k - 4], g1 = k < 2 ? ga[2 * k + 1] : gb[2 * k - 3];
          ow[k] = cvtpk2(y0 * g0 * silu_f(r0), y1 * g1 * silu_f(r1)); }
        uint4 o4; o4.x = ow[0]; o4.y = ow[1]; o4.z = ow[2]; o4.w = ow[3];
        *(uint4*)(yout + tok * (size_t)ystride + h * GDV + c8) = o4; }
    }
    __syncthreads();
  }
  if (!WITH_O) {
#pragma unroll
    for (int kt = 0; kt < 4; ++kt)
#pragma unroll
      for (int r = 0; r < 16; ++r) Lu[(size_t)(32 * kt + crow(r, hi)) * GDV + 32 * wid + r32] = st[kt][r];
    if (tid < 128) GD[(size_t)u * GDK + tid] = gdec;
  }
#undef GLA_LOAD
#undef GLA_STORE
}
__device__ __forceinline__ void scan_groups(float* __restrict__ LS, const float* __restrict__ GD, int gtid, int nthreads) {
  for (int i = gtid; i < NB * GH * (GDK * GDV / 2); i += nthreads) {
    const int bh = i >> 14, e2 = i & 16383, k = e2 >> 7, v2 = e2 & 127;
    float* p = LS + (size_t)bh * NGRP * LS_UNIT + (size_t)k * GDV + 2 * v2;
    const float* gd = GD + (size_t)bh * NGRP * GDK + k;
    f2_t s = {0.f, 0.f};
#pragma unroll 8
    for (int g = 0; g < NGRP; ++g) { const f2_t l = *(const f2_t*)(p + (size_t)g * LS_UNIT); const float d = gd[(size_t)g * GDK];
      *(f2_t*)(p + (size_t)g * LS_UNIT) = s; s = s * d + l; }
  }
}
#undef GLA_PK
}

#define LAS __attribute__((address_space(3)))
constexpr int NWAVES = 8, NTHREADS = NWAVES * 64;
constexpr int LDS_XB = 151552;
constexpr int LDS_BYTES = LDS_XB + 256;
constexpr int CW_BAR = 4096;
constexpr int N_PHASES = 48;

#define XB_TMO      128
#define XB_XCNT(j)  (256  + 64 * (j))
#define XB_XSUB(j)  (1280 + 64 * (j))
#define XB_XGEN(j)  (2304 + 64 * (j))
#define XB_TOP      3328
#define XB_TOPGEN   3392
#define XCD_BAR_WORDS 3456
#define XB_SPIN_CAP (1u << 18)
__device__ __forceinline__ unsigned xb_ld(unsigned* p)              { return __hip_atomic_load(p, __ATOMIC_RELAXED, __HIP_MEMORY_SCOPE_AGENT); }
__device__ __forceinline__ unsigned xb_add(unsigned* p, unsigned v) { return __hip_atomic_fetch_add(p, v, __ATOMIC_RELAXED, __HIP_MEMORY_SCOPE_AGENT); }
__device__ __forceinline__ unsigned xb_xcc_id() { return (unsigned)__builtin_amdgcn_s_getreg((3 << 11) | 20) & 0xFu; }
#define XB_SPIN(cond, bar) do { unsigned _sp = 0; while (cond) { __builtin_amdgcn_s_sleep(1); \
    if ((++_sp & 255u) == 0u) { if (xb_ld(&(bar)[XB_TMO])) break; if (_sp > XB_SPIN_CAP) { atomicAdd(&(bar)[XB_TMO], 1u); break; } } } } while (0)
struct XcdBarrier { unsigned* bar; unsigned x; volatile LAS unsigned* st; };
__device__ __forceinline__ XcdBarrier xcd_barrier_post(unsigned* bar, volatile LAS unsigned* st) {
    XcdBarrier b; b.bar = bar; b.x = xb_xcc_id(); b.st = st;
    if (threadIdx.x == 0) (void)xb_add(&bar[XB_XCNT(b.x)], 1u);
    return b;
}
__device__ __forceinline__ void xcd_barrier_complete(unsigned* bar, unsigned x, unsigned& nloc, unsigned& nx) {
    const unsigned G = gridDim.x * gridDim.y * gridDim.z;
    unsigned sum, cnt, mine, sp = 0u;
    for (;;) {
        sum = 0u; cnt = 0u; mine = 0u;
#pragma unroll
        for (unsigned j = 0; j < 16; ++j) { const unsigned c = xb_ld(&bar[XB_XCNT(j)]); sum += c; cnt += (c > 0u) ? 1u : 0u; mine = (j == x) ? c : mine; }
        if (sum == G) break;
        __builtin_amdgcn_s_sleep(1);
        if ((++sp & 255u) == 0u) { if (xb_ld(&bar[XB_TMO])) break; if (sp > XB_SPIN_CAP) { atomicAdd(&bar[XB_TMO], 1u); break; } }
    }
    nloc = mine > 0u ? mine : 1u; nx = cnt > 0u ? cnt : 1u;
}
__device__ __forceinline__ void xcd_barrier(const XcdBarrier& b, int tid) {
    asm volatile("s_waitcnt vmcnt(0)" ::: "memory");
    __syncthreads();
    if (tid == 0) {
        unsigned* bar = b.bar;
        __builtin_amdgcn_s_waitcnt(0);
        unsigned nloc = b.st[0], nx = b.st[1];
        if (nloc == 0u) { xcd_barrier_complete(bar, b.x, nloc, nx); b.st[0] = nloc; b.st[1] = nx; }
        const unsigned old = xb_add(&bar[XB_XSUB(b.x)], 1u);
        const unsigned gen = old / nloc;
        if (old + 1u == (gen + 1u) * nloc) {
            __builtin_amdgcn_fence(__ATOMIC_RELEASE, "agent");
            asm volatile("s_waitcnt vmcnt(0)" ::: "memory");
            const unsigned og = xb_add(&bar[XB_TOP], 1u);
            const unsigned tg = og / nx;
            if (og + 1u == (tg + 1u) * nx) xb_add(&bar[XB_TOPGEN], 1u);
            else XB_SPIN(xb_ld(&bar[XB_TOPGEN]) == tg, bar);
            __builtin_amdgcn_fence(__ATOMIC_ACQUIRE, "agent");
            xb_add(&bar[XB_XGEN(b.x)], 1u);
            asm volatile("s_waitcnt vmcnt(0)" ::: "memory");
        } else {
            XB_SPIN(xb_ld(&bar[XB_XGEN(b.x)]) == gen, bar);
            __builtin_amdgcn_fence(__ATOMIC_ACQUIRE, "agent");
            asm volatile("s_waitcnt vmcnt(0)" ::: "memory");
        }
    }
    __syncthreads();
}

struct MArgs { const float* in[24]; float* out; unsigned char* ws; int ph_lo, ph_hi, li, pad; };

__device__ __forceinline__ unsigned pk2(float lo, float hi) { return (unsigned)f2bf(lo) | ((unsigned)f2bf(hi) << 16); }
__device__ __forceinline__ void tr_item(const float* W, int ld, int K, int N, bf16_t* WT, int rs, int roff, float scale, int nscale, float* scr, int item, int lane) {
    const int nblk = N / 32, kb = item / nblk, nb = item % nblk, k0 = 64 * kb, n0 = 32 * nb;
    const float sc = (n0 + (lane & 31)) < nscale ? scale : 1.f;
#pragma unroll 8
    for (int i = 0; i < 32; ++i) { const int kk = 2 * i + (lane >> 5); scr[kk * 33 + (lane & 31)] = __builtin_nontemporal_load(W + (size_t)(k0 + kk) * ld + n0 + (lane & 31)) * sc; }
    asm volatile("s_waitcnt lgkmcnt(0)" ::: "memory");
    const int c = lane & 7;
#pragma unroll
    for (int j = 0; j < 4; ++j) { const int n = (lane >> 3) + 8 * j; const float* s = scr + (8 * c) * 33 + n;
        uint4 o; o.x = pk2(s[0 * 33], s[1 * 33]); o.y = pk2(s[2 * 33], s[3 * 33]); o.z = pk2(s[4 * 33], s[5 * 33]); o.w = pk2(s[6 * 33], s[7 * 33]);
        const int ng = n0 + n, drow = (ng >> 4) * rs + (ng & 15) + roff;
        *(uint4*)(WT + (size_t)drow * K + k0 + 8 * c) = o; }
    asm volatile("s_waitcnt lgkmcnt(0)" ::: "memory");
}
__device__ __forceinline__ const void* ldptr(volatile LAS unsigned long long* tab, int i) { const unsigned long long v = tab[i];
    const unsigned lo = __builtin_amdgcn_readfirstlane((unsigned)v), hi = __builtin_amdgcn_readfirstlane((unsigned)(v >> 32)); return (const void*)(const __attribute__((address_space(1))) char*)(((unsigned long long)hi << 32) | lo); }
#define INP(i) ((const float*)ldptr(ptab, (i)))
__device__ __forceinline__ void ph_convert(volatile LAS unsigned long long* ptab, unsigned char* ws, unsigned char* lds, int gw, int NGW, int wave, int lane) {
    float* scr = (float*)(lds + wave * 16384);
    constexpr int I0 = 2 * 16 * 96, I1 = 2 * 16 * 32, I2 = 16 * 64, I3 = 2 * 16 * 32, I4 = 2 * 16 * 32, I5 = 64 * 16 * 16, I6 = I5, I7 = 64 * 8 * 32;
    constexpr int NIT = I0 + I1 + I2 + I3 + I4 + I5 + I6 + I7;
    for (int it = gw; it < NIT; it += NGW) {
        int r = it; const float* src; bf16_t* dst; int ld, K = D, N, rs = 16, roff = 0, nscale = 0, item; float scale = 1.f;
        if (r < I0) { const int z = r / (16 * 96); item = r % (16 * 96); src = INP(1) + (size_t)z * D * GIN; ld = GIN; N = GQKVR; dst = (bf16_t*)(ws + WS_WIN) + (size_t)z * GQKVR * D; scale = 0.08838834764831845f; nscale = 512; }
        else if ((r -= I0) < I1) { const int z = r / 512; item = r % 512; src = INP(5) + (size_t)z * D * D; ld = D; N = D; dst = (bf16_t*)(ws + WS_WOA) + (size_t)z * D * D; }
        else if ((r -= I1) < I2) { item = r; src = INP(6); ld = 2048; N = 2048; dst = (bf16_t*)(ws + WS_WKV); }
        else if ((r -= I2) < I3) { const int z = r / 512; item = r % 512; src = INP(7) + (size_t)z * D * D; ld = D; N = D; dst = (bf16_t*)(ws + WS_WQ) + (size_t)z * D * D; scale = 0.125f * 1.4426950408889634f; nscale = 1024; }
        else if ((r -= I3) < I4) { const int z = r / 512; item = r % 512; src = INP(13) + (size_t)z * D * D; ld = D; N = D; dst = (bf16_t*)(ws + WS_WOB) + (size_t)z * D * D; }
        else if ((r -= I4) < I5) { const int z = r / 256; item = r % 256; src = INP(19) + (size_t)z * D * FF; ld = FF; N = FF; dst = (bf16_t*)(ws + WS_WGU) + (size_t)z * 1024 * D; rs = 32; }
        else if ((r -= I5) < I6) { const int z = r / 256; item = r % 256; src = INP(20) + (size_t)z * D * FF; ld = FF; N = FF; dst = (bf16_t*)(ws + WS_WGU) + (size_t)z * 1024 * D; rs = 32; roff = 16; }
        else { r -= I6; const int z = r / 256; item = r % 256; src = INP(21) + (size_t)z * FF * D; ld = D; K = FF; N = D; dst = (bf16_t*)(ws + WS_WD) + (size_t)z * D * FF; }
        tr_item(src, ld, K, N, dst, rs, roff, scale, nscale, scr, item, lane);
    }
}

__device__ __forceinline__ void kdec_ref_phase(bf16_t* qkvr, const float* lr, const float* w_gate2, const float* b_gate, float* dec, unsigned char* lds, int tid) {
    float (*slr)[16] = (float (*)[16])lds;
    const int ch = tid;
    for (int bc = blockIdx.x; bc < NB * NCH; bc += gridDim.x) {
        const size_t tok0 = (size_t)bc * CHUNK;
        __syncthreads();
        for (int i = tid; i < 64 * 16; i += NTHREADS) slr[i >> 4][i & 15] = lr[tok0 * 16 + i];
        float wg[16];
#pragma unroll
        for (int j = 0; j < 16; ++j) wg[j] = w_gate2[j * GHK + ch];
        const float bg = b_gate[ch];
        __syncthreads();
        float cum[64]; float run = 0.f;
#pragma unroll
        for (int t = 0; t < 64; ++t) {
            float z = bg;
#pragma unroll
            for (int j = 0; j < 16; ++j) z += slr[t][j] * wg[j];
            const float ls = fminf(z, 0.f) - __logf(1.f + __expf(-fabsf(z)));
            run += ls * (1.f / 16.f); cum[t] = run;
        }
#pragma unroll
        for (int t = 0; t < 64; ++t) { bf16_t* kp = qkvr + (tok0 + t) * GQKVR + GHK + ch; *kp = f2bf(bf2f(*kp) * __expf(run - cum[t])); }
        dec[(size_t)bc * GHK + ch] = __expf(run);
    }
    __syncthreads();
}
constexpr size_t WS_O1 = WS_R1 + (size_t)T * D * 2, WS_O2 = WS_R1 + (size_t)2 * T * D * 2;
#define PTRS unsigned char* const ws = (unsigned char*)ldptr(ptab, 25); float* const outp = (float*)ldptr(ptab, 24); int* const CTL = (int*)(ws + WS_CTL); \
    bf16_t *WIN = (bf16_t*)(ws + WS_WIN), *WOA = (bf16_t*)(ws + WS_WOA), *WKV = (bf16_t*)(ws + WS_WKV), *WQ = (bf16_t*)(ws + WS_WQ), *WOB = (bf16_t*)(ws + WS_WOB), *WGU = (bf16_t*)(ws + WS_WGU), *WD = (bf16_t*)(ws + WS_WD); \
    bf16_t *HB = (bf16_t*)(ws + WS_HB), *R1 = (bf16_t*)(ws + WS_R1), *MIX = (bf16_t*)(ws + WS_MIX), *HBUF = (bf16_t*)(ws + WS_HBUF), *YSLOT = (bf16_t*)(ws + WS_YSLOT), *QB = (bf16_t*)(ws + WS_QB); \
    bf16_t *O1 = (bf16_t*)(ws + WS_O1), *O2 = (bf16_t*)(ws + WS_O2); float *LR = (float*)(ws + WS_LR), *DEC = (float*)(ws + WS_DEC), *TOKW = (float*)(ws + WS_TOKW); \
    int *LIST = (int*)(ws + WS_LIST), *TOKE = (int*)(ws + WS_TOKE), *TOKP = (int*)(ws + WS_TOKP); bf16_t* KV = (bf16_t*)outp; float* OBUF = outp; int* cnt = CTL + CW_CNT + 64 * l; \
    (void)WIN; (void)WOA; (void)WKV; (void)WQ; (void)WOB; (void)WGU; (void)WD; (void)HB; (void)R1; (void)MIX; (void)HBUF; (void)YSLOT; (void)QB; (void)O1; (void)O2; (void)LR; (void)DEC; (void)TOKW; (void)LIST; (void)TOKE; (void)TOKP; (void)KV; (void)OBUF; (void)cnt;
#define PHASE(id, ...) do { if ((id) >= lo && (id) < hi) { int lane; asm volatile("v_mbcnt_lo_u32_b32 %0, -1, 0\n\tv_mbcnt_hi_u32_b32 %0, -1, %0" : "=v"(lane)); const int wave = wave0, tid = wave0 * 64 + lane, gw = blockIdx.x * NWAVES + wave; (void)lane; (void)gw; PTRS \
        __VA_ARGS__; if ((id) + 1 < hi) { XcdBarrier bl = bar; asm volatile("" : "+s"(bl.bar), "+s"(bl.x)); xcd_barrier(bl, tid); } } } while (0)

template <int l> __device__ __forceinline__ void layer_phases(volatile LAS unsigned long long* const ptab, unsigned char* const lds, LAS unsigned char* const ldsl, const XcdBarrier& bar,
                                                            const int lo, const int hi, const int wave0, const int G, const int NGW) {
        const int pb = 1 + 12 * l;
        if (l < 2) {
            PHASE(pb + 0, { const pg8::Gemm g{HB, WIN + (size_t)l * GQKVR * D, D, D, D, 0}; pg8::DenseOrder S; S.init(T, GQKVR, G, (int)blockIdx.x); const pg8::EpiBf16 E{R1, GQKVR}; pg8::gemm_phase(ldsl, g, S, E, tid); });
            PHASE(pb + 1, kdec_ref_phase(R1, LR, INP(2) + (size_t)l * 16 * GHK, INP(3) + (size_t)l * GHK, DEC, lds, tid));
            PHASE(pb + 2, gla::scan_unit<false>(R1, DEC, (float*)MIX, (float*)MIX + (size_t)gla::NUNIT * gla::LS_UNIT, nullptr, nullptr, 0, (int)blockIdx.x, (char*)lds, tid));
            PHASE(pb + 3, gla::scan_groups((float*)MIX, (const float*)MIX + (size_t)gla::NUNIT * gla::LS_UNIT, (int)blockIdx.x * NTHREADS + tid, G * NTHREADS));
            PHASE(pb + 4, gla::scan_unit<true>(R1, DEC, (float*)MIX, nullptr, INP(4) + (size_t)l * GHV, R1 + 1024, GQKVR, (int)blockIdx.x, (char*)lds, tid));
            PHASE(pb + 5, { const pg8::Gemm g{R1 + 1024, WOA + (size_t)l * D * D, GQKVR, D, D, 0}; pg8::DenseOrder S; S.init(T, D, G, (int)blockIdx.x); const pg8::EpiBf16 E{MIX, D}; pg8::gemm_phase(ldsl, g, S, E, tid); });
        } else {
            const int j = l - 2; const float lambda_init = l == 2 ? 0.47071302f : 0.55605820f;
            PHASE(pb + 0, { { const pg8::Gemm g{HB, WQ + (size_t)j * D * D, D, D, D, 0}; pg8::DenseOrder S; S.init(T, D, G, (int)blockIdx.x); const pg8::EpiBf16 E{QB, D}; pg8::gemm_phase(ldsl, g, S, E, tid); }
                            if (l == 2) { const pg8::Gemm g{HB, WKV, D, D, D, 0}; pg8::DenseOrder S; S.init(T, 2048, G, (int)blockIdx.x); const pg8::EpiBf16 E{KV, 2048}; pg8::gemm_phase(ldsl, g, S, E, tid); } });
            PHASE(pb + 1, att::attn_phase(QB, KV, (float*)O1, O2, INP(14), INP(8) + j * 64, INP(9) + j * 64, INP(10) + j * 64, INP(11) + j * 64, INP(12) + j * ADV, lambda_init, (char*)lds, tid));
            PHASE(pb + 5, { const pg8::Gemm g{O2, WOB + (size_t)j * D * D, D, D, D, 0}; pg8::DenseOrder S; S.init(T, D, G, (int)blockIdx.x); const pg8::EpiBf16 E{MIX, D}; pg8::gemm_phase(ldsl, g, S, E, tid); });
        }
        PHASE(pb + 6, { RowArgs r{}; r.mode = 1; r.hb = HB; r.mix = MIX; r.ln_g = INP(22) + (size_t)(l * 2) * D; r.ln_b = INP(23) + (size_t)(l * 2) * D;
                        r.w_group = INP(15) + (size_t)l * D * 4; r.b_group = INP(16) + l * 4; r.w_router = INP(17) + (size_t)l * D * 16; r.b_router = INP(18) + l * 16;
                        r.cnt = cnt; r.list = LIST; r.tok_e = TOKE; r.tok_pos = TOKP; r.tok_w = TOKW;
                        row_phase<NTHREADS, 20>(r, lds, G, blockIdx.x, tid); });
        PHASE(pb + 7, { const pg8::Gemm g{HB, WGU + (size_t)l * NE * 1024 * D, D, D, D, (size_t)1024 * D}; const pg8::MoeOrder<true> S{cnt, LIST, 4, G, (int)blockIdx.x}; const pg8::EpiSwiglu E{HBUF, FF}; pg8::gemm_phase(ldsl, g, S, E, tid); });
        PHASE(pb + 8, { const pg8::Gemm g{HBUF, WD + (size_t)l * NE * D * FF, FF, FF, FF, (size_t)D * FF}; const pg8::MoeOrder<false> S{cnt, LIST, 4, G, (int)blockIdx.x}; const pg8::EpiBf16 E{YSLOT, D}; pg8::gemm_phase(ldsl, g, S, E, tid); });
        PHASE(pb + 9, { RowArgs r{}; r.mode = 2; r.hb = HB; r.Y = YSLOT; r.ln_g = INP(22) + (size_t)(l * 2 + 1) * D; r.ln_b = INP(23) + (size_t)(l * 2 + 1) * D;
                        r.cnt = cnt; r.tok_e = TOKE; r.tok_pos = TOKP; r.tok_w = TOKW;
                        if (l == 0) { r.lr_w = INP(1) + (size_t)D * GIN + 3072; r.lr_out = LR; }
                        if (l == 3) r.out = outp;
                        row_phase<NTHREADS, (l == 0 ? 16 : 0)>(r, lds, G, blockIdx.x, tid); });
}

__global__ void __launch_bounds__(NTHREADS, 2) fwd(MArgs a) {
    extern __shared__ __attribute__((aligned(16))) unsigned char lds[];
    const int tid0 = threadIdx.x, wave0 = __builtin_amdgcn_readfirstlane(tid0 >> 6);
    const int G = gridDim.x, NGW = G * NWAVES;
    volatile LAS unsigned long long* const ptab = (volatile LAS unsigned long long*)(lds + LDS_XB + 16);
    if (tid0 < 4) ((volatile LAS unsigned*)(lds + LDS_XB))[tid0] = 0u;
    if (tid0 < 24) ptab[tid0] = (unsigned long long)a.in[tid0];
    if (tid0 == 24) ptab[24] = (unsigned long long)a.out;
    if (tid0 == 25) ptab[25] = (unsigned long long)a.ws;
    __syncthreads();
    XcdBarrier bar = xcd_barrier_post((unsigned*)(a.ws + WS_CTL) + CW_BAR + a.li * XCD_BAR_WORDS, (volatile LAS unsigned*)(lds + LDS_XB));
    const int lo = a.ph_lo, hi = a.ph_hi;
    PG8_LAS unsigned char* const ldsl = (PG8_LAS unsigned char*)lds;
    { const int l = 0;
    PHASE(0, { ph_convert(ptab, ws, lds, gw, NGW, wave, lane); __syncthreads();
               RowArgs r{}; r.mode = 0; r.x = INP(0); r.hb = HB; r.lr_w = INP(1) + 3072; r.lr_out = LR; row_phase<NTHREADS, 16>(r, lds, G, blockIdx.x, tid); }); }
    layer_phases<0>(ptab, lds, ldsl, bar, lo, hi, wave0, G, NGW);
    layer_phases<1>(ptab, lds, ldsl, bar, lo, hi, wave0, G, NGW);
    layer_phases<2>(ptab, lds, ldsl, bar, lo, hi, wave0, G, NGW);
    layer_phases<3>(ptab, lds, ldsl, bar, lo, hi, wave0, G, NGW);
}
#undef PHASE

#ifndef RUN_MODE
#define RUN_MODE 1
#endif
extern "C" void kernel_launch(void* const* d_in, const int* in_sizes, int n_in, void* d_out, int out_size, void* d_ws, size_t ws_size, hipStream_t stream) {
    static int grid = 0;
    if (grid == 0) {
        if (n_in != 24 || out_size != T * D || ws_size < WS_END) { fprintf(stderr, "kernel_launch: unexpected sizes n_in %d out %d ws %zu (need %zu)\n", n_in, out_size, ws_size, (size_t)WS_END); grid = -1; return; }
        int dev = 0, cus = 0, per_cu = 0;
        if (hipGetDevice(&dev) != hipSuccess || hipDeviceGetAttribute(&cus, hipDeviceAttributeMultiprocessorCount, dev) != hipSuccess) { grid = -1; return; }
        if (hipFuncSetAttribute((const void*)fwd, hipFuncAttributeMaxDynamicSharedMemorySize, LDS_BYTES) != hipSuccess) { fprintf(stderr, "hipFuncSetAttribute failed\n"); grid = -1; return; }
        if (hipOccupancyMaxActiveBlocksPerMultiprocessor(&per_cu, (const void*)fwd, NTHREADS, LDS_BYTES) != hipSuccess || per_cu < 1) { fprintf(stderr, "occupancy query: %d blocks per CU\n", per_cu); grid = -1; return; }
        (void)hipGetLastError();
        grid = cus;
        if (grid != 256 || T % (grid * NWAVES * 4) != 0) { fprintf(stderr, "unsupported CU count %d\n", cus); grid = -1; return; }
    }
    if (grid < 0) return;
    (void)hipMemsetAsync((unsigned char*)d_ws + WS_CTL, 0, CTL_BYTES, stream);
    MArgs a{};
    for (int i = 0; i < 24; ++i) a.in[i] = (const float*)d_in[i];
    a.out = (float*)d_out; a.ws = (unsigned char*)d_ws;
#if RUN_MODE == 1
    a.ph_lo = 0; a.ph_hi = N_PHASES - 1; a.li = 0;
    hipLaunchKernelGGL(fwd, dim3(grid), dim3(NTHREADS), LDS_BYTES, stream, a);
#else
    int li = 0;
    for (int p = 0; p < N_PHASES - 1; ++p) {
        const int k = (p - 1) % 12, l = (p - 1) / 12;
        if (p > 0) { if (k >= 10) continue; if (l >= 2 && (k == 2 || k == 3 || k == 4)) continue; }
        a.ph_lo = p; a.ph_hi = p + 1; a.li = li++;
        hipLaunchKernelGGL(fwd, dim3(grid), dim3(NTHREADS), LDS_BYTES, stream, a);
    }
#endif
}
```
